# Optimizing an MI355X kernel written in HIP

```python
import jax, jax.numpy as jnp
from jax import lax
import numpy as np

D_MODEL = 1024
BATCH = 2
SEQ = 8192
DEPTH = 1

CHUNK = 64
MIX_WIDTH = D_MODEL
SGU_WIDTH = MIX_WIDTH // 2
SGU_HEADS = 8
SGU_HEAD_DIM = SGU_WIDTH // SGU_HEADS
SGU_BLOCK = 128
RWKV_WIDTH = MIX_WIDTH - SGU_WIDTH
RWKV_HEAD_DIM = 64
RWKV_HEADS = RWKV_WIDTH // RWKV_HEAD_DIM
DECAY_LORA = 64
ICLR_LORA = 64
GATE_LORA = 128
LNX_EPS = 64e-5
IN_WIDTH = 2 * SGU_WIDTH + 3 * RWKV_WIDTH
N_EXPERTS = 32
TOP_K = 4
D_EXPERT = D_MODEL
SWIGLU_ALPHA = 1.702
SWIGLU_LIMIT = 7.0
MOE_BLOCK = 128
RMS_EPS = 1e-5
LN_EPS = 1e-5

kernel_name = "hymba_sgu_rwkv7_moe_block"


def rms_norm(x, g):
    xf = x.astype(jnp.float32)
    y = xf * lax.rsqrt(jnp.mean(xf * xf, axis=-1, keepdims=True) + RMS_EPS)
    return (y * g.astype(jnp.float32)).astype(x.dtype)


def token_shift(z):
    return jnp.pad(z, ((0, 0), (1, 0), (0, 0)))[:, :-1]


def shift_mix(z, mu):
    return z + (token_shift(z) - z) * mu


def chunk_causal_mask(n):
    c = jnp.arange(n) // CHUNK
    return c[None, :] <= c[:, None]


def spatial_gating(z, ln_g, ln_b, w_s, b_s):
    b, s, _ = z.shape
    u, v = jnp.split(z, 2, axis=-1)
    vf = v.astype(jnp.float32)
    mu = jnp.mean(vf, axis=-1, keepdims=True)
    var = jnp.mean(jnp.square(vf - mu), axis=-1, keepdims=True)
    v = ((vf - mu) * lax.rsqrt(var + LN_EPS) * ln_g.astype(jnp.float32)
         + ln_b.astype(jnp.float32)).astype(z.dtype)
    v = v.reshape(b, s // SGU_BLOCK, SGU_BLOCK, SGU_HEADS, SGU_HEAD_DIM)
    w = jnp.where(chunk_causal_mask(SGU_BLOCK)[None], w_s, jnp.zeros_like(w_s))
    sv = jnp.einsum('hij,bnjhc->bnihc', w, v) + jnp.transpose(b_s)[None, None, :, :, None]
    return u * sv.reshape(b, s, SGU_WIDTH).astype(u.dtype)


def rwkv7_time_mix(hn, p_r, p_k, p_v, mu_rkv, mu_wag, w0, w1, w2, a0, a1, a2,
                   g1, g2, k_k, k_a, r_k, lnx_g, lnx_b):
    f32 = jnp.float32
    b, s, _ = hn.shape
    H, N = RWKV_HEADS, RWKV_HEAD_DIM
    hd = (b, s, H, N)
    r = shift_mix(p_r, mu_rkv[0]).astype(f32).reshape(hd)
    k = shift_mix(p_k, mu_rkv[1]).astype(f32).reshape(hd)
    v = shift_mix(p_v, mu_rkv[2]).astype(f32).reshape(hd)
    xw = shift_mix(hn, mu_wag[0])
    xa = shift_mix(hn, mu_wag[1])
    xg = shift_mix(hn, mu_wag[2])
    w = -jax.nn.softplus(-(w0 + jnp.tanh(xw @ w1) @ w2).astype(f32)) - 0.5
    decay = jnp.exp(-jnp.exp(w)).reshape(hd)
    iclr = jax.nn.sigmoid((a0 + (xa @ a1) @ a2).astype(f32)).reshape(hd)
    gate = (jax.nn.sigmoid(xg @ g1) @ g2).astype(f32)
    kk = k * k_k.astype(f32).reshape(H, N)
    kk = kk / jnp.maximum(jnp.sqrt(jnp.sum(kk * kk, axis=-1, keepdims=True)), 1e-12)
    k = k * (1.0 + (iclr - 1.0) * k_a.astype(f32).reshape(H, N))

    def step(state, inp):
        r_t, w_t, k_t, v_t, a_t, b_t = inp
        sa = jnp.einsum('bhvk,bhk->bhv', state, a_t)
        state = (state * w_t[:, :, None, :] + sa[..., None] * b_t[:, :, None, :]
                 + v_t[..., None] * k_t[:, :, None, :])
        return state, jnp.einsum('bhvk,bhk->bhv', state, r_t)

    seq_first = lambda z: jnp.moveaxis(z, 1, 0)
    xs = (seq_first(r), seq_first(decay), seq_first(k), seq_first(v),
          seq_first(-kk), seq_first(kk * iclr))
    state0 = jnp.zeros((b, H, N, N), f32)
    _, y = lax.scan(step, state0, xs)
    y = jnp.moveaxis(y, 0, 1)
    mu = jnp.mean(y, axis=-1, keepdims=True)
    var = jnp.mean(jnp.square(y - mu), axis=-1, keepdims=True)
    y = ((y - mu) * lax.rsqrt(var + LNX_EPS) * lnx_g.astype(f32).reshape(H, N)
         + lnx_b.astype(f32).reshape(H, N))
    y = y + jnp.sum(r * k * r_k.astype(f32), axis=-1, keepdims=True) * v
    return (y.reshape(b, s, RWKV_WIDTH) * gate).astype(hn.dtype)


def clamped_swiglu(hid):
    x_glu, x_lin = hid[..., ::2], hid[..., 1::2]
    x_glu = jnp.minimum(x_glu, SWIGLU_LIMIT)
    x_lin = jnp.clip(x_lin, -SWIGLU_LIMIT, SWIGLU_LIMIT)
    return x_glu * jax.nn.sigmoid(SWIGLU_ALPHA * x_glu) * (x_lin + 1.0)


def moe_ffn(h, router_w, router_b, w1, b1, w2, b2):
    b, s, d = h.shape
    t = b * s
    hf = h.reshape(t, d)
    logits = (hf @ router_w + router_b).astype(jnp.float32)
    top_val, top_idx = lax.top_k(logits, TOP_K)
    gates = jax.nn.softmax(top_val, axis=-1)
    n_assign = t * TOP_K
    e_flat = top_idx.reshape(-1).astype(jnp.int32)
    tok_flat = (jnp.arange(n_assign, dtype=jnp.int32) // TOP_K)
    gate_flat = gates.reshape(-1)
    order = jnp.argsort(e_flat)
    e_sorted = e_flat[order]
    counts = jnp.bincount(e_flat, length=N_EXPERTS).astype(jnp.int32)
    padded = (counts + MOE_BLOCK - 1) // MOE_BLOCK * MOE_BLOCK
    start = jnp.cumsum(counts) - counts
    pad_end = jnp.cumsum(padded)
    pad_start = pad_end - padded
    dest = pad_start[e_sorted] + jnp.arange(n_assign, dtype=jnp.int32) - start[e_sorted]
    n_blocks = -(-n_assign // MOE_BLOCK) + N_EXPERTS
    n_rows = n_blocks * MOE_BLOCK
    row_tok = jnp.full((n_rows,), t, jnp.int32).at[dest].set(tok_flat[order])
    row_gate = jnp.zeros((n_rows,), jnp.float32).at[dest].set(gate_flat[order])
    block_start = jnp.arange(n_blocks, dtype=jnp.int32) * MOE_BLOCK
    block_expert = jnp.minimum(jnp.searchsorted(pad_end, block_start, side='right'),
                               N_EXPERTS - 1).astype(jnp.int32)
    hpad = jnp.concatenate([hf, jnp.zeros((1, d), hf.dtype)], axis=0)
    xin = hpad[row_tok].reshape(n_blocks, MOE_BLOCK, d)

    def expert_block(args):
        xb, e = args
        hid = xb @ w1[e] + b1[e]
        return clamped_swiglu(hid) @ w2[e] + b2[e]

    yout = lax.map(expert_block, (xin, block_expert)).reshape(n_rows, d)
    y = jnp.zeros((t + 1, d), jnp.float32).at[row_tok].add(
        yout.astype(jnp.float32) * row_gate[:, None])
    return y[:t].reshape(b, s, d).astype(h.dtype)


def setup_inputs(seed: int = 0) -> dict:
    key = jax.random.key(seed)
    ks = iter(jax.random.split(key, 40))
    L, D = DEPTH, D_MODEL
    nrm = lambda shape, scale: jax.random.normal(next(ks), shape, jnp.float32) * scale
    gain = lambda shape: 1.0 + nrm(shape, 0.05)
    uni = lambda shape, lo, hi: jax.random.uniform(next(ks), shape, jnp.float32, lo, hi)
    return {
        "x": nrm((BATCH, SEQ, D), 1.0),
        "norm1_g": gain((L, D)),
        "w_in": nrm((L, D, IN_WIDTH), D ** -0.5),
        "sgu_ln_g": gain((L, SGU_WIDTH)),
        "sgu_ln_b": nrm((L, SGU_WIDTH), 0.05),
        "sgu_w": nrm((L, SGU_HEADS, SGU_BLOCK, SGU_BLOCK), SGU_BLOCK ** -0.5),
        "sgu_b": 1.0 + nrm((L, SGU_HEADS, SGU_BLOCK), 0.1),
        "mu_rkv": uni((L, 3, RWKV_WIDTH), 0.0, 1.0),
        "mu_wag": uni((L, 3, D), 0.0, 1.0),
        "decay_w0": uni((L, RWKV_WIDTH), -5.5, 1.0),
        "decay_w1": nrm((L, D, DECAY_LORA), D ** -0.5),
        "decay_w2": nrm((L, DECAY_LORA, RWKV_WIDTH), 0.5 * DECAY_LORA ** -0.5),
        "iclr_a0": nrm((L, RWKV_WIDTH), 0.1),
        "iclr_a1": nrm((L, D, ICLR_LORA), D ** -0.5),
        "iclr_a2": nrm((L, ICLR_LORA, RWKV_WIDTH), ICLR_LORA ** -0.5),
        "gate_g1": nrm((L, D, GATE_LORA), D ** -0.5),
        "gate_g2": nrm((L, GATE_LORA, RWKV_WIDTH), GATE_LORA ** -0.5),
        "k_k": 0.85 + nrm((L, RWKV_WIDTH), 0.05),
        "k_a": gain((L, RWKV_WIDTH)),
        "r_k": nrm((L, RWKV_HEADS, RWKV_HEAD_DIM), 0.1),
        "lnx_g": gain((L, RWKV_WIDTH)),
        "lnx_b": nrm((L, RWKV_WIDTH), 0.05),
        "w_out": nrm((L, MIX_WIDTH, D), MIX_WIDTH ** -0.5),
        "norm2_g": gain((L, D)),
        "router_w": nrm((L, D, N_EXPERTS), D ** -0.5),
        "router_b": nrm((L, N_EXPERTS), 0.01),
        "moe_w1": nrm((L, N_EXPERTS, D, 2 * D_EXPERT), D ** -0.5),
        "moe_b1": nrm((L, N_EXPERTS, 2 * D_EXPERT), 0.01),
        "moe_w2": nrm((L, N_EXPERTS, D_EXPERT, D), D_EXPERT ** -0.5),
        "moe_b2": nrm((L, N_EXPERTS, D), 0.01),
        "final_g": gain((D,)),
    }


def reference(x, norm1_g, w_in, sgu_ln_g, sgu_ln_b, sgu_w, sgu_b, mu_rkv, mu_wag,
              decay_w0, decay_w1, decay_w2, iclr_a0, iclr_a1, iclr_a2, gate_g1, gate_g2,
              k_k, k_a, r_k, lnx_g, lnx_b, w_out, norm2_g, router_w, router_b,
              moe_w1, moe_b1, moe_w2, moe_b2, final_g):
    split_at = [2 * SGU_WIDTH, 2 * SGU_WIDTH + RWKV_WIDTH, 2 * SGU_WIDTH + 2 * RWKV_WIDTH]
    h = x
    for l in range(DEPTH):
        hn = rms_norm(h, norm1_g[l])
        proj = hn @ w_in[l]
        z_a, p_r, p_k, p_v = jnp.split(proj, split_at, axis=-1)
        y_a = spatial_gating(jax.nn.gelu(z_a, approximate=False),
                             sgu_ln_g[l], sgu_ln_b[l], sgu_w[l], sgu_b[l])
        y_b = rwkv7_time_mix(hn, p_r, p_k, p_v, mu_rkv[l], mu_wag[l],
                             decay_w0[l], decay_w1[l], decay_w2[l],
                             iclr_a0[l], iclr_a1[l], iclr_a2[l], gate_g1[l], gate_g2[l],
                             k_k[l], k_a[l], r_k[l], lnx_g[l], lnx_b[l])
        h = h + jnp.concatenate([y_a, y_b], axis=-1) @ w_out[l]
        h = h + moe_ffn(rms_norm(h, norm2_g[l]), router_w[l], router_b[l],
                        moe_w1[l], moe_b1[l], moe_w2[l], moe_b2[l])
    return rms_norm(h, final_g)
```

```cpp
#include <hip/hip_runtime.h>
#include <cstdio>
#include <cstdint>
#include <cstring>

#ifndef MK_N_LAUNCHES
#define MK_N_LAUNCHES 1
#endif
constexpr int N_PHASES = 10;
#ifndef PROBE_MASK
#define PROBE_MASK 0
#endif
#define REP(k) for (int rep_ = 0; rep_ < (((PROBE_MASK >> (k)) & 1) ? 2 : 1); ++rep_)

#define LAS __attribute__((address_space(3)))
#define GAS __attribute__((address_space(1)))
typedef unsigned short bf16_t;
typedef short bf16x8 __attribute__((ext_vector_type(8)));
typedef float f32x4 __attribute__((ext_vector_type(4)));
typedef float f32x2 __attribute__((ext_vector_type(2)));
typedef float f32x16 __attribute__((ext_vector_type(16)));
typedef unsigned u32x4 __attribute__((ext_vector_type(4)));
typedef unsigned u32x2 __attribute__((ext_vector_type(2)));
typedef GAS unsigned gu32;
#define RLX_AGENT __ATOMIC_RELAXED, __HIP_MEMORY_SCOPE_AGENT
#define LDS_WAIT() asm volatile("s_waitcnt lgkmcnt(0)" ::: "memory")
#define VM_WAIT() asm volatile("s_waitcnt vmcnt(0)" ::: "memory")
#define WG_BAR() do { asm volatile("s_waitcnt vmcnt(0) lgkmcnt(0)" ::: "memory"); __builtin_amdgcn_s_barrier(); asm volatile("" ::: "memory"); } while (0)

constexpr int BATCH = 2, SEQ = 8192, D = 1024, M = BATCH * SEQ;
constexpr int NPROJ = 3072;
constexpr int COL_V = 512, COL_R = 1024, COL_K = 1536, COL_VR = 2048, COL_LA = 2560, COL_LB = 2816;
constexpr int NEXP = 32, TOPK = 4, DEXP = 1024, NHID = 2048;
constexpr int NASSIGN = M * TOPK;
constexpr int MAXROWS = NASSIGN + NEXP * 256;
constexpr int RT_TOK = 32, NRT = M / RT_TOK;
constexpr int CH = 64, NCHUNK = SEQ / CH, SEGC = 8, NSEG = NCHUNK / SEGC;
constexpr int NRU = BATCH * 8 * NSEG;

constexpr size_t MiB = 1u << 20;
constexpr size_t WS_CTL = 0, CTL_ZERO_BYTES = 13824;
constexpr size_t WS_WCAT = 2 * MiB;
constexpr size_t WS_WOUT = 8 * MiB;
constexpr size_t WS_SMALL = 10 * MiB;
constexpr size_t WS_LW2 = WS_SMALL;
constexpr size_t WS_LA2 = WS_LW2 + 512 * 64 * 2;
constexpr size_t WS_LG2 = WS_LA2 + 512 * 64 * 2;
constexpr size_t WS_SGUW = WS_LG2 + 512 * 128 * 2;
constexpr size_t WS_RW = WS_SGUW + 8 * 128 * 128 * 2;
constexpr size_t WS_ETAB = WS_RW + 1024 * 32 * 4;
constexpr size_t WS_CNT = WS_ETAB + 1024;
constexpr size_t WS_RIDX = WS_CNT + NRT * 32 * 4;
constexpr size_t WS_RGATE = WS_RIDX + (size_t)M * 4 * 4;
constexpr size_t WS_RRANK = WS_RGATE + (size_t)M * 4 * 4;
constexpr size_t WS_TDEST = WS_RRANK + (size_t)M * 4 * 4;
static_assert(WS_TDEST + (size_t)M * 4 * 4 <= 12 * MiB, "small region");
constexpr size_t WS_ROWTOK = 12 * MiB;
constexpr size_t WS_ROWGATE = 13 * MiB;
constexpr size_t WS_SEGP = 14 * MiB;
constexpr size_t WS_SEGQ = 16 * MiB;
constexpr size_t WS_XN = 32 * MiB;
constexpr size_t WS_YCAT = 64 * MiB;
constexpr size_t WS_HN2 = 96 * MiB;
constexpr size_t WS_H1 = 128 * MiB;
constexpr size_t WS_PROJ = 192 * MiB;
constexpr size_t WS_W1T = 288 * MiB;
constexpr size_t WS_W2T = 416 * MiB;
constexpr size_t WS_ACT = 480 * MiB;
constexpr size_t WS_YOUT = 624 * MiB;
constexpr size_t WS_RK = 768 * MiB;
constexpr size_t WS_PHIT = WS_RK, WS_PSI = WS_RK + 8192, WS_YS = WS_RK + 16384, WS_YL = WS_RK + 24576, WS_GT = WS_RK + 32768, WS_BV = WS_RK + 40960;
constexpr size_t WS_END = 864 * MiB;
constexpr int CW_BAR = 0;

constexpr int RING_BYTES = 131072;
constexpr int TAB_OFF = 151552;
constexpr int TEXP_OFF = TAB_OFF + 2048;
constexpr int LDS_BYTES = 155648;
constexpr int MISC_OFF = LDS_BYTES - 256;

typedef __bf16 bf16v2_t __attribute__((ext_vector_type(2)));
__device__ __forceinline__ unsigned pk2(float lo, float hi) { const f32x2 v = {lo, hi}; return __builtin_bit_cast(unsigned, __builtin_convertvector(v, bf16v2_t)); }
__device__ __forceinline__ unsigned f2bf(float f) { return pk2(f, 0.f) & 0xffffu; }
__device__ __forceinline__ float bf2f(unsigned short b) { return __builtin_bit_cast(float, (unsigned)b << 16); }
__device__ __forceinline__ float bflo(unsigned w) { return __builtin_bit_cast(float, w << 16); }
__device__ __forceinline__ float bfhi(unsigned w) { return __builtin_bit_cast(float, w & 0xffff0000u); }
__device__ __forceinline__ void unpack8(const u32x4 w, float (&o)[8]) { o[0] = bflo(w.x); o[1] = bfhi(w.x); o[2] = bflo(w.y); o[3] = bfhi(w.y); o[4] = bflo(w.z); o[5] = bfhi(w.z); o[6] = bflo(w.w); o[7] = bfhi(w.w); }
__device__ __forceinline__ u32x4 pack8(const float (&v)[8]) { u32x4 w; w.x = pk2(v[0], v[1]); w.y = pk2(v[2], v[3]); w.z = pk2(v[4], v[5]); w.w = pk2(v[6], v[7]); return w; }
__device__ __forceinline__ float fsigmoid(float x) { return __builtin_amdgcn_rcpf(1.0f + __expf(-x)); }
__device__ __forceinline__ unsigned pk4_fp8(float a, float b, float c, float d) {
    a = fminf(fmaxf(a, -448.f), 448.f); b = fminf(fmaxf(b, -448.f), 448.f); c = fminf(fmaxf(c, -448.f), 448.f); d = fminf(fmaxf(d, -448.f), 448.f);
    unsigned w = 0u; w = __builtin_amdgcn_cvt_pk_fp8_f32(a, b, w, false); w = __builtin_amdgcn_cvt_pk_fp8_f32(c, d, w, true); return w; }
constexpr float FP8_SW = 64.0f;
constexpr float FP8_SA = 4.0f;
constexpr float FP8_SY = 16.0f;
__device__ __forceinline__ float wave_sum(float v) {
#pragma unroll
    for (int o = 1; o < 64; o <<= 1) v += __shfl_xor(v, o);
    return v;
}

namespace pg8 {
constexpr int BM = 256, BK = 64, HALF = 128, HTB = HALF * BK * 2, STAGE_BYTES = 8 * HTB, NXCD = 8, WGM = 8;
__host__ __device__ __forceinline__ int lds_byte(int r, int c) { const int st = (r >> 4) * 2 + (c >> 5), rr = r & 15, cc = c & 31, ob = rr * 64 + cc * 2; return st * 1024 + (ob ^ (((ob >> 9) & 1) << 5)); }
__host__ __device__ __forceinline__ void stage_rc(int b, int& R, int& C) { const int st = b / 1024, sb = b % 1024, swz = sb ^ (((sb >> 9) & 1) << 5); R = (st >> 1) * 16 + swz / 64; C = (st & 1) * 32 + (swz % 64) / 2; }
__host__ __device__ __forceinline__ int perm32(int rho) { const int n = rho >> 4, i = rho & 15; return 8 * (i >> 2) + 4 * n + (i & 3); }

struct Unit { int pm, pn; };
struct Gemm { const bf16_t* A; const bf16_t* Bt; int M, N, K; };

struct StaticOrder {
    int nM, nN, nwg, G, c, K;
    __device__ void init(int M_, int N_, int K_, int G_, int c_) { nM = M_ / BM; nN = N_ / BM; nwg = nM * nN; G = G_; c = c_; K = K_ * 2; }
    __device__ bool next(int i, Unit& u) const {
        const long L = (long)i * G + c; if (L >= nwg) return false;
        int wgid = (int)L; { const int q = nwg / NXCD, r = nwg % NXCD, xcd = wgid % NXCD, off = wgid / NXCD; wgid = (xcd < r ? xcd * (q + 1) : r * (q + 1) + (xcd - r) * q) + off; }
        const int nig = WGM * nN, gid = wgid / nig, fm = gid * WGM, gsz = (nM - fm) < WGM ? (nM - fm) : WGM;
        u.pm = fm + ((wgid % nig) % gsz); u.pn = (wgid % nig) / gsz; return true;
    }
    __device__ __forceinline__ size_t a_off(const Unit& u) const { return (size_t)u.pm * BM * K; }
    __device__ __forceinline__ size_t b_off(const Unit& u) const { return (size_t)u.pn * BM * K; }
    __device__ __forceinline__ const int* rows(const Unit&) const { return nullptr; }
};
struct MoeOrder {
    int ntiles, nN, G, c, K, N; const int* pad_start; const int* rowtok; const LAS unsigned char* texp;
    __device__ __forceinline__ int expert_of(int pm) const { return (int)texp[pm]; }
    __device__ __forceinline__ void build_texp(LAS unsigned char* lds) { LAS unsigned char* t = lds + TEXP_OFF;
        for (int pm = (int)threadIdx.x; pm < MAXROWS / BM; pm += 512) { const int r0 = pm * BM; int e = 0;
            for (int j = 1; j < NEXP; ++j) if (pad_start[j] <= r0) e = j;
            t[pm] = (unsigned char)e; }
        texp = t; WG_BAR(); }
    __device__ bool next(int i, Unit& u) const { const long L = (long)i * G + c; if (L >= (long)ntiles * nN) return false; u.pm = (int)(L / nN); u.pn = (int)(L % nN); return true; }
    __device__ __forceinline__ size_t a_off(const Unit& u) const { return (size_t)u.pm * BM * K; }
    __device__ __forceinline__ size_t b_off(const Unit& u) const { return ((size_t)expert_of(u.pm) * N + (size_t)u.pn * BM) * K; }
    __device__ __forceinline__ const int* rows(const Unit& u) const { return rowtok + u.pm * BM; }
};

__device__ __forceinline__ unsigned cvt_pk_bf16(float lo, float hi) { unsigned r; asm volatile("v_cvt_pk_bf16_f32 %0, %1, %2" : "=v"(r) : "v"(lo), "v"(hi)); return r; }
__device__ __forceinline__ f32x2 gelu_pk(f32x2 v) {
    const f32x2 av = __builtin_elementwise_abs(v), d = av * 0.2316418882f + 1.0f;
    f32x2 t; t.x = __builtin_amdgcn_rcpf(d.x); t.y = __builtin_amdgcn_rcpf(d.y);
    f32x2 q = t * 0.5307027145f + (-0.7265760135f); q = q * t + 0.7107068705f; q = q * t + (-0.142248368f); q = q * t + 0.127414796f; q = q * t;
    const f32x2 s = (v * v) * (-0.72134752044f);
    f32x2 e; e.x = __builtin_amdgcn_exp2f(s.x); e.y = __builtin_amdgcn_exp2f(s.y);
    const f32x2 m = v * (q * e), r = v - m;
    f32x2 o; o.x = v.x < 0.f ? m.x : r.x; o.y = v.y < 0.f ? m.y : r.y; return o;
}
struct EpiProj {
    static constexpr bool PERM = true;
    bf16_t* O; int ldc; int ngelu;
    __device__ __forceinline__ void operator()(const f32x4 (&acc)[2][2][4][2], const Unit& u, int wr, int wc, int fr, int fq) const {
        const int row0 = u.pm * BM + wr * 64 + fr, col0 = u.pn * BM + wc * 32 + 8 * fq; const bool act = u.pn < ngelu;
#pragma unroll
        for (int ai = 0; ai < 2; ++ai)
#pragma unroll
            for (int m = 0; m < 4; ++m) { bf16_t* rowp = O + (size_t)(row0 + ai * HALF + m * 16) * ldc + col0;
#pragma unroll
                for (int bj = 0; bj < 2; ++bj) { f32x4 v0 = acc[ai][bj][m][0], v1 = acc[ai][bj][m][1];
                    if (act) { f32x2 a = gelu_pk((f32x2){v0[0], v0[1]}), b = gelu_pk((f32x2){v0[2], v0[3]}), c = gelu_pk((f32x2){v1[0], v1[1]}), d = gelu_pk((f32x2){v1[2], v1[3]});
                        v0 = (f32x4){a.x, a.y, b.x, b.y}; v1 = (f32x4){c.x, c.y, d.x, d.y}; }
                    u32x4 w; w.x = cvt_pk_bf16(v0[0], v0[1]); w.y = cvt_pk_bf16(v0[2], v0[3]); w.z = cvt_pk_bf16(v1[0], v1[1]); w.w = cvt_pk_bf16(v1[2], v1[3]);
                    *(u32x4*)(rowp + bj * HALF) = w; } }
    }
};
struct EpiResF32 {
    static constexpr bool PERM = false;
    const float* base; float* out; int ldc;
    __device__ __forceinline__ void operator()(const f32x4 (&acc)[2][2][4][2], const Unit& u, int wr, int wc, int fr, int fq) const {
        const int col0 = u.pn * BM + wc * 32 + 4 * fq;
#pragma unroll
        for (int ai = 0; ai < 2; ++ai)
#pragma unroll
            for (int m = 0; m < 4; ++m) { const size_t off = (size_t)(u.pm * BM + ai * HALF + wr * 64 + m * 16 + fr) * ldc + col0;
#pragma unroll
                for (int bj = 0; bj < 2; ++bj)
#pragma unroll
                    for (int n = 0; n < 2; ++n) { const f32x4 bs = *(const f32x4*)(base + off + bj * HALF + n * 16); *(f32x4*)(out + off + bj * HALF + n * 16) = bs + acc[ai][bj][m][n]; } }
    }
};
struct EpiSwiglu {
    static constexpr bool PERM = true;
    unsigned char* O; const float* b1; const MoeOrder* S;
    __device__ __forceinline__ void operator()(const f32x4 (&acc)[2][2][4][2], const Unit& u, int wr, int wc, int fr, int fq) const {
        const int e = S->expert_of(u.pm); const int row0 = u.pm * BM + wr * 64 + fr, oc0 = u.pn * HALF + wc * 32 + 8 * fq;
        const float* bp = b1 + (size_t)e * NHID + 2 * oc0;
        f32x4 bg[2], bl[2];
#pragma unroll
        for (int n = 0; n < 2; ++n) { const f32x4 x0 = *(const f32x4*)(bp + 8 * n), x1 = *(const f32x4*)(bp + 8 * n + 4); bg[n] = (f32x4){x0[0], x0[2], x1[0], x1[2]}; bl[n] = (f32x4){x0[1], x0[3], x1[1], x1[3]}; }
#pragma unroll
        for (int ai = 0; ai < 2; ++ai)
#pragma unroll
            for (int m = 0; m < 4; ++m) { unsigned char* rowp = O + (size_t)(row0 + ai * HALF + m * 16) * DEXP + oc0; float o[8];
#pragma unroll
                for (int n = 0; n < 2; ++n) { const f32x4 g = acc[ai][0][m][n] * (1.0f / FP8_SW) + bg[n], l = acc[ai][1][m][n] * (1.0f / FP8_SW) + bl[n];
#pragma unroll
                    for (int q = 0; q < 4; ++q) { const float gg = fminf(g[q], 7.0f), ll = fminf(fmaxf(l[q], -7.0f), 7.0f); o[4 * n + q] = gg * fsigmoid(1.702f * gg) * (ll + 1.0f) * FP8_SA; } }
                u32x2 w; w.x = pk4_fp8(o[0], o[1], o[2], o[3]); w.y = pk4_fp8(o[4], o[5], o[6], o[7]);
                *(u32x2*)rowp = w; }
    }
};
struct EpiGate {
    static constexpr bool PERM = true;
    unsigned char* O; const float* b2; const float* rowgate; const MoeOrder* S;
    __device__ __forceinline__ void operator()(const f32x4 (&acc)[2][2][4][2], const Unit& u, int wr, int wc, int fr, int fq) const {
        const int e = S->expert_of(u.pm); const int row0 = u.pm * BM + wr * 64 + fr, col0 = u.pn * BM + wc * 32 + 8 * fq;
        f32x4 bv[2][2];
#pragma unroll
        for (int bj = 0; bj < 2; ++bj)
#pragma unroll
            for (int n = 0; n < 2; ++n) bv[bj][n] = *(const f32x4*)(b2 + (size_t)e * D + col0 + bj * HALF + 4 * n);
#pragma unroll
        for (int ai = 0; ai < 2; ++ai)
#pragma unroll
            for (int m = 0; m < 4; ++m) { const int row = row0 + ai * HALF + m * 16; const float gt = rowgate[row] * FP8_SY; unsigned char* rowp = O + (size_t)row * D + col0;
#pragma unroll
                for (int bj = 0; bj < 2; ++bj) { const f32x4 v0 = (acc[ai][bj][m][0] * (1.0f / (FP8_SW * FP8_SA)) + bv[bj][0]) * gt, v1 = (acc[ai][bj][m][1] * (1.0f / (FP8_SW * FP8_SA)) + bv[bj][1]) * gt;
                    u32x2 w; w.x = pk4_fp8(v0[0], v0[1], v0[2], v0[3]); w.y = pk4_fp8(v1[0], v1[1], v1[2], v1[3]);
                    *(u32x2*)(rowp + bj * HALF) = w; } }
    }
};

typedef int v8i32 __attribute__((ext_vector_type(8)));
template <class Epi, class Sched, bool GATHER, bool FP8 = false>
__device__ __forceinline__ void gemm_phase(LAS unsigned char* lds, const Gemm g, const Sched& S, const Epi& E) {
    const int tid = threadIdx.x, wid = __builtin_amdgcn_readfirstlane(tid >> 6), lane = tid & 63, wr = wid >> 2, wc = wid & 3, fr = lane & 15, fq = lane >> 4;
    const int K = FP8 ? g.K : g.K * 2  , nt = K / (BK * 2);
    unsigned voffA[2], voffB[2]; int rA[2];
#pragma unroll
    for (int i = 0; i < 2; ++i) { int R, C; stage_rc(tid * 16 + i * 8192, R, C); const int Rb = Epi::PERM ? ((R & ~31) + perm32(R & 31)) : R;
        voffA[i] = GATHER ? (unsigned)(C * 2) : (unsigned)(R * K + C * 2); voffB[i] = (unsigned)(Rb * K + C * 2); rA[i] = R; }
    const size_t kstep = (size_t)(BK * 2);
    const size_t hstep = (size_t)HALF * K;
    const unsigned ldsw = (unsigned)wid * 1024u;
    const int aoff0 = FP8 ? lds_byte(wr * 64 + fr, 16 * fq) : lds_byte(wr * 64 + fr, fq * 8), aoff1 = FP8 ? lds_byte(wr * 64 + fr, 16 * fq + 8) : aoff0 + 1024;
    const int boff0 = FP8 ? lds_byte(wc * 32 + fr, 16 * fq) : lds_byte(wc * 32 + fr, fq * 8), boff1 = FP8 ? lds_byte(wc * 32 + fr, 16 * fq + 8) : boff0 + 1024;
    LAS unsigned* tab = (LAS unsigned*)(lds + TAB_OFF);
#define PG8_SA(b, h) (((b) * 2 + (h)) * HTB)
#define PG8_SB(b, h) ((4 + (b) * 2 + (h)) * HTB)
#define PG8_STAGE(bufoff, gbase, voff) do { _Pragma("unroll") for (int _i = 0; _i < 2; ++_i) \
        __builtin_amdgcn_global_load_lds((const unsigned*)((const char*)(gbase) + (voff)[_i]), (LAS unsigned*)(lds + (bufoff) + ldsw + _i * 8192), 16, 0, 0); } while (0)
#define PG8_STAGE_A(bufoff, gbase, h, sl) do { if constexpr (GATHER) { _Pragma("unroll") for (int _i = 0; _i < 2; ++_i) { const unsigned _ro = tab[(sl) * 256 + (h) * 128 + rA[_i]]; \
        __builtin_amdgcn_global_load_lds((const unsigned*)((const char*)(gbase) + _ro + voffA[_i]), (LAS unsigned*)(lds + (bufoff) + ldsw + _i * 8192), 16, 0, 0); } } \
        else { PG8_STAGE(bufoff, (const char*)(gbase) + (h) * hstep, voffA); } } while (0)
#define PG8_LDA(dst, b, h) do { _Pragma("unroll") for (int m = 0; m < 4; ++m) { dst[m][0] = *(const LAS bf16x8*)(lds + PG8_SA(b, h) + aoff0 + m * 2048); dst[m][1] = *(const LAS bf16x8*)(lds + PG8_SA(b, h) + aoff1 + m * 2048); } } while (0)
#define PG8_LDB(dst, b, h) do { _Pragma("unroll") for (int n = 0; n < 2; ++n) { dst[n][0] = *(const LAS bf16x8*)(lds + PG8_SB(b, h) + boff0 + n * 2048); dst[n][1] = *(const LAS bf16x8*)(lds + PG8_SB(b, h) + boff1 + n * 2048); } } while (0)
#define PG8_CAT(x) __builtin_bit_cast(v8i32, __builtin_shufflevector((x)[0], (x)[1], 0, 1, 2, 3, 4, 5, 6, 7, 8, 9, 10, 11, 12, 13, 14, 15))
#define PG8_MMA(ai, bj, At, Bt) do { __builtin_amdgcn_s_setprio(1); _Pragma("unroll") for (int m = 0; m < 4; ++m) _Pragma("unroll") for (int n = 0; n < 2; ++n) { \
        if constexpr (FP8) acc[ai][bj][m][n] = __builtin_amdgcn_mfma_scale_f32_16x16x128_f8f6f4(PG8_CAT(Bt[n]), PG8_CAT(At[m]), acc[ai][bj][m][n], 0, 0, 0, 0x7f7f7f7f, 0, 0x7f7f7f7f); \
        else { _Pragma("unroll") for (int k = 0; k < 2; ++k) acc[ai][bj][m][n] = __builtin_amdgcn_mfma_f32_16x16x32_bf16(Bt[n][k], At[m][k], acc[ai][bj][m][n], 0, 0, 0); } } \
        __builtin_amdgcn_s_setprio(0); \
        if constexpr (FP8) { _Pragma("unroll") for (int m = 0; m < 4; ++m) asm volatile("" : "+v"(acc[ai][bj][m][0]), "+v"(acc[ai][bj][m][1])); } } while (0)
#define PG8_WAIT_V(n) asm volatile("s_waitcnt vmcnt(" #n ")" ::: "memory")
#define PG8_WAIT_L(n) asm volatile("s_waitcnt lgkmcnt(" #n ")" ::: "memory")
#define PG8_BAR __builtin_amdgcn_s_barrier()
#define PG8_SCHED __builtin_amdgcn_sched_barrier(0)
#define PG8_SCHF do { if constexpr (FP8) __builtin_amdgcn_sched_barrier(0); } while (0)
    Unit cur, nxt; int ui = 0;
    if (!S.next(0, cur)) return;
    f32x4 acc[2][2][4][2];
#pragma unroll
    for (int a = 0; a < 2; ++a)
#pragma unroll
        for (int b = 0; b < 2; ++b)
#pragma unroll
            for (int m = 0; m < 4; ++m)
#pragma unroll
                for (int n = 0; n < 2; ++n) acc[a][b][m][n] = (f32x4){0.f, 0.f, 0.f, 0.f};
    bf16x8 At[4][2], B0[2][2], B1[2][2];
    const char* cA = (const char*)g.A + (GATHER ? (size_t)0 : S.a_off(cur)); const char* cB = (const char*)g.Bt + S.b_off(cur);
    if constexpr (GATHER) {
        if (tid < 256) tab[tid] = (unsigned)S.rows(cur)[tid] * (unsigned)K;
        WG_BAR();
    }
    PG8_STAGE(PG8_SB(0, 0), cB, voffB); PG8_STAGE(PG8_SB(0, 1), cB + hstep, voffB); PG8_STAGE_A(PG8_SA(0, 0), cA, 0, 0); PG8_STAGE_A(PG8_SA(0, 1), cA, 1, 0);
    if (wr == 1) PG8_BAR;
    PG8_WAIT_V(2); PG8_BAR;
    PG8_STAGE(PG8_SB(1, 0), cB + kstep, voffB); PG8_STAGE_A(PG8_SA(1, 0), cA + kstep, 0, 0); PG8_STAGE(PG8_SB(1, 1), cB + hstep + kstep, voffB);
    PG8_WAIT_V(6); PG8_BAR;
    for (;;) {
        const bool has_next = S.next(ui + 1, nxt);
        const int sc = ui & 1, sn = has_next ? ((ui + 1) & 1) : sc;
        if constexpr (GATHER) { if (has_next && tid < 256) tab[sn * 256 + tid] = (unsigned)S.rows(nxt)[tid] * (unsigned)K; }
        const char* nA = has_next ? (const char*)g.A + (GATHER ? (size_t)0 : S.a_off(nxt)) : cA; const char* nB = has_next ? (const char*)g.Bt + S.b_off(nxt) : cB;
        for (int t = 0; t < nt; t += 2) {
            const bool last = (t == nt - 2);
            const char* a1 = cA + (size_t)(t + 1) * kstep;
            const char* a2 = last ? nA : cA + (size_t)(t + 2) * kstep; const char* b2 = last ? nB : cB + (size_t)(t + 2) * kstep;
            const char* a3 = a2 + kstep; const char* b3 = b2 + kstep;
            const int s2 = last ? sn : sc;
            PG8_LDB(B0, 0, 0); PG8_LDB(B1, 0, 1); PG8_SCHED; PG8_LDA(At, 0, 0); PG8_STAGE_A(PG8_SA(1, 1), a1, 1, sc);
            PG8_WAIT_V(8); PG8_WAIT_L(0); PG8_BAR; PG8_SCHF; PG8_MMA(0, 0, At, B0); PG8_MMA(0, 1, At, B1); PG8_BAR; PG8_SCHED;
            PG8_LDA(At, 0, 1); PG8_STAGE(PG8_SB(0, 0), b2, voffB); PG8_STAGE(PG8_SB(0, 1), b2 + hstep, voffB); PG8_STAGE_A(PG8_SA(0, 0), a2, 0, s2);
            PG8_WAIT_V(8); PG8_WAIT_L(0); PG8_BAR; PG8_SCHF; PG8_MMA(1, 0, At, B0); PG8_MMA(1, 1, At, B1); PG8_BAR; PG8_SCHED;
            PG8_LDB(B0, 1, 0); PG8_LDB(B1, 1, 1); PG8_SCHED; PG8_LDA(At, 1, 0); PG8_STAGE_A(PG8_SA(0, 1), a2, 1, s2);
            PG8_WAIT_V(8); PG8_WAIT_L(0); PG8_BAR; PG8_SCHF; PG8_MMA(0, 0, At, B0); PG8_MMA(0, 1, At, B1); PG8_BAR; PG8_SCHED;
            PG8_LDA(At, 1, 1); PG8_STAGE(PG8_SB(1, 0), b3, voffB); PG8_STAGE(PG8_SB(1, 1), b3 + hstep, voffB); PG8_STAGE_A(PG8_SA(1, 0), a3, 0, s2);
            PG8_WAIT_V(8); PG8_WAIT_L(0); PG8_BAR; PG8_SCHF; PG8_MMA(1, 0, At, B0); PG8_MMA(1, 1, At, B1); PG8_BAR; PG8_SCHED;
        }
        if (wr == 0) PG8_BAR;
        E(acc, cur, wr, wc, fr, fq);
        if (!has_next) break;
#pragma unroll
        for (int a = 0; a < 2; ++a)
#pragma unroll
            for (int b = 0; b < 2; ++b)
#pragma unroll
                for (int m = 0; m < 4; ++m)
#pragma unroll
                    for (int n = 0; n < 2; ++n) acc[a][b][m][n] = (f32x4){0.f, 0.f, 0.f, 0.f};
        cur = nxt; cA = nA; cB = nB; ++ui;
        if (wr == 1) PG8_BAR;
    }
    PG8_WAIT_V(0);
    PG8_BAR;
#undef PG8_SA
#undef PG8_SB
#undef PG8_STAGE
#undef PG8_STAGE_A
#undef PG8_LDA
#undef PG8_LDB
#undef PG8_MMA
#undef PG8_CAT
#undef PG8_WAIT_V
#undef PG8_WAIT_L
#undef PG8_BAR
#undef PG8_SCHED
#undef PG8_SCHF
}
}

#define XB_TMO      128
#define XB_XCNT(j)  (256  + 64 * (j))
#define XB_XSUB(j)  (1280 + 64 * (j))
#define XB_XGEN(j)  (2304 + 64 * (j))
#define XB_TOP      3328
#define XB_TOPGEN   3392
#define XCD_BAR_WORDS 3456
#define XB_SPIN_CAP (1u << 18)
__device__ __forceinline__ unsigned xb_ld(unsigned* p)              { return __hip_atomic_load(p, __ATOMIC_RELAXED, __HIP_MEMORY_SCOPE_AGENT); }
__device__ __forceinline__ unsigned xb_add(unsigned* p, unsigned v) { return __hip_atomic_fetch_add(p, v, __ATOMIC_RELAXED, __HIP_MEMORY_SCOPE_AGENT); }
__device__ __forceinline__ unsigned xb_xcc_id() { return (unsigned)__builtin_amdgcn_s_getreg((3 << 11) | 20) & 0xFu; }
#define XB_SPIN(cond, bar) do { unsigned _sp = 0; while (cond) { __builtin_amdgcn_s_sleep(1); \
    if ((++_sp & 255u) == 0u) { if (xb_ld(&(bar)[XB_TMO])) break; if (_sp > XB_SPIN_CAP) { atomicAdd(&(bar)[XB_TMO], 1u); break; } } } } while (0)
struct XcdBarrier { unsigned* bar; unsigned x; volatile LAS unsigned* st; };
__device__ __forceinline__ XcdBarrier xcd_barrier_post(unsigned* bar, volatile LAS unsigned* st) {
    XcdBarrier b; b.bar = bar; b.x = xb_xcc_id(); b.st = st;
    if (threadIdx.x == 0) (void)xb_add(&bar[XB_XCNT(b.x)], 1u);
    return b;
}
__device__ __forceinline__ void xcd_barrier_complete(unsigned* bar, unsigned x, unsigned& nloc, unsigned& nx) {
    const unsigned G = gridDim.x * gridDim.y * gridDim.z;
    unsigned sum, cnt, mine, sp = 0u;
    for (;;) {
        sum = 0u; cnt = 0u; mine = 0u;
#pragma unroll
        for (unsigned j = 0; j < 16; ++j) { const unsigned c = xb_ld(&bar[XB_XCNT(j)]); sum += c; cnt += (c > 0u) ? 1u : 0u; mine = (j == x) ? c : mine; }
        if (sum == G) break;
        __builtin_amdgcn_s_sleep(1);
        if ((++sp & 255u) == 0u) { if (xb_ld(&bar[XB_TMO])) break; if (sp > XB_SPIN_CAP) { atomicAdd(&bar[XB_TMO], 1u); break; } }
    }
    nloc = mine > 0u ? mine : 1u; nx = cnt > 0u ? cnt : 1u;
}
__device__ __forceinline__ void xcd_barrier(const XcdBarrier& b) {
    asm volatile("s_waitcnt vmcnt(0)" ::: "memory");
    __syncthreads();
    if (threadIdx.x == 0) {
        unsigned* bar = b.bar;
        __builtin_amdgcn_s_waitcnt(0);
        unsigned nloc = b.st[0], nx = b.st[1];
        if (nloc == 0u) { xcd_barrier_complete(bar, b.x, nloc, nx); b.st[0] = nloc; b.st[1] = nx; }
        const unsigned old = xb_add(&bar[XB_XSUB(b.x)], 1u);
        const unsigned gen = old / nloc;
        if (old + 1u == (gen + 1u) * nloc) {
            __builtin_amdgcn_fence(__ATOMIC_RELEASE, "agent");
            asm volatile("s_waitcnt vmcnt(0)" ::: "memory");
            const unsigned og = xb_add(&bar[XB_TOP], 1u);
            const unsigned tg = og / nx;
            if (og + 1u == (tg + 1u) * nx) xb_add(&bar[XB_TOPGEN], 1u);
            else XB_SPIN(xb_ld(&bar[XB_TOPGEN]) == tg, bar);
            __builtin_amdgcn_fence(__ATOMIC_ACQUIRE, "agent");
            xb_add(&bar[XB_XGEN(b.x)], 1u);
            asm volatile("s_waitcnt vmcnt(0)" ::: "memory");
        } else {
            XB_SPIN(xb_ld(&bar[XB_XGEN(b.x)]) == gen, bar);
            __builtin_amdgcn_fence(__ATOMIC_ACQUIRE, "agent");
            asm volatile("s_waitcnt vmcnt(0)" ::: "memory");
        }
    }
    __syncthreads();
}

struct Args {
    const float* in[31]; float* out; unsigned char* ws;
    int ph_lo, ph_hi, li, pad;
};
enum { I_X = 0, I_N1G, I_WIN, I_SLNG, I_SLNB, I_SGUW, I_SGUB, I_MURKV, I_MUWAG, I_W0, I_W1, I_W2, I_A0, I_A1, I_A2, I_G1, I_G2, I_KK, I_KA, I_RK, I_LNXG, I_LNXB, I_WOUT, I_N2G, I_RW, I_RB,
       I_MW1, I_MB1, I_MW2, I_MB2, I_FG };

struct Ctx { LAS unsigned char* lds; int tid, lane, wave, G, vcu; unsigned char* ws; const float* const* in; };

template <int KS> __device__ __forceinline__ void mma_nt(f32x4& acc, const LAS bf16_t* X, int ldx, const LAS bf16_t* Y, int ldy, int lane) {
    const LAS bf16_t* xp = X + (lane & 15) * ldx + 8 * (lane >> 4); const LAS bf16_t* yp = Y + (lane & 15) * ldy + 8 * (lane >> 4);
#pragma unroll
    for (int ks = 0; ks < KS; ++ks) { const bf16x8 a = *(const LAS bf16x8*)(xp + 32 * ks), b = *(const LAS bf16x8*)(yp + 32 * ks); acc = __builtin_amdgcn_mfma_f32_16x16x32_bf16(a, b, acc, 0, 0, 0); }
}
template <int KS> __device__ __forceinline__ void mma_nt_gx(f32x4& acc, const bf16_t* X, int ldx, const LAS bf16_t* Y, int ldy, int lane) {
    const bf16_t* xp = X + (size_t)(lane & 15) * ldx + 8 * (lane >> 4); const LAS bf16_t* yp = Y + (lane & 15) * ldy + 8 * (lane >> 4);
#pragma unroll
    for (int ks = 0; ks < KS; ++ks) { const bf16x8 a = *(const bf16x8*)(xp + 32 * ks), b = *(const LAS bf16x8*)(yp + 32 * ks); acc = __builtin_amdgcn_mfma_f32_16x16x32_bf16(a, b, acc, 0, 0, 0); }
}
__device__ __forceinline__ void st4bf(LAS bf16_t* p, const f32x4 v) { u32x2 w; w.x = pk2(v[0], v[1]); w.y = pk2(v[2], v[3]); *(LAS u32x2*)p = w; }

__device__ __forceinline__ void p0_transpose_item(const float* W, int N, bf16_t* WT, int ldo, int row_off, const float* sc, int mode, bool remap, LAS float* scr, int item, int lane) {
    const int nblk = N / 32, kb = item / nblk, nb = item % nblk, k0 = 64 * kb, n0 = 32 * nb;
#pragma unroll 8
    for (int i = 0; i < 32; ++i) { const int kk = 2 * i + (lane >> 5); float v = W[(size_t)(k0 + kk) * N + n0 + (lane & 31)];
        if (mode) { const float s = sc[k0 + kk]; v *= (mode == 1) ? s : (1.0f - s); }
        scr[kk * 33 + (lane & 31)] = v; }
    LDS_WAIT(); asm volatile("" ::: "memory");
    const int c = lane & 7;
#pragma unroll
    for (int j = 0; j < 4; ++j) { const int n = (lane >> 3) + 8 * j; const LAS float* s = scr + (8 * c) * 33 + n;
        u32x4 o; o.x = pk2(s[0 * 33], s[1 * 33]); o.y = pk2(s[2 * 33], s[3 * 33]); o.z = pk2(s[4 * 33], s[5 * 33]); o.w = pk2(s[6 * 33], s[7 * 33]);
        int orow = n0 + n; if (remap) { const int oc = orow >> 1; orow = 256 * (oc >> 7) + 128 * (orow & 1) + (oc & 127); }
        *(u32x4*)(WT + (size_t)(row_off + orow) * ldo + k0 + 8 * c) = o; }
    LDS_WAIT(); asm volatile("" ::: "memory");
}
__device__ __forceinline__ void p0_transpose_item_fp8(const float* W, int N, unsigned char* WT, int ldo, bool remap, LAS float* scr, int item, int lane) {
    const int nblk = N / 32, kb = item / nblk, nb = item % nblk, k0 = 64 * kb, n0 = 32 * nb;
    float tv[32];
#pragma unroll
    for (int i = 0; i < 32; ++i) tv[i] = W[(size_t)(k0 + 2 * i + (lane >> 5)) * N + n0 + (lane & 31)];
#pragma unroll
    for (int i = 0; i < 32; ++i) scr[(2 * i + (lane >> 5)) * 33 + (lane & 31)] = tv[i] * FP8_SW;
    LDS_WAIT(); asm volatile("" ::: "memory");
    const int c = lane & 3;
#pragma unroll
    for (int j = 0; j < 2; ++j) { const int n = (lane >> 2) + 16 * j; const LAS float* sp = scr + (16 * c) * 33 + n;
        u32x4 o; o.x = pk4_fp8(sp[0 * 33], sp[1 * 33], sp[2 * 33], sp[3 * 33]); o.y = pk4_fp8(sp[4 * 33], sp[5 * 33], sp[6 * 33], sp[7 * 33]);
        o.z = pk4_fp8(sp[8 * 33], sp[9 * 33], sp[10 * 33], sp[11 * 33]); o.w = pk4_fp8(sp[12 * 33], sp[13 * 33], sp[14 * 33], sp[15 * 33]);
        int orow = n0 + n; if (remap) { const int oc = orow >> 1; orow = 256 * (oc >> 7) + 128 * (orow & 1) + (oc & 127); }
        *(u32x4*)(WT + (size_t)orow * ldo + k0 + 16 * c) = o; }
    LDS_WAIT(); asm volatile("" ::: "memory");
}
__device__ __forceinline__ void moe_weight_phase(const Ctx& F) {
    LAS float* scr = (LAS float*)(F.lds + 4096 + F.wave * 16384);
    const int gw = F.vcu * 8 + F.wave, NGW = F.G * 8, lane = F.lane;
    unsigned char* ws = F.ws;
    constexpr int I_M1 = 16 * 64, I_M2 = 16 * 32;
    for (int it = gw; it < NEXP * (I_M1 + I_M2); it += NGW) {
        int r = it; const int e = r / (I_M1 + I_M2); r -= e * (I_M1 + I_M2);
        if (r < I_M1) p0_transpose_item_fp8(F.in[I_MW1] + (size_t)e * D * NHID, NHID, ws + WS_W1T + (size_t)e * NHID * D, D, true, scr, r, lane);
        else p0_transpose_item_fp8(F.in[I_MW2] + (size_t)e * DEXP * D, D, ws + WS_W2T + (size_t)e * D * DEXP, DEXP, false, scr, r - I_M1, lane);
    }
}
__device__ __forceinline__ void p0_prologue(const Ctx& F) {
    LAS float* scr = (LAS float*)(F.lds + F.wave * 16384);
    const int gw = F.vcu * 8 + F.wave, NGW = F.G * 8, lane = F.lane;
    unsigned char* ws = F.ws;
    bf16_t* WCAT = (bf16_t*)(ws + WS_WCAT);
    constexpr int I_WIN_N = 16 * 80, I_L64 = 16 * 2, I_L128 = 16 * 4, I_WO = 16 * 32, I_M1 = 16 * 64, I_M2 = 16 * 32, I_S64 = 1 * 16, I_S128 = 2 * 16;
    constexpr int N_SMALL = I_WIN_N + 4 * I_L64 + 2 * I_L128 + I_WO + 2 * I_S64 + I_S128;
    constexpr int NITEMS = N_SMALL;
    const float* mu_wag = F.in[I_MUWAG];
    for (int it = gw; it < NITEMS; it += NGW) {
        int r = it;
        if (r < I_WIN_N) { p0_transpose_item(F.in[I_WIN], 2560, WCAT, D, 0, nullptr, 0, false, scr, r, lane); continue; } r -= I_WIN_N;
        if (r < I_L64) { p0_transpose_item(F.in[I_W1], 64, WCAT, D, COL_LA + 0, mu_wag + 0 * D, 2, false, scr, r, lane); continue; } r -= I_L64;
        if (r < I_L64) { p0_transpose_item(F.in[I_W1], 64, WCAT, D, COL_LB + 0, mu_wag + 0 * D, 1, false, scr, r, lane); continue; } r -= I_L64;
        if (r < I_L64) { p0_transpose_item(F.in[I_A1], 64, WCAT, D, COL_LA + 64, mu_wag + 1 * D, 2, false, scr, r, lane); continue; } r -= I_L64;
        if (r < I_L64) { p0_transpose_item(F.in[I_A1], 64, WCAT, D, COL_LB + 64, mu_wag + 1 * D, 1, false, scr, r, lane); continue; } r -= I_L64;
        if (r < I_L128) { p0_transpose_item(F.in[I_G1], 128, WCAT, D, COL_LA + 128, mu_wag + 2 * D, 2, false, scr, r, lane); continue; } r -= I_L128;
        if (r < I_L128) { p0_transpose_item(F.in[I_G1], 128, WCAT, D, COL_LB + 128, mu_wag + 2 * D, 1, false, scr, r, lane); continue; } r -= I_L128;
        if (r < I_WO) { p0_transpose_item(F.in[I_WOUT], D, (bf16_t*)(ws + WS_WOUT), D, 0, nullptr, 0, false, scr, r, lane); continue; } r -= I_WO;
        if (r < I_S64) { p0_transpose_item(F.in[I_W2], 512, (bf16_t*)(ws + WS_LW2), 64, 0, nullptr, 0, false, scr, r, lane); continue; } r -= I_S64;
        if (r < I_S64) { p0_transpose_item(F.in[I_A2], 512, (bf16_t*)(ws + WS_LA2), 64, 0, nullptr, 0, false, scr, r, lane); continue; } r -= I_S64;
        p0_transpose_item(F.in[I_G2], 512, (bf16_t*)(ws + WS_LG2), 128, 0, nullptr, 0, false, scr, r, lane);
    }
    const int gt = F.vcu * 512 + F.tid, NGT = F.G * 512;
    { bf16_t* SW = (bf16_t*)(ws + WS_SGUW); const float* w = F.in[I_SGUW];
      for (int i = gt; i < 8 * 128 * 128; i += NGT) { const int qi = (i >> 7) & 127, kj = i & 127; SW[i] = (bf16_t)(((kj >> 6) <= (qi >> 6)) ? f2bf(w[i]) : 0u); } }
    { float* RW = (float*)(ws + WS_RW); const float* w = F.in[I_RW]; const float* g = F.in[I_N2G];
      for (int i = gt; i < D * NEXP; i += NGT) RW[i] = w[i] * g[i >> 5]; }
    { int* rt = (int*)(ws + WS_ROWTOK); float* rg = (float*)(ws + WS_ROWGATE);
      for (int i = gt; i < MAXROWS; i += NGT) { rt[i] = 0; rg[i] = 0.f; } }
    { const float* g1 = F.in[I_N1G]; f32x4 gv[4];
#pragma unroll
      for (int j = 0; j < 4; ++j) gv[j] = *((const f32x4*)g1 + lane + 64 * j);
      for (int m = gw; m < M; m += NGW) {
          const f32x4* xr = (const f32x4*)(F.in[I_X] + (size_t)m * D) + lane; f32x4 v[4]; float s = 0.f;
#pragma unroll
          for (int j = 0; j < 4; ++j) { v[j] = xr[64 * j]; s += (v[j].x * v[j].x + v[j].y * v[j].y) + (v[j].z * v[j].z + v[j].w * v[j].w); }
          const float rstd = __builtin_amdgcn_rsqf(wave_sum(s) * (1.0f / D) + 1e-5f);
          u32x2* o8 = (u32x2*)((bf16_t*)(ws + WS_XN) + (size_t)m * D) + lane;
#pragma unroll
          for (int j = 0; j < 4; ++j) { u32x2 w; w.x = pk2(v[j].x * rstd * gv[j].x, v[j].y * rstd * gv[j].y); w.y = pk2(v[j].z * rstd * gv[j].z, v[j].w * rstd * gv[j].w); o8[64 * j] = w; }
      } }
}

#define LB() do { asm volatile("s_waitcnt lgkmcnt(0)" ::: "memory"); __builtin_amdgcn_s_barrier(); asm volatile("" ::: "memory"); } while (0)
typedef short v4i16_t __attribute__((ext_vector_type(4)));
__device__ __forceinline__ bf16x8 tr_frag(const LAS bf16_t* base, int ld, int lane) {
    const LAS bf16_t* a = base + (8 * (lane >> 4) + ((lane & 15) >> 2)) * ld + 4 * (lane & 3);
    const v4i16_t lo = __builtin_amdgcn_ds_read_tr16_b64_v4i16((LAS v4i16_t*)a), hi = __builtin_amdgcn_ds_read_tr16_b64_v4i16((LAS v4i16_t*)(a + 4 * ld));
    return __builtin_shufflevector(lo, hi, 0, 1, 2, 3, 4, 5, 6, 7);
}
template <int KS> __device__ __forceinline__ void mma_tx(f32x4& acc, const LAS bf16_t* XR, int ldx, const LAS bf16_t* Y, int ldy, int lane) {
    const LAS bf16_t* yp = Y + (lane & 15) * ldy + 8 * (lane >> 4);
#pragma unroll
    for (int ks = 0; ks < KS; ++ks) { const bf16x8 a = tr_frag(XR + 32 * ks * ldx, ldx, lane), b = *(const LAS bf16x8*)(yp + 32 * ks); acc = __builtin_amdgcn_mfma_f32_16x16x32_bf16(a, b, acc, 0, 0, 0); }
}
template <int KS> __device__ __forceinline__ void mma_ty(f32x4& acc, const LAS bf16_t* X, int ldx, const LAS bf16_t* YR, int ldy, int lane) {
    const LAS bf16_t* xp = X + (lane & 15) * ldx + 8 * (lane >> 4);
#pragma unroll
    for (int ks = 0; ks < KS; ++ks) { const bf16x8 a = *(const LAS bf16x8*)(xp + 32 * ks), b = tr_frag(YR + 32 * ks * ldy, ldy, lane); acc = __builtin_amdgcn_mfma_f32_16x16x32_bf16(a, b, acc, 0, 0, 0); }
}
template <int KS> __device__ __forceinline__ void mma_rx(f32x4& acc, const bf16x8 (&xf)[KS], const LAS bf16_t* Y, int ldy, int lane) {
    const LAS bf16_t* yp = Y + (lane & 15) * ldy + 8 * (lane >> 4);
#pragma unroll
    for (int ks = 0; ks < KS; ++ks) { const bf16x8 b = *(const LAS bf16x8*)(yp + 32 * ks); acc = __builtin_amdgcn_mfma_f32_16x16x32_bf16(xf[ks], b, acc, 0, 0, 0); }
}

__device__ __forceinline__ void sgu_phase(const Ctx& F) {
    const int w = F.wave;
    const bf16_t* PROJ = (const bf16_t*)(F.ws + WS_PROJ); bf16_t* YCAT = (bf16_t*)(F.ws + WS_YCAT); const bf16_t* SW = (const bf16_t*)(F.ws + WS_SGUW);
    LAS bf16_t* vn = (LAS bf16_t*)F.lds;
    constexpr int LDV = 264;
    for (int unit = F.vcu; unit < 256; unit += F.G) {
        int tv_ = F.tid; asm volatile("" : "+v"(tv_)); const int lane = tv_ & 63;
        const int nb = unit >> 1, hh = unit & 1, m0 = nb * 128;
        float lg[8], lb[8];
#pragma unroll
        for (int q = 0; q < 8; ++q) { lg[q] = F.in[I_SLNG][lane * 8 + q]; lb[q] = F.in[I_SLNB][lane * 8 + q]; }
        const int hl = w >> 1, ih = w & 1, h = hh * 4 + hl;
        u32x4 raw[16];
#pragma unroll
        for (int rr = 0; rr < 16; ++rr) raw[rr] = *(const u32x4*)(PROJ + (size_t)(m0 + w * 16 + rr) * NPROJ + COL_V + lane * 8);
        bf16x8 bfr[4][4]; u32x2 ur[4][4]; float bsv[4];
#pragma unroll
        for (int ks = 0; ks < 4; ++ks)
#pragma unroll
            for (int it = 0; it < 4; ++it) bfr[ks][it] = *(const bf16x8*)(SW + (size_t)h * 16384 + (ih * 64 + it * 16 + (lane & 15)) * 128 + ks * 32 + 8 * (lane >> 4));
#pragma unroll
        for (int it = 0; it < 4; ++it) { const int i = ih * 64 + it * 16 + (lane & 15); bsv[it] = F.in[I_SGUB][h * 128 + i];
#pragma unroll
            for (int ct = 0; ct < 4; ++ct) ur[it][ct] = *(const u32x2*)(PROJ + (size_t)(m0 + i) * NPROJ + h * 64 + ct * 16 + 4 * (lane >> 4)); }
#pragma unroll
        for (int rr = 0; rr < 16; ++rr) {
            const int pos = w * 16 + rr; float v[8]; unpack8(raw[rr], v);
            float s = 0.f;
#pragma unroll
            for (int q = 0; q < 8; ++q) s += v[q];
            const float mean = wave_sum(s) * (1.0f / 512.0f); float qq = 0.f;
#pragma unroll
            for (int q = 0; q < 8; ++q) { v[q] -= mean; qq += v[q] * v[q]; }
            const float rstd = __builtin_amdgcn_rsqf(wave_sum(qq) * (1.0f / 512.0f) + 1e-5f);
            if ((lane >> 5) == hh) { float o[8];
#pragma unroll
                for (int q = 0; q < 8; ++q) o[q] = v[q] * rstd * lg[q] + lb[q];
                *(LAS u32x4*)(vn + pos * LDV + (lane & 31) * 8) = pack8(o); }
        }
        LB();
        f32x4 acc[4][4];
#pragma unroll
        for (int a = 0; a < 4; ++a)
#pragma unroll
            for (int b = 0; b < 4; ++b) acc[a][b] = (f32x4){0.f, 0.f, 0.f, 0.f};
#pragma unroll
        for (int ks = 0; ks < 4; ++ks) {
            bf16x8 af[4];
#pragma unroll
            for (int ct = 0; ct < 4; ++ct) af[ct] = tr_frag(vn + (32 * ks) * LDV + hl * 64 + ct * 16, LDV, lane);
#pragma unroll
            for (int ct = 0; ct < 4; ++ct)
#pragma unroll
                for (int it = 0; it < 4; ++it) acc[ct][it] = __builtin_amdgcn_mfma_f32_16x16x32_bf16(af[ct], bfr[ks][it], acc[ct][it], 0, 0, 0);
        }
#pragma unroll
        for (int it = 0; it < 4; ++it) { const int i = ih * 64 + it * 16 + (lane & 15); const float bs = bsv[it]; const size_t row = (size_t)(m0 + i);
#pragma unroll
            for (int ct = 0; ct < 4; ++ct) { const int c = h * 64 + ct * 16 + 4 * (lane >> 4); const u32x2 uu = ur[it][ct];
                const f32x4 a = acc[ct][it]; u32x2 o; o.x = pk2(bflo(uu.x) * (a[0] + bs), bfhi(uu.x) * (a[1] + bs)); o.y = pk2(bflo(uu.y) * (a[2] + bs), bfhi(uu.y) * (a[3] + bs));
                *(u32x2*)(YCAT + row * D + c) = o; } }
        LB();
    }
}

namespace rk {
constexpr int LD = 72, LDF = 68, LDG = 136, MBY = 64 * LD * 2;
constexpr int O_AT = 0, O_RT = MBY, O_BH = 2 * MBY, O_KH = 3 * MBY, O_V = 4 * MBY, O_TB = 5 * MBY, O_LAK = 6 * MBY, O_MRB = 7 * MBY, O_MRK = 8 * MBY,
              O_ST = 9 * MBY, O_XT = 11 * MBY, O_UT = 13 * MBY, O_WC = 15 * MBY, O_WT = O_WC + 512, O_PAR = O_WT + 2048, O_END = O_PAR + 2560;
static_assert(O_END <= MISC_OFF, "RWKV LDS map");
enum { P_MUR = 0, P_MUK, P_MUV, P_W0, P_A0, P_KK, P_KA, P_RK, P_LG, P_LB };
constexpr size_t CHB = 6 * 4096;
template <int KS> __device__ __forceinline__ void mma_txy(f32x4& acc, const LAS bf16_t* XR, int ldx, const LAS bf16_t* YR, int ldy, int lane) {
#pragma unroll
    for (int ks = 0; ks < KS; ++ks) { const bf16x8 a = tr_frag(XR + 32 * ks * ldx, ldx, lane), b = tr_frag(YR + 32 * ks * ldy, ldy, lane); acc = __builtin_amdgcn_mfma_f32_16x16x32_bf16(a, b, acc, 0, 0, 0); }
}
__device__ __forceinline__ void state_yfrags(const f32x4 (&acc)[4], bf16x8 (&yf)[2]) {
#pragma unroll
    for (int ks = 0; ks < 2; ++ks) { u32x4 wv; wv.x = pk2(acc[2 * ks][0], acc[2 * ks][1]); wv.y = pk2(acc[2 * ks][2], acc[2 * ks][3]); wv.z = pk2(acc[2 * ks + 1][0], acc[2 * ks + 1][1]); wv.w = pk2(acc[2 * ks + 1][2], acc[2 * ks + 1][3]);
        yf[ks] = __builtin_bit_cast(bf16x8, wv); }
}
__device__ __forceinline__ void load_xfrags(u32x2 (&xr)[4][2][2], const bf16_t* mt, int ldm, int lane) {
#pragma unroll
    for (int ct = 0; ct < 4; ++ct)
#pragma unroll
        for (int ks = 0; ks < 2; ++ks)
#pragma unroll
            for (int hf = 0; hf < 2; ++hf) xr[ct][ks][hf] = *(const u32x2*)(mt + (size_t)(16 * ct + (lane & 15)) * ldm + 32 * ks + 16 * hf + 4 * (lane >> 4));
}
__device__ __forceinline__ void load_xfrags_lds(u32x2 (&xr)[4][2][2], const LAS bf16_t* mt, int ldm, int lane) {
#pragma unroll
    for (int ct = 0; ct < 4; ++ct)
#pragma unroll
        for (int ks = 0; ks < 2; ++ks)
#pragma unroll
            for (int hf = 0; hf < 2; ++hf) xr[ct][ks][hf] = *(const LAS u32x2*)(mt + (16 * ct + (lane & 15)) * ldm + 32 * ks + 16 * hf + 4 * (lane >> 4));
}
__device__ __forceinline__ void state_step(f32x4 (&acc)[4], const u32x2 (&xr)[4][2][2]) {
    bf16x8 yf[2]; state_yfrags(acc, yf);
#pragma unroll
    for (int ct = 0; ct < 4; ++ct) { f32x4 d = (f32x4){0.f, 0.f, 0.f, 0.f};
#pragma unroll
        for (int ks = 0; ks < 2; ++ks) { u32x4 xw; xw.x = xr[ct][ks][0].x; xw.y = xr[ct][ks][0].y; xw.z = xr[ct][ks][1].x; xw.w = xr[ct][ks][1].y;
            d = __builtin_amdgcn_mfma_f32_16x16x32_bf16(__builtin_bit_cast(bf16x8, xw), yf[ks], d, 0, 0, 0); }
        acc[ct] = d; }
}
__device__ __forceinline__ f32x4 bf4(const u32x2 w) { return (f32x4){bflo(w.x), bfhi(w.x), bflo(w.y), bfhi(w.y)}; }
__device__ __forceinline__ int frag_off(int row, int col) { return (((row >> 4) * 64 + ((col >> 2) & 3) * 16 + (row & 15)) * 4 + (col >> 4)) * 4 + (col & 3); }
}

__device__ __forceinline__ void rwkv_prep_unit(const Ctx& F, int unit) {
    using namespace rk;
    const int w = F.wave;
    const int b = unit >> 7, h = (unit >> 4) & 7, seg = unit & 15;
    constexpr int NL = 4;
    LAS unsigned char* L = F.lds;
    LAS bf16_t *AT = (LAS bf16_t*)(L + O_AT), *RT = (LAS bf16_t*)(L + O_RT), *BH = (LAS bf16_t*)(L + O_BH), *KH = (LAS bf16_t*)(L + O_KH), *V = (LAS bf16_t*)(L + O_V), *TB = (LAS bf16_t*)(L + O_TB),
                *LAK = (LAS bf16_t*)(L + O_LAK), *MRB = (LAS bf16_t*)(L + O_MRB), *MRK = (LAS bf16_t*)(L + O_MRK), *ST = (LAS bf16_t*)(L + O_ST), *XT = (LAS bf16_t*)(L + O_XT), *UT = (LAS bf16_t*)(L + O_UT);
    LAS bf16_t *DECP = ST, *ICLP = ST + 64 * LD, *LW = XT, *LA = XT + 64 * LD, *BT = XT, *KT = XT + 64 * LD, *LG = UT, *AH = ST, *XL = ST + 64 * LD, *UL = XT, *PHL = UT, *PSL = UT + 64 * LD;
    LAS float *LF = (LAS float*)(L + O_ST), *TF = (LAS float*)(L + O_XT), *TMP = (LAS float*)(L + O_UT), *WC = (LAS float*)(L + O_WC), *WT = (LAS float*)(L + O_WT), *PAR = (LAS float*)(L + O_PAR);
    const bf16_t* PROJ = (const bf16_t*)(F.ws + WS_PROJ);
    bf16_t* SEGP = (bf16_t*)(F.ws + WS_SEGP); float* SEGQ = (float*)(F.ws + WS_SEGQ);
    bf16_t *PHIT = (bf16_t*)(F.ws + WS_PHIT), *PSI = (bf16_t*)(F.ws + WS_PSI), *YSG = (bf16_t*)(F.ws + WS_YS), *YLG = (bf16_t*)(F.ws + WS_YL), *GTG = (bf16_t*)(F.ws + WS_GT), *BVG = (bf16_t*)(F.ws + WS_BV);

    { int tid = F.tid; asm volatile("" : "+v"(tid));
      for (int i = tid; i < 640; i += 512) { const int pv = i >> 6, cc = h * 64 + (i & 63); const float* src;
          switch (pv) { case P_MUR: src = F.in[I_MURKV] + 0 * 512; break; case P_MUK: src = F.in[I_MURKV] + 1 * 512; break; case P_MUV: src = F.in[I_MURKV] + 2 * 512; break; case P_W0: src = F.in[I_W0]; break;
                        case P_A0: src = F.in[I_A0]; break; case P_KK: src = F.in[I_KK]; break; case P_KA: src = F.in[I_KA]; break; case P_RK: src = F.in[I_RK]; break; case P_LG: src = F.in[I_LNXG]; break; default: src = F.in[I_LNXB]; break; }
          PAR[i] = src[cc]; }
    }
    const bf16_t* LW2 = (const bf16_t*)(F.ws + WS_LW2); const bf16_t* LA2 = (const bf16_t*)(F.ws + WS_LA2); const bf16_t* LG2 = (const bf16_t*)(F.ws + WS_LG2);

    f32x4 acc[4];
#pragma unroll
    for (int ct = 0; ct < 4; ++ct) acc[ct] = (f32x4){0.f, 0.f, 0.f, 0.f};
    if (w < 4) { int tv0_ = F.tid; asm volatile("" : "+v"(tv0_)); const int lane = tv0_ & 63;
#pragma unroll
        for (int ct = 0; ct < 4; ++ct)
#pragma unroll
            for (int r = 0; r < 4; ++r) acc[ct][r] = (16 * ct + 4 * (lane >> 4) + r == 16 * w + (lane & 15)) ? 1.0f : 0.0f; }
    LB();

    u32x4 rw_c[3 + NL], rw_p[3 + NL];
    auto load_raw = [&](int c, int tv) {
        const int t = tv >> 3, c0 = (tv & 7) * 8, hc = h * 64 + c0; const int tq0 = (seg * SEGC + c) * CH;
        const bf16_t* rowc = PROJ + ((size_t)b * SEQ + tq0 + t) * NPROJ; const bool hasp = (tq0 + t) > 0; const bf16_t* rowp = hasp ? rowc - NPROJ : rowc;
        rw_c[0] = *(const u32x4*)(rowc + COL_R + hc); rw_c[1] = *(const u32x4*)(rowc + COL_K + hc); rw_c[2] = *(const u32x4*)(rowc + COL_VR + hc);
        rw_p[0] = *(const u32x4*)(rowp + COL_R + hc); rw_p[1] = *(const u32x4*)(rowp + COL_K + hc); rw_p[2] = *(const u32x4*)(rowp + COL_VR + hc);
#pragma unroll
        for (int q4 = 0; q4 < NL; ++q4) { rw_c[3 + q4] = *(const u32x4*)(rowc + COL_LA + q4 * 64 + c0); rw_p[3 + q4] = *(const u32x4*)(rowp + COL_LB + q4 * 64 + c0); }
    };
    bf16x8 fW[2], fA[2], fG[4];
    { int tvw_ = F.tid; asm volatile("" : "+v"(tvw_)); const int g_ = (tvw_ & 63) >> 4, ln_ = tvw_ & 15; const size_t row = (size_t)(h * 64 + (w & 3) * 16 + ln_);
#pragma unroll
      for (int ks = 0; ks < 2; ++ks) { fW[ks] = *(const bf16x8*)(LW2 + row * 64 + 32 * ks + 8 * g_); fA[ks] = *(const bf16x8*)(LA2 + row * 64 + 32 * ks + 8 * g_); }
#pragma unroll
      for (int ks = 0; ks < 4; ++ks) fG[ks] = *(const bf16x8*)(LG2 + row * 128 + 32 * ks + 8 * g_); }
    { int tv0_ = F.tid; asm volatile("" : "+v"(tv0_)); load_raw(0, tv0_); }

    for (int c = 0; c < SEGC; ++c) {
        int tv_ = F.tid; asm volatile("" : "+v"(tv_));
        const int lane = tv_ & 63, t = tv_ >> 3, cg = tv_ & 7, c0 = cg * 8, g = lane >> 4, ln = lane & 15;
        const size_t cu = (size_t)((b * 8 + h) * NCHUNK + seg * SEGC + c) * CHB;
        float r_[8], k_[8], v_[8], a_[8], b_[8], ld_[8], pf_[8];
        {
            float cv[8], pv[8];
            { const unsigned km = ((seg * SEGC + c) * CH + t) > 0 ? 0xffffffffu : 0u;
#pragma unroll
              for (int i = 0; i < 3 + NL; ++i) { rw_p[i].x &= km; rw_p[i].y &= km; rw_p[i].z &= km; rw_p[i].w &= km; } }
            unpack8(rw_c[0], cv); unpack8(rw_p[0], pv);
#pragma unroll
            for (int q = 0; q < 8; ++q) r_[q] = cv[q] + (pv[q] - cv[q]) * PAR[P_MUR * 64 + c0 + q];
            unpack8(rw_c[1], cv); unpack8(rw_p[1], pv);
#pragma unroll
            for (int q = 0; q < 8; ++q) k_[q] = cv[q] + (pv[q] - cv[q]) * PAR[P_MUK * 64 + c0 + q];
            unpack8(rw_c[2], cv); unpack8(rw_p[2], pv);
#pragma unroll
            for (int q = 0; q < 8; ++q) v_[q] = cv[q] + (pv[q] - cv[q]) * PAR[P_MUV * 64 + c0 + q];
#pragma unroll
            for (int q4 = 0; q4 < NL; ++q4) { float o[8];
                unpack8(rw_c[3 + q4], cv); unpack8(rw_p[3 + q4], pv);
#pragma unroll
                for (int q = 0; q < 8; ++q) { const float x = cv[q] + pv[q]; o[q] = (q4 == 0) ? (1.0f - 2.0f * __builtin_amdgcn_rcpf(1.0f + __expf(2.0f * x))) : (q4 == 1 ? x : fsigmoid(x)); }
                LAS bf16_t* dst = (q4 == 0) ? (LW + t * LD + c0) : (q4 == 1) ? (LA + t * LD + c0) : (LG + t * LDG + (q4 - 2) * 64 + c0);
                *(LAS u32x4*)dst = pack8(o);
            }
        }
        LB();
        {
            const int ct = w & 3, tp = (w >> 2) * 2;
#pragma unroll
            for (int j = 0; j < 2; ++j) { const int tt = tp + j; const int so = (tt * 16 + ln) * LD + ct * 16 + 4 * g;
                f32x4 d = (f32x4){0.f, 0.f, 0.f, 0.f}; mma_rx<2>(d, fW, LW + tt * 16 * LD, LD, lane); st4bf(DECP + so, d);
                d = (f32x4){0.f, 0.f, 0.f, 0.f}; mma_rx<2>(d, fA, LA + tt * 16 * LD, LD, lane); st4bf(ICLP + so, d);
                d = (f32x4){0.f, 0.f, 0.f, 0.f}; mma_rx<4>(d, fG, LG + tt * 16 * LDG, LDG, lane);
                u32x2 gw; gw.x = pk2(d[0], d[1]); gw.y = pk2(d[2], d[3]); *(u32x2*)(GTG + cu + frag_off(tt * 16 + ln, ct * 16 + 4 * g)) = gw; }
        }
        LB();
        {
            float dp[8], ip[8]; unpack8(*(const LAS u32x4*)(DECP + t * LD + c0), dp); unpack8(*(const LAS u32x4*)(ICLP + t * LD + c0), ip);
            float kk[8], ss = 0.f, bonus = 0.f;
#pragma unroll
            for (int q = 0; q < 8; ++q) {
                const float xw = dp[q] + PAR[P_W0 * 64 + c0 + q]; const float z = -xw;
                const float sp = fmaxf(z, 0.f) + __logf(1.0f + __expf(-fabsf(z)));
                const float wl = -sp - 0.5f; ld_[q] = -__expf(wl);
                ip[q] = fsigmoid(ip[q] + PAR[P_A0 * 64 + c0 + q]);
                kk[q] = k_[q] * PAR[P_KK * 64 + c0 + q]; ss += kk[q] * kk[q];
            }
            ss += __shfl_xor(ss, 1); ss += __shfl_xor(ss, 2); ss += __shfl_xor(ss, 4);
            const float inv = __builtin_amdgcn_rsqf(fmaxf(ss, 1e-24f));
#pragma unroll
            for (int q = 0; q < 8; ++q) { kk[q] *= inv; k_[q] = k_[q] * (1.0f + (ip[q] - 1.0f) * PAR[P_KA * 64 + c0 + q]); a_[q] = -kk[q]; b_[q] = kk[q] * ip[q];
                bonus += r_[q] * k_[q] * PAR[P_RK * 64 + c0 + q]; }
            bonus += __shfl_xor(bonus, 1); bonus += __shfl_xor(bonus, 2); bonus += __shfl_xor(bonus, 4);
            { float o[8];
#pragma unroll
              for (int q = 0; q < 8; ++q) o[q] = bonus * v_[q];
              const u32x4 pw = pack8(o); u32x2 lo_, hi_; lo_.x = pw.x; lo_.y = pw.y; hi_.x = pw.z; hi_.y = pw.w;
              *(u32x2*)(BVG + cu + frag_off(t, c0)) = lo_; *(u32x2*)(BVG + cu + frag_off(t, c0 + 4)) = hi_; }
#pragma unroll
            for (int q = 0; q < 8; ++q) { float x = ld_[q];
#pragma unroll
                for (int dsh = 8; dsh < 64; dsh <<= 1) { const float y = __shfl_up(x, dsh); x += (lane >= dsh) ? y : 0.f; }
                pf_[q] = x; }
            if ((lane >> 3) == 7) { *(LAS f32x4*)(WT + w * 64 + c0) = (f32x4){pf_[0], pf_[1], pf_[2], pf_[3]}; *(LAS f32x4*)(WT + w * 64 + c0 + 4) = (f32x4){pf_[4], pf_[5], pf_[6], pf_[7]}; }
        }
        LB();
        REP(16) {
        {
            float off[8], tot[8];
#pragma unroll
            for (int q = 0; q < 8; ++q) { off[q] = 0.f; tot[q] = 0.f; }
#pragma unroll
            for (int ww = 0; ww < 8; ++ww) { const f32x4 x0 = *(const LAS f32x4*)(WT + ww * 64 + c0), x1 = *(const LAS f32x4*)(WT + ww * 64 + c0 + 4); const float m = (ww < w) ? 1.0f : 0.0f;
#pragma unroll
                for (int q = 0; q < 4; ++q) { tot[q] += x0[q]; tot[q + 4] += x1[q]; off[q] += m * x0[q]; off[q + 4] += m * x1[q]; } }
            float o1[8], o2[8], o3[8], o4[8], o5[8], o6[8];
#pragma unroll
            for (int q = 0; q < 8; ++q) { const float cu_ = pf_[q] + off[q]; const float ec = __expf(cu_), en = __builtin_amdgcn_rcpf(ec), wc = __expf(tot[q]), er = wc * en;
                o1[q] = a_[q] * __expf(cu_ - ld_[q]); o2[q] = r_[q] * ec; o3[q] = b_[q] * en; o4[q] = k_[q] * en; o5[q] = b_[q] * er; o6[q] = k_[q] * er;
                if (t == 63) WC[c0 + q] = wc; }
            *(LAS u32x4*)(AT + t * LD + c0) = pack8(o1); *(LAS u32x4*)(RT + t * LD + c0) = pack8(o2); *(LAS u32x4*)(BT + t * LD + c0) = pack8(o3); *(LAS u32x4*)(KT + t * LD + c0) = pack8(o4);
            *(LAS u32x4*)(BH + t * LD + c0) = pack8(o5); *(LAS u32x4*)(KH + t * LD + c0) = pack8(o6); *(LAS u32x4*)(V + t * LD + c0) = pack8(v_);
        }
        LB();
        {
            const int tt = w & 3, ip0 = (w >> 2) * 2;
#pragma unroll
            for (int j = 0; j < 2; ++j) { const int it = ip0 + j; const int i0 = it * 16 + 4 * g, tq = tt * 16 + ln;
                f32x4 d0 = (f32x4){0.f, 0.f, 0.f, 0.f}, d1 = d0, d2 = d0, d3 = d0;
                if (it <= tt) {
                    mma_nt<2>(d0, BT + it * 16 * LD, LD, AT + tt * 16 * LD, LD, lane); mma_nt<2>(d1, KT + it * 16 * LD, LD, AT + tt * 16 * LD, LD, lane);
                    mma_nt<2>(d2, BT + it * 16 * LD, LD, RT + tt * 16 * LD, LD, lane); mma_nt<2>(d3, KT + it * 16 * LD, LD, RT + tt * 16 * LD, LD, lane);
                    if (it == tt) {
#pragma unroll
                        for (int r = 0; r < 4; ++r) { const int i = i0 + r; if (!(i < tq)) { d0[r] = 0.f; d1[r] = 0.f; } if (!(i <= tq)) { d2[r] = 0.f; d3[r] = 0.f; } } }
                }
                *(LAS f32x4*)(LF + tq * LDF + i0) = d0; st4bf(LAK + tq * LD + i0, d1); st4bf(MRB + tq * LD + i0, d2); st4bf(MRK + tq * LD + i0, d3); }
        }
        LB();
        }
        load_raw(c + 1 < SEGC ? c + 1 : c, tv_);
        REP(14) {
        if (w == 0) { const int bk = lane >> 4, j = lane & 15; float x[16];
            const LAS float* Lb = LF + (16 * bk) * LDF + 16 * bk; LAS float* Tb = TF + (16 * bk) * LDF + 16 * bk + j;
            f32x4 ra[4], rb[4];
#pragma unroll
            for (int q = 0; q < 4; ++q) ra[q] = *(const LAS f32x4*)(Lb + 1 * LDF + 4 * q);
            x[0] = (j == 0) ? 1.0f : 0.0f; Tb[0] = x[0];
#pragma unroll
            for (int tr = 1; tr < 16; ++tr) {
                f32x4 (&cur)[4] = (tr & 1) ? ra : rb; f32x4 (&nxt)[4] = (tr & 1) ? rb : ra;
                if (tr < 15) {
#pragma unroll
                    for (int q = 0; q < 4; ++q) nxt[q] = *(const LAS f32x4*)(Lb + (tr + 1) * LDF + 4 * q); }
                float s0 = (tr == j) ? 1.0f : 0.0f, s1 = 0.f;
#pragma unroll
                for (int i = 0; i < tr; ++i) { if (i & 1) s1 += cur[i >> 2][i & 3] * x[i]; else s0 += cur[i >> 2][i & 3] * x[i]; }
                x[tr] = s0 + s1; Tb[tr * LDF] = x[tr]; } }
        LB();
        if (w < 2) { const int p = w, lr = lane & 15, lk = lane >> 4; f32x4 d = (f32x4){0.f, 0.f, 0.f, 0.f};
#pragma unroll
            for (int ks = 0; ks < 4; ++ks) d = __builtin_amdgcn_mfma_f32_16x16x4f32(LF[(32 * p + 16 + lr) * LDF + 32 * p + 4 * ks + lk], TF[(32 * p + 4 * ks + lk) * LDF + 32 * p + lr], d, 0, 0, 0);
#pragma unroll
            for (int r = 0; r < 4; ++r) TMP[(32 * p + 16 + 4 * lk + r) * LDF + 32 * p + lr] = d[r];
            LDS_WAIT(); f32x4 e = (f32x4){0.f, 0.f, 0.f, 0.f};
#pragma unroll
            for (int ks = 0; ks < 4; ++ks) e = __builtin_amdgcn_mfma_f32_16x16x4f32(TF[(32 * p + 16 + lr) * LDF + 32 * p + 16 + 4 * ks + lk], TMP[(32 * p + 16 + 4 * ks + lk) * LDF + 32 * p + lr], e, 0, 0, 0);
#pragma unroll
            for (int r = 0; r < 4; ++r) TF[(32 * p + 16 + 4 * lk + r) * LDF + 32 * p + lr] = e[r]; }
        LB();
        if (w < 4) { const int ri = w >> 1, cj = w & 1, lr = lane & 15, lk = lane >> 4; f32x4 d = (f32x4){0.f, 0.f, 0.f, 0.f};
#pragma unroll
            for (int ks = 0; ks < 8; ++ks) { const int k = 4 * ks + lk; const float bb = ((k >> 4) >= cj) ? TF[k * LDF + 16 * cj + lr] : 0.0f;
                d = __builtin_amdgcn_mfma_f32_16x16x4f32(LF[(32 + 16 * ri + lr) * LDF + k], bb, d, 0, 0, 0); }
#pragma unroll
            for (int r = 0; r < 4; ++r) TMP[(32 + 16 * ri + 4 * lk + r) * LDF + 16 * cj + lr] = d[r]; }
        LB();
        if (w < 4) { const int ri = w >> 1, cj = w & 1, lr = lane & 15, lk = lane >> 4; f32x4 d = (f32x4){0.f, 0.f, 0.f, 0.f};
#pragma unroll
            for (int ks = 0; ks < 8; ++ks) { const int k = 4 * ks + lk; const float aa = (ri >= (k >> 4)) ? TF[(32 + 16 * ri + lr) * LDF + 32 + k] : 0.0f;
                d = __builtin_amdgcn_mfma_f32_16x16x4f32(aa, TMP[(32 + k) * LDF + 16 * cj + lr], d, 0, 0, 0); }
#pragma unroll
            for (int r = 0; r < 4; ++r) TF[(32 + 16 * ri + 4 * lk + r) * LDF + 16 * cj + lr] = d[r]; }
        LB();
        { float o[8];
#pragma unroll
          for (int q = 0; q < 8; ++q) { const int i = c0 + q; o[q] = ((i >> 4) <= (t >> 4)) ? TF[t * LDF + i] : 0.0f; }
          *(LAS u32x4*)(TB + t * LD + c0) = pack8(o); }
        LB();
        }
        const int tt = w & 3, pr = (w >> 2) * 2;
        REP(15) {
#pragma unroll
        for (int j = 0; j < 2; ++j) { const int mt = pr + j; const int so = (tt * 16 + ln) * LD + mt * 16 + 4 * g;
            f32x4 d = (f32x4){0.f, 0.f, 0.f, 0.f}; mma_tx<2>(d, AT + 16 * mt, LD, TB + tt * 16 * LD, LD, lane); st4bf(AH + so, d);
            d = (f32x4){0.f, 0.f, 0.f, 0.f}; mma_tx<2>(d, V + 16 * mt, LD, LAK + tt * 16 * LD, LD, lane); st4bf(XL + so, d); }
        LB();
#pragma unroll
        for (int j = 0; j < 2; ++j) { const int mt = pr + j; const int so = (tt * 16 + ln) * LD + mt * 16 + 4 * g;
            f32x4 d = (f32x4){0.f, 0.f, 0.f, 0.f}; mma_tx<2>(d, XL + 16 * mt, LD, TB + tt * 16 * LD, LD, lane); st4bf(UL + so, d);
            d = bf4(*(const LAS u32x2*)(RT + so)); mma_tx<2>(d, AH + 16 * mt, LD, MRB + tt * 16 * LD, LD, lane);
            { u32x2 o; o.x = pk2(d[0], d[1]); o.y = pk2(d[2], d[3]); *(u32x2*)(YSG + cu + frag_off(tt * 16 + ln, mt * 16 + 4 * g)) = o; }
            d = (f32x4){0.f, 0.f, 0.f, 0.f}; mma_txy<2>(d, AH + 16 * mt, LD, BH + 16 * tt, LD, lane);
            { const f32x4 wc4 = *(const LAS f32x4*)(WC + mt * 16 + 4 * g);
#pragma unroll
              for (int r = 0; r < 4; ++r) d[r] += (mt * 16 + 4 * g + r == tt * 16 + ln) ? wc4[r] : 0.0f;
              u32x2 o; o.x = pk2(d[0], d[1]); o.y = pk2(d[2], d[3]); *(LAS u32x2*)(PHL + so) = o; } }
        LB();
#pragma unroll
        for (int j = 0; j < 2; ++j) { const int mt = pr + j; const int so = (tt * 16 + ln) * LD + mt * 16 + 4 * g;
            f32x4 d = (f32x4){0.f, 0.f, 0.f, 0.f}; mma_txy<2>(d, BH + 16 * mt, LD, UL + 16 * tt, LD, lane); mma_txy<2>(d, KH + 16 * mt, LD, V + 16 * tt, LD, lane);
            { u32x2 o; o.x = pk2(d[0], d[1]); o.y = pk2(d[2], d[3]); *(LAS u32x2*)(PSL + so) = o; }
            d = (f32x4){0.f, 0.f, 0.f, 0.f}; mma_tx<2>(d, UL + 16 * mt, LD, MRB + tt * 16 * LD, LD, lane); mma_tx<2>(d, V + 16 * mt, LD, MRK + tt * 16 * LD, LD, lane);
            { u32x2 o; o.x = pk2(d[0], d[1]); o.y = pk2(d[2], d[3]); *(u32x2*)(YLG + cu + frag_off(tt * 16 + ln, mt * 16 + 4 * g)) = o; } }
        LB();
        }
        { u32x2 xr[4][2][2]; load_xfrags_lds(xr, PHL, LD, lane); state_step(acc, xr);
          if (w >= 4) {
#pragma unroll
              for (int ct = 0; ct < 4; ++ct) { acc[ct] += bf4(*(const LAS u32x2*)(PSL + (16 * (w - 4) + ln) * LD + 16 * ct + 4 * g));
                  u32x2 o; o.x = pk2(acc[ct][0], acc[ct][1]); o.y = pk2(acc[ct][2], acc[ct][3]); *(u32x2*)(PSI + cu + frag_off(16 * (w - 4) + ln, 16 * ct + 4 * g)) = o; }
          } else {
#pragma unroll
              for (int ct = 0; ct < 4; ++ct) { float v0 = acc[ct][0], v1 = acc[ct][1], v2 = acc[ct][2], v3 = acc[ct][3];
                  { const bool od = lane & 1; float t0 = od ? v0 : v1, t1 = od ? v2 : v3; t0 = __shfl_xor(t0, 1); t1 = __shfl_xor(t1, 1); if (od) { v0 = t0; v2 = t1; } else { v1 = t0; v3 = t1; } }
                  { const bool od = lane & 2; float t0 = od ? v0 : v2, t1 = od ? v1 : v3; t0 = __shfl_xor(t0, 2); t1 = __shfl_xor(t1, 2); if (od) { v0 = t0; v1 = t1; } else { v2 = t0; v3 = t1; } }
                  u32x2 o; o.x = pk2(v0, v1); o.y = pk2(v2, v3); *(u32x2*)(PHIT + cu + frag_off(16 * ct + 4 * g + (ln & 3), 16 * w + (ln & 12))) = o; } } }
        LB();
    }
    LB();
}

namespace rk {
struct FoldRegs { u32x2 x[4][2][2]; f32x4 q[4]; };
__device__ __forceinline__ void fold_load(FoldRegs& R, const bf16_t* RP, const bf16_t* RQ, int up, int rt, int lane) {
    const size_t cu = ((size_t)up * SEGC + (SEGC - 1)) * CHB;
#pragma unroll
    for (int ct = 0; ct < 4; ++ct)
#pragma unroll
        for (int ks = 0; ks < 2; ++ks) { const u32x4 v = *(const u32x4*)(RP + cu + (size_t)(ct * 64 + lane) * 16 + 8 * ks); R.x[ct][ks][0] = (u32x2){v.x, v.y}; R.x[ct][ks][1] = (u32x2){v.z, v.w}; }
#pragma unroll
    for (int ks = 0; ks < 2; ++ks) { const u32x4 v = *(const u32x4*)(RQ + cu + (size_t)(rt * 64 + lane) * 16 + 8 * ks); R.q[2 * ks] = bf4((u32x2){v.x, v.y}); R.q[2 * ks + 1] = bf4((u32x2){v.z, v.w}); }
}
__device__ __forceinline__ void fold_step(const FoldRegs& R, f32x4 (&acc)[4]) { state_step(acc, R.x);
#pragma unroll
    for (int ct = 0; ct < 4; ++ct) acc[ct] += R.q[ct]; }
}
__device__ __forceinline__ void rwkv_scan_unit(const Ctx& F, int unit) {
    using namespace rk;
    const int w = F.wave;
    const int b = unit >> 7, h = (unit >> 4) & 7, seg = unit & 15;
    int tv_ = F.tid; asm volatile("" : "+v"(tv_));
    const int lane = tv_ & 63, g = lane >> 4, ln = lane & 15;
    LAS bf16_t* ST = (LAS bf16_t*)F.lds;
    LAS float* PG = (LAS float*)(F.lds + MBY);
    const bf16_t *RP = (const bf16_t*)(F.ws + WS_PHIT), *RQ = (const bf16_t*)(F.ws + WS_PSI), *YSG = (const bf16_t*)(F.ws + WS_YS), *YLG = (const bf16_t*)(F.ws + WS_YL), *GTG = (const bf16_t*)(F.ws + WS_GT), *BVG = (const bf16_t*)(F.ws + WS_BV);
    bf16_t* YCAT = (bf16_t*)(F.ws + WS_YCAT);
    const bf16_t* SEGP = (const bf16_t*)(F.ws + WS_SEGP); const float* SEGQ = (const float*)(F.ws + WS_SEGQ);
    if (tv_ < 128) PG[tv_] = (tv_ < 64) ? F.in[I_LNXG][h * 64 + tv_] : F.in[I_LNXB][h * 64 + tv_ - 64];
    const int c = w;
    const size_t cu = (size_t)((b * 8 + h) * NCHUNK + seg * SEGC + c) * CHB, cp = c > 0 ? cu - CHB : cu;
    bf16x8 ptx[4][2]; u32x4 qv[4][2]; bf16x8 ysr[4][2];
#define SCAN_LOADS() do { \
_Pragma("unroll") \
    for (int ct = 0; ct < 4; ++ct) \
_Pragma("unroll") \
        for (int ks = 0; ks < 2; ++ks) { ptx[ct][ks] = *(const bf16x8*)(RP + cp + (size_t)(ct * 64 + lane) * 16 + 8 * ks); qv[ct][ks] = *(const u32x4*)(RQ + cp + (size_t)(ct * 64 + lane) * 16 + 8 * ks); \
            ysr[ct][ks] = *(const bf16x8*)(YSG + cu + (size_t)(ct * 64 + lane) * 16 + 8 * ks); } \
    } while (0)
    if (w < 4) SCAN_LOADS();
    if (w >= 4) {
        f32x4 acc[4];
#pragma unroll
        for (int ct = 0; ct < 4; ++ct) acc[ct] = (f32x4){0.f, 0.f, 0.f, 0.f};
        const int rt = w - 4, u0 = unit - seg; FoldRegs F0, F1, F2, F3;
        const int ul = unit > 0 ? unit - 1 : 0;
#define FLD(R, k) do { const int un_ = u0 + (k); fold_load(R, RP, RQ, un_ < ul ? un_ : ul, rt, lane); } while (0)
        FLD(F0, 0); FLD(F1, 1); FLD(F2, 2);
        for (int sp = 0; sp < seg; sp += 4) {
            FLD(F3, sp + 3); fold_step(F0, acc);
            FLD(F0, sp + 4); if (sp + 1 < seg) fold_step(F1, acc);
            FLD(F1, sp + 5); if (sp + 2 < seg) fold_step(F2, acc);
            FLD(F2, sp + 6); if (sp + 3 < seg) fold_step(F3, acc);
        }
#undef FLD
#pragma unroll
        for (int ct = 0; ct < 4; ++ct) st4bf(ST + (16 * rt + ln) * LD + 16 * ct + 4 * g, acc[ct]);
        SCAN_LOADS();
    }
#undef SCAN_LOADS
    LB();
    bf16x8 xs[4][2];
#pragma unroll
    for (int rt = 0; rt < 4; ++rt) {
        f32x4 sc[4];
        if (c > 0) {
            bf16x8 yf[2];
#pragma unroll
            for (int ks = 0; ks < 2; ++ks) { const u32x2 lo_ = *(const LAS u32x2*)(ST + (16 * rt + ln) * LD + 32 * ks + 4 * g), hi_ = *(const LAS u32x2*)(ST + (16 * rt + ln) * LD + 32 * ks + 16 + 4 * g);
                u32x4 wv; wv.x = lo_.x; wv.y = lo_.y; wv.z = hi_.x; wv.w = hi_.y; yf[ks] = __builtin_bit_cast(bf16x8, wv); }
#pragma unroll
            for (int ct = 0; ct < 4; ++ct) { u32x2 q2; if (ct & 1) { q2.x = qv[rt][ct >> 1].z; q2.y = qv[rt][ct >> 1].w; } else { q2.x = qv[rt][ct >> 1].x; q2.y = qv[rt][ct >> 1].y; } f32x4 d = bf4(q2);
#pragma unroll
                for (int ks = 0; ks < 2; ++ks) d = __builtin_amdgcn_mfma_f32_16x16x32_bf16(ptx[ct][ks], yf[ks], d, 0, 0, 0);
                sc[ct] = d; }
        } else {
#pragma unroll
            for (int ct = 0; ct < 4; ++ct) sc[ct] = bf4(*(const LAS u32x2*)(ST + (16 * rt + ln) * LD + 16 * ct + 4 * g));
        }
        state_yfrags(sc, xs[rt]);
    }
    const size_t orow0 = ((size_t)b * SEQ + (size_t)(seg * SEGC + c) * CH) * D + 512 + h * 64;
    u32x4 yl[4][2], gt[4][2], bv[4][2];
#pragma unroll
    for (int tt = 0; tt < 4; ++tt)
#pragma unroll
        for (int ks = 0; ks < 2; ++ks) { const size_t ro = cu + (size_t)(tt * 64 + lane) * 16 + 8 * ks; yl[tt][ks] = *(const u32x4*)(YLG + ro); gt[tt][ks] = *(const u32x4*)(GTG + ro); bv[tt][ks] = *(const u32x4*)(BVG + ro); }
#define H2(a, vt) (((vt) & 1) ? (u32x2){(a)[(vt) >> 1].z, (a)[(vt) >> 1].w} : (u32x2){(a)[(vt) >> 1].x, (a)[(vt) >> 1].y})
#pragma unroll
    for (int tt = 0; tt < 4; ++tt) {
        f32x4 y[4]; float s = 0.f;
#pragma unroll
        for (int vt = 0; vt < 4; ++vt) { f32x4 d = bf4(H2(yl[tt], vt));
#pragma unroll
            for (int ks = 0; ks < 2; ++ks) d = __builtin_amdgcn_mfma_f32_16x16x32_bf16(xs[vt][ks], ysr[tt][ks], d, 0, 0, 0);
            y[vt] = d; s += (d[0] + d[1]) + (d[2] + d[3]); }
        s += __shfl_xor(s, 16); s += __shfl_xor(s, 32);
        const float mean = s * (1.0f / 64.0f); float qq = 0.f;
#pragma unroll
        for (int vt = 0; vt < 4; ++vt) { y[vt] = y[vt] - mean; qq += (y[vt][0] * y[vt][0] + y[vt][1] * y[vt][1]) + (y[vt][2] * y[vt][2] + y[vt][3] * y[vt][3]); }
        qq += __shfl_xor(qq, 16); qq += __shfl_xor(qq, 32);
        const float rstd = __builtin_amdgcn_rsqf(qq * (1.0f / 64.0f) + 64e-5f);
        const size_t orow = orow0 + (size_t)(16 * tt + ln) * D;
#pragma unroll
        for (int vt = 0; vt < 4; ++vt) { const f32x4 lg4 = *(const LAS f32x4*)(PG + 16 * vt + 4 * g), lb4 = *(const LAS f32x4*)(PG + 64 + 16 * vt + 4 * g);
            const f32x4 o = (y[vt] * rstd * lg4 + lb4 + bf4(H2(bv[tt], vt))) * bf4(H2(gt[tt], vt)); u32x2 ow; ow.x = pk2(o[0], o[1]); ow.y = pk2(o[2], o[3]);
            *(u32x2*)(YCAT + orow + 16 * vt + 4 * g) = ow; }
    }
#undef H2
    LB();
}

__device__ __forceinline__ void router_phase(const Ctx& F) {
    const int tid = F.tid, lane = F.lane, w = F.wave;
    constexpr int LDX = 1028;
    LAS float* X = (LAS float*)F.lds;
    LAS float* RS = (LAS float*)(F.lds + 32 * LDX * 4);
    LAS float* LOG = RS + 32;
    LAS int* LCNT = (LAS int*)(LOG + 32 * 33);
    const float* H1 = (const float*)(F.ws + WS_H1); unsigned char* HN2 = F.ws + WS_HN2; const float* RW = (const float*)(F.ws + WS_RW);
    int* CNT = (int*)(F.ws + WS_CNT); int* RIDX = (int*)(F.ws + WS_RIDX); float* RGATE = (float*)(F.ws + WS_RGATE); int* RRANK = (int*)(F.ws + WS_RRANK);
    f32x4 gv[4];
#pragma unroll
    for (int j = 0; j < 4; ++j) gv[j] = *((const f32x4*)F.in[I_N2G] + lane + 64 * j);
    for (int tile = F.vcu; tile < NRT; tile += F.G) {
        f32x4 vr[4][4];
#pragma unroll
        for (int rr = 0; rr < 4; ++rr) { const f32x4* xr = (const f32x4*)(H1 + ((size_t)tile * RT_TOK + w * 4 + rr) * D) + lane;
#pragma unroll
            for (int j = 0; j < 4; ++j) vr[rr][j] = xr[64 * j]; }
#pragma unroll
        for (int rr = 0; rr < 4; ++rr) { const int row = w * 4 + rr; const size_t m = (size_t)tile * RT_TOK + row;
            f32x4 v[4]; float s = 0.f;
#pragma unroll
            for (int j = 0; j < 4; ++j) { v[j] = vr[rr][j]; s += (v[j].x * v[j].x + v[j].y * v[j].y) + (v[j].z * v[j].z + v[j].w * v[j].w); }
            const float rstd = __builtin_amdgcn_rsqf(wave_sum(s) * (1.0f / D) + 1e-5f);
            unsigned* o4 = (unsigned*)(HN2 + m * D) + lane;
#pragma unroll
            for (int j = 0; j < 4; ++j) { o4[64 * j] = pk4_fp8(v[j].x * rstd * gv[j].x, v[j].y * rstd * gv[j].y, v[j].z * rstd * gv[j].z, v[j].w * rstd * gv[j].w);
                *(LAS f32x4*)(X + row * LDX + 4 * (lane + 64 * j)) = v[j]; }
            if (lane == 0) RS[row] = rstd; }
        WG_BAR();
        f32x16 acc;
#pragma unroll
        for (int r = 0; r < 16; ++r) acc[r] = 0.f;
        { const int i = lane & 31, hh = lane >> 5;
#pragma unroll 4
          for (int kg = 0; kg < 16; ++kg) { const int kb = 128 * w + 8 * kg + 4 * hh; const f32x4 xa = *(const LAS f32x4*)(X + i * LDX + kb);
#pragma unroll
              for (int j = 0; j < 4; ++j) acc = __builtin_amdgcn_mfma_f32_32x32x2f32(xa[j], RW[(kb + j) * NEXP + i], acc, 0, 0, 0); } }
        WG_BAR();
#pragma unroll
        for (int r = 0; r < 16; ++r) { const int tok = (r & 3) + 8 * (r >> 2) + 4 * (lane >> 5); X[(w * 32 + tok) * 33 + (lane & 31)] = acc[r]; }
        WG_BAR();
#pragma unroll
        for (int q = 0; q < 2; ++q) { const int idx = tid + 512 * q, tok = idx >> 5, e = idx & 31; float s = 0.f;
#pragma unroll
            for (int ww = 0; ww < 8; ++ww) s += X[(ww * 32 + tok) * 33 + e];
            LOG[tok * 33 + e] = s * RS[tok] + F.in[I_RB][e]; }
        if (tid < 32) LCNT[tid] = 0;
        WG_BAR();
        {
            const int e = lane & 31;
#pragma unroll
            for (int it = 0; it < 2; ++it) { const int tok = w * 4 + 2 * it + (lane >> 5); float val = LOG[tok * 33 + e]; float tv[4]; int ti[4];
#pragma unroll
                for (int p = 0; p < 4; ++p) { float cand = val; int idx = e;
#pragma unroll
                    for (int d = 1; d < 32; d <<= 1) { const float ov = __shfl_xor(cand, d); const int oi = __shfl_xor(idx, d); const bool take = (ov > cand) || (ov == cand && oi < idx); cand = take ? ov : cand; idx = take ? oi : idx; }
                    tv[p] = cand; ti[p] = idx; if (e == idx) val = -3.0e38f; }
                float ex[4], es = 0.f;
#pragma unroll
                for (int p = 0; p < 4; ++p) { ex[p] = __expf(tv[p] - tv[0]); es += ex[p]; }
                const float inv = __builtin_amdgcn_rcpf(es); const size_t m = (size_t)tile * RT_TOK + tok;
#pragma unroll
                for (int p = 0; p < 4; ++p) if (e == ti[p]) { const int rk = atomicAdd((int*)(LCNT + e), 1); RIDX[m * 4 + p] = e; RGATE[m * 4 + p] = ex[p] * inv; RRANK[m * 4 + p] = rk; }
            }
        }
        WG_BAR();
        if (tid < 32) CNT[tile * 32 + tid] = LCNT[tid];
        WG_BAR();
    }
}

__device__ __forceinline__ void scatter_phase(const Ctx& F) {
    const int tid = F.tid;
    LAS int* PS = (LAS int*)F.lds;
    LAS int* PAD = PS + 512;
    LAS int* BASE = PAD + 64;
    const int* CNT = (const int*)(F.ws + WS_CNT); const int* RIDX = (const int*)(F.ws + WS_RIDX); const float* RGATE = (const float*)(F.ws + WS_RGATE); const int* RRANK = (const int*)(F.ws + WS_RRANK);
    int* TDEST = (int*)(F.ws + WS_TDEST); int* ROWTOK = (int*)(F.ws + WS_ROWTOK); float* ROWGATE = (float*)(F.ws + WS_ROWGATE); int* ETAB = (int*)(F.ws + WS_ETAB);
    { const int e = tid & 31, p = tid >> 5; int sm = 0;
#pragma unroll
      for (int j = 0; j < 32; ++j) sm += CNT[(32 * p + j) * 32 + e];
      PS[p * 32 + e] = sm; }
    WG_BAR();
    if (tid < 64) { const int e = tid & 31; int tot = 0;
#pragma unroll
        for (int p = 0; p < 16; ++p) tot += PS[p * 32 + e];
        const int padn = (tot + 255) & ~255; int inc = padn;
#pragma unroll
        for (int d = 1; d < 32; d <<= 1) { const int o = __shfl_up(inc, d, 32); inc += (e >= d) ? o : 0; }
        if (tid < 32) { PAD[e] = inc - padn; if (e == 31) PAD[32] = inc; } }
    WG_BAR();
    if (F.vcu == 0 && tid < 33) ETAB[tid] = PAD[tid];
    for (int tile = F.vcu; tile < NRT; tile += F.G) {
        if (tid < 32) { const int p = tile >> 5; int sm = PAD[tid];
#pragma unroll
            for (int pp = 0; pp < 16; ++pp) sm += (pp < p) ? PS[pp * 32 + tid] : 0;
#pragma unroll
            for (int j = 0; j < 32; ++j) { const int v = CNT[(32 * p + j) * 32 + tid]; sm += (32 * p + j < tile) ? v : 0; }
            BASE[tid] = sm; }
        WG_BAR();
        if (tid < 128) { const size_t ix = (size_t)tile * 128 + tid; const int e = RIDX[ix]; const int dest = BASE[e] + RRANK[ix];
            ROWTOK[dest] = (int)(ix >> 2); ROWGATE[dest] = RGATE[ix]; TDEST[ix] = dest; }
        WG_BAR();
    }
}

struct CombRows { f32x4 v[4]; unsigned y[4][4]; };
__device__ __forceinline__ void comb_load(CombRows& R, const float* H1, const unsigned char* YOUT, const int4 td, int m, int lane) {
    const f32x4* xr = (const f32x4*)(H1 + (size_t)m * D) + lane;
#pragma unroll
    for (int j = 0; j < 4; ++j) R.v[j] = xr[64 * j];
    const int dd[4] = {td.x, td.y, td.z, td.w};
#pragma unroll
    for (int p = 0; p < 4; ++p) { const unsigned* yr = (const unsigned*)(YOUT + (size_t)dd[p] * D) + lane;
#pragma unroll
        for (int j = 0; j < 4; ++j) R.y[p][j] = yr[64 * j]; }
}
__device__ __forceinline__ void comb_store(const CombRows& R, const f32x4 (&gv)[4], float* out, int m, int lane) {
    f32x4 v[4]; float s = 0.f;
#pragma unroll
    for (int j = 0; j < 4; ++j) { v[j] = R.v[j];
#pragma unroll
        for (int p = 0; p < 4; ++p) { const unsigned y = R.y[p][j]; const f32x2 lo = __builtin_amdgcn_cvt_pk_f32_fp8(y, false), hi = __builtin_amdgcn_cvt_pk_f32_fp8(y, true);
            v[j].x += lo.x * (1.0f / FP8_SY); v[j].y += lo.y * (1.0f / FP8_SY); v[j].z += hi.x * (1.0f / FP8_SY); v[j].w += hi.y * (1.0f / FP8_SY); }
        s += (v[j].x * v[j].x + v[j].y * v[j].y) + (v[j].z * v[j].z + v[j].w * v[j].w); }
    const float rstd = __builtin_amdgcn_rsqf(wave_sum(s) * (1.0f / D) + 1e-5f);
    f32x4* o = (f32x4*)(out + (size_t)m * D) + lane;
#pragma unroll
    for (int j = 0; j < 4; ++j) o[64 * j] = v[j] * rstd * gv[j];
}
__device__ __forceinline__ void combine_phase(const Ctx& F, float* out) {
    const int lane = F.lane; const int gw = F.vcu * 8 + F.wave, NGW = F.G * 8;
    const float* H1 = (const float*)(F.ws + WS_H1); const unsigned char* YOUT = F.ws + WS_YOUT; const int4* TDEST = (const int4*)(F.ws + WS_TDEST);
    f32x4 gv[4];
#pragma unroll
    for (int j = 0; j < 4; ++j) gv[j] = *((const f32x4*)F.in[I_FG] + lane + 64 * j);
    for (int m0 = gw; m0 < M; m0 += 8 * NGW) {
        int4 td[8];
#pragma unroll
        for (int i = 0; i < 8; ++i) { const int m = m0 + i * NGW; td[i] = TDEST[m < M ? m : M - 1]; }
        CombRows A, B;
        comb_load(A, H1, YOUT, td[0], m0, lane);
#pragma unroll
        for (int i = 0; i < 8; i += 2) {
            { const int m = m0 + (i + 1) * NGW; comb_load(B, H1, YOUT, td[i + 1], m < M ? m : M - 1, lane); }
            { const int m = m0 + i * NGW; if (m < M) comb_store(A, gv, out, m, lane); }
            if (i + 2 < 8) { const int m = m0 + (i + 2) * NGW; comb_load(A, H1, YOUT, td[i + 2], m < M ? m : M - 1, lane); }
            { const int m = m0 + (i + 1) * NGW; if (m < M) comb_store(B, gv, out, m, lane); }
        }
    }
}

__global__ void __launch_bounds__(512, 2) mk_fwd(Args args) {
    extern __shared__ __attribute__((aligned(16))) unsigned char lds_raw[];
    Ctx F;
    F.lds = (LAS unsigned char*)lds_raw;
    F.tid = threadIdx.x; F.lane = F.tid & 63; F.wave = __builtin_amdgcn_readfirstlane(F.tid >> 6);
    F.G = gridDim.x; { const int bx = blockIdx.x; F.vcu = (F.G % 8 == 0) ? (bx % 8) * (F.G / 8) + bx / 8 : bx; }
    F.ws = args.ws; F.in = args.in;
    volatile LAS unsigned* MISC = (volatile LAS unsigned*)(F.lds + MISC_OFF);
    if (F.tid < 64) MISC[F.tid] = 0u;
    __syncthreads();
    unsigned* ctl = (unsigned*)(args.ws + WS_CTL);
    XcdBarrier bar; bar.bar = ctl + CW_BAR; bar.x = 0; bar.st = nullptr;
    const int lo = args.ph_lo, hi = args.ph_hi;
    if (hi - lo > 1) bar = xcd_barrier_post(ctl + CW_BAR + args.li * XCD_BAR_WORDS, MISC + 8);
#define IN(k) (lo <= (k) && (k) < hi)
#define SEAM(k) do { if (IN(k) && IN((k) + 1)) xcd_barrier(bar); } while (0)
    unsigned char* ws = args.ws;

    if (IN(0)) REP(0) { p0_prologue(F); } SEAM(0);
    if (IN(1)) REP(1) {
        pg8::Gemm g{(const bf16_t*)(ws + WS_XN), (const bf16_t*)(ws + WS_WCAT), M, NPROJ, D}; pg8::StaticOrder S; S.init(M, NPROJ, D, F.G, (int)blockIdx.x);
        pg8::EpiProj E{(bf16_t*)(ws + WS_PROJ), NPROJ, 4};
        pg8::gemm_phase<pg8::EpiProj, pg8::StaticOrder, false>(F.lds, g, S, E);
    } SEAM(1);
    if (IN(2)) REP(2) { REP(10) sgu_phase(F); for (int u = F.vcu; u < NRU; u += F.G) rwkv_prep_unit(F, u); } SEAM(2);
    if (IN(3)) REP(3) { for (int u = F.vcu; u < NRU; u += F.G) rwkv_scan_unit(F, u); } SEAM(3);
    if (IN(4)) REP(4) {
        pg8::Gemm g{(const bf16_t*)(ws + WS_YCAT), (const bf16_t*)(ws + WS_WOUT), M, D, D}; pg8::StaticOrder S; S.init(M, D, D, F.G, (int)blockIdx.x);
        pg8::EpiResF32 E{F.in[I_X], (float*)(ws + WS_H1), D};
        pg8::gemm_phase<pg8::EpiResF32, pg8::StaticOrder, false>(F.lds, g, S, E);
    } SEAM(4);
    if (IN(5)) REP(5) { router_phase(F); } SEAM(5);
    if (IN(6)) REP(6) { scatter_phase(F); moe_weight_phase(F); } SEAM(6);
    if (IN(7)) REP(7) {
        const int* etab = (const int*)(ws + WS_ETAB);
        pg8::MoeOrder S; S.ntiles = etab[32] >> 8; S.nN = NHID / 256; S.G = F.G; S.c = (int)blockIdx.x; S.K = D; S.N = NHID; S.pad_start = etab; S.rowtok = (const int*)(ws + WS_ROWTOK); S.build_texp(F.lds);
        pg8::Gemm g{(const bf16_t*)(ws + WS_HN2), (const bf16_t*)(ws + WS_W1T), MAXROWS, NHID, D};
        pg8::EpiSwiglu E{ws + WS_ACT, F.in[I_MB1], &S};
        pg8::gemm_phase<pg8::EpiSwiglu, pg8::MoeOrder, true, true>(F.lds, g, S, E);
    } SEAM(7);
    if (IN(8)) REP(8) {
        const int* etab = (const int*)(ws + WS_ETAB);
        pg8::MoeOrder S; S.ntiles = etab[32] >> 8; S.nN = D / 256; S.G = F.G; S.c = (int)blockIdx.x; S.K = DEXP; S.N = D; S.pad_start = etab; S.rowtok = nullptr; S.build_texp(F.lds);
        pg8::Gemm g{(const bf16_t*)(ws + WS_ACT), (const bf16_t*)(ws + WS_W2T), MAXROWS, D, DEXP};
        pg8::EpiGate E{ws + WS_YOUT, F.in[I_MB2], (const float*)(ws + WS_ROWGATE), &S};
        pg8::gemm_phase<pg8::EpiGate, pg8::MoeOrder, false, true>(F.lds, g, S, E);
    } SEAM(8);
    if (IN(9)) REP(9) { combine_phase(F, args.out); }
#undef IN
#undef SEAM
}

extern "C" void kernel_launch(void* const* d_in, const int* in_sizes, int n_in, void* d_out, int out_size, void* d_ws, size_t ws_size, hipStream_t stream) {
    static int grid = 0;
    if (grid == 0) {
        if (n_in != 31 || in_sizes[0] != M * D || out_size != M * D || ws_size < WS_END) { fprintf(stderr, "kernel_launch: unexpected problem (n_in %d, out %d, ws %zu); nothing launched\n", n_in, out_size, ws_size); grid = -1; return; }
        int dev = 0, cus = 0, per_cu = 0;
        if (hipGetDevice(&dev) != hipSuccess || hipDeviceGetAttribute(&cus, hipDeviceAttributeMultiprocessorCount, dev) != hipSuccess) { grid = -1; return; }
        if (hipFuncSetAttribute((const void*)mk_fwd, hipFuncAttributeMaxDynamicSharedMemorySize, LDS_BYTES) != hipSuccess) { fprintf(stderr, "kernel_launch: hipFuncSetAttribute failed\n"); grid = -1; return; }
        if (hipOccupancyMaxActiveBlocksPerMultiprocessor(&per_cu, (const void*)mk_fwd, 512, LDS_BYTES) != hipSuccess || per_cu < 1) fprintf(stderr, "kernel_launch: occupancy query reports %d\n", per_cu);
        (void)hipGetLastError();
        grid = cus;
    }
    if (grid < 0) return;
    if (hipMemsetAsync((char*)d_ws + WS_CTL, 0, CTL_ZERO_BYTES, stream) != hipSuccess) return;
    Args a; memset(&a, 0, sizeof(a));
    for (int i = 0; i < 31; ++i) a.in[i] = (const float*)d_in[i];
    a.out = (float*)d_out; a.ws = (unsigned char*)d_ws;
    constexpr int NL = MK_N_LAUNCHES;
    static_assert(NL == 1 || NL == N_PHASES, "MK_N_LAUNCHES: 1 (one launch) or 10 (one launch per phase)");
    for (int li = 0; li < NL; ++li) {
        a.ph_lo = (NL == 1) ? 0 : li; a.ph_hi = (NL == 1) ? N_PHASES : li + 1; a.li = 0; a.pad = 0;
        hipLaunchKernelGGL(mk_fwd, dim3(grid), dim3(512), LDS_BYTES, stream, a);
    }
}
```

```cpp
#include <hip/hip_runtime.h>
#include <cstdio>
#include <cstdint>
#include <cstring>

#ifndef MK_N_LAUNCHES
#define MK_N_LAUNCHES 1
#endif
constexpr int N_PHASES = 10;
#ifndef PROBE_MASK
#define PROBE_MASK 0
#endif
#define REP(k) for (int rep_ = 0; rep_ < (((PROBE_MASK >> (k)) & 1) ? 2 : 1); ++rep_)

#define LAS __attribute__((address_space(3)))
#define GAS __attribute__((address_space(1)))
typedef unsigned short bf16_t;
typedef short bf16x8 __attribute__((ext_vector_type(8)));
typedef float f32x4 __attribute__((ext_vector_type(4)));
typedef float f32x2 __attribute__((ext_vector_type(2)));
typedef float f32x16 __attribute__((ext_vector_type(16)));
typedef unsigned u32x4 __attribute__((ext_vector_type(4)));
typedef unsigned u32x2 __attribute__((ext_vector_type(2)));
typedef GAS unsigned gu32;
#define RLX_AGENT __ATOMIC_RELAXED, __HIP_MEMORY_SCOPE_AGENT
#define LDS_WAIT() asm volatile("s_waitcnt lgkmcnt(0)" ::: "memory")
#define VM_WAIT() asm volatile("s_waitcnt vmcnt(0)" ::: "memory")
#define WG_BAR() do { asm volatile("s_waitcnt vmcnt(0) lgkmcnt(0)" ::: "memory"); __builtin_amdgcn_s_barrier(); asm volatile("" ::: "memory"); } while (0)

constexpr int BATCH = 2, SEQ = 8192, D = 1024, M = BATCH * SEQ;
constexpr int NPROJ = 3072;
constexpr int COL_V = 512, COL_R = 1024, COL_K = 1536, COL_VR = 2048, COL_LA = 2560, COL_LB = 2816;
constexpr int NEXP = 32, TOPK = 4, DEXP = 1024, NHID = 2048;
constexpr int NASSIGN = M * TOPK;
constexpr int MAXROWS = NASSIGN + NEXP * 256;
constexpr int RT_TOK = 32, NRT = M / RT_TOK;
constexpr int CH = 64, NCHUNK = SEQ / CH, SEGC = 8, NSEG = NCHUNK / SEGC;
constexpr int NRU = BATCH * 8 * NSEG;

constexpr size_t MiB = 1u << 20;
constexpr size_t WS_CTL = 0, CTL_ZERO_BYTES = 13824;
constexpr size_t WS_WCAT = 2 * MiB;
constexpr size_t WS_WOUT = 8 * MiB;
constexpr size_t WS_SMALL = 10 * MiB;
constexpr size_t WS_LW2 = WS_SMALL;
constexpr size_t WS_LA2 = WS_LW2 + 512 * 64 * 2;
constexpr size_t WS_LG2 = WS_LA2 + 512 * 64 * 2;
constexpr size_t WS_SGUW = WS_LG2 + 512 * 128 * 2;
constexpr size_t WS_RW = WS_SGUW + 8 * 128 * 128 * 2;
constexpr size_t WS_ETAB = WS_RW + 1024 * 32 * 4;
constexpr size_t WS_CNT = WS_ETAB + 1024;
constexpr size_t WS_RIDX = WS_CNT + NRT * 32 * 4;
constexpr size_t WS_RGATE = WS_RIDX + (size_t)M * 4 * 4;
constexpr size_t WS_RRANK = WS_RGATE + (size_t)M * 4 * 4;
constexpr size_t WS_TDEST = WS_RRANK + (size_t)M * 4 * 4;
static_assert(WS_TDEST + (size_t)M * 4 * 4 <= 12 * MiB, "small region");
constexpr size_t WS_ROWTOK = 12 * MiB;
constexpr size_t WS_ROWGATE = 13 * MiB;
constexpr size_t WS_SEGP = 14 * MiB;
constexpr size_t WS_SEGQ = 16 * MiB;
constexpr size_t WS_XN = 32 * MiB;
constexpr size_t WS_YCAT = 64 * MiB;
constexpr size_t WS_HN2 = 96 * MiB;
constexpr size_t WS_H1 = 128 * MiB;
constexpr size_t WS_PROJ = 192 * MiB;
constexpr size_t WS_W1T = 288 * MiB;
constexpr size_t WS_W2T = 416 * MiB;
constexpr size_t WS_ACT = 480 * MiB;
constexpr size_t WS_YOUT = 624 * MiB;
constexpr size_t WS_RK = 768 * MiB;
constexpr size_t WS_PHIT = WS_RK, WS_PSI = WS_RK + 8192, WS_YS = WS_RK + 16384, WS_YL = WS_RK + 24576, WS_GT = WS_RK + 32768, WS_BV = WS_RK + 40960;
constexpr size_t WS_END = 864 * MiB;
constexpr int CW_BAR = 0;

constexpr int RING_BYTES = 131072;
constexpr int TAB_OFF = 151552;
constexpr int TEXP_OFF = TAB_OFF + 2048;
constexpr int LDS_BYTES = 155648;
constexpr int MISC_OFF = LDS_BYTES - 256;

typedef __bf16 bf16v2_t __attribute__((ext_vector_type(2)));
__device__ __forceinline__ unsigned pk2(float lo, float hi) { const f32x2 v = {lo, hi}; return __builtin_bit_cast(unsigned, __builtin_convertvector(v, bf16v2_t)); }
__device__ __forceinline__ unsigned f2bf(float f) { return pk2(f, 0.f) & 0xffffu; }
__device__ __forceinline__ float bf2f(unsigned short b) { return __builtin_bit_cast(float, (unsigned)b << 16); }
__device__ __forceinline__ float bflo(unsigned w) { return __builtin_bit_cast(float, w << 16); }
__device__ __forceinline__ float bfhi(unsigned w) { return __builtin_bit_cast(float, w & 0xffff0000u); }
__device__ __forceinline__ void unpack8(const u32x4 w, float (&o)[8]) { o[0] = bflo(w.x); o[1] = bfhi(w.x); o[2] = bflo(w.y); o[3] = bfhi(w.y); o[4] = bflo(w.z); o[5] = bfhi(w.z); o[6] = bflo(w.w); o[7] = bfhi(w.w); }
__device__ __forceinline__ u32x4 pack8(const float (&v)[8]) { u32x4 w; w.x = pk2(v[0], v[1]); w.y = pk2(v[2], v[3]); w.z = pk2(v[4], v[5]); w.w = pk2(v[6], v[7]); return w; }
__device__ __forceinline__ float fsigmoid(float x) { return __builtin_amdgcn_rcpf(1.0f + __expf(-x)); }
__device__ __forceinline__ unsigned pk4_fp8(float a, float b, float c, float d) {
    a = fminf(fmaxf(a, -448.f), 448.f); b = fminf(fmaxf(b, -448.f), 448.f); c = fminf(fmaxf(c, -448.f), 448.f); d = fminf(fmaxf(d, -448.f), 448.f);
    unsigned w = 0u; w = __builtin_amdgcn_cvt_pk_fp8_f32(a, b, w, false); w = __builtin_amdgcn_cvt_pk_fp8_f32(c, d, w, true); return w; }
constexpr float FP8_SW = 64.0f;
constexpr float FP8_SA = 4.0f;
constexpr float FP8_SY = 16.0f;
__device__ __forceinline__ float wave_sum(float v) {
#pragma unroll
    for (int o = 1; o < 64; o <<= 1) v += __shfl_xor(v, o);
    return v;
}

namespace pg8 {
constexpr int BM = 256, BK = 64, HALF = 128, HTB = HALF * BK * 2, STAGE_BYTES = 8 * HTB, NXCD = 8, WGM = 8;
__host__ __device__ __forceinline__ int lds_byte(int r, int c) { const int st = (r >> 4) * 2 + (c >> 5), rr = r & 15, cc = c & 31, ob = rr * 64 + cc * 2; return st * 1024 + (ob ^ (((ob >> 9) & 1) << 5)); }
__host__ __device__ __forceinline__ void stage_rc(int b, int& R, int& C) { const int st = b / 1024, sb = b % 1024, swz = sb ^ (((sb >> 9) & 1) << 5); R = (st >> 1) * 16 + swz / 64; C = (st & 1) * 32 + (swz % 64) / 2; }
__host__ __device__ __forceinline__ int perm32(int rho) { const int n = rho >> 4, i = rho & 15; return 8 * (i >> 2) + 4 * n + (i & 3); }

struct Unit { int pm, pn; };
struct Gemm { const bf16_t* A; const bf16_t* Bt; int M, N, K; };

struct StaticOrder {
    int nM, nN, nwg, G, c, K;
    __device__ void init(int M_, int N_, int K_, int G_, int c_) { nM = M_ / BM; nN = N_ / BM; nwg = nM * nN; G = G_; c = c_; K = K_ * 2; }
    __device__ bool next(int i, Unit& u) const {
        const long L = (long)i * G + c; if (L >= nwg) return false;
        int wgid = (int)L; { const int q = nwg / NXCD, r = nwg % NXCD, xcd = wgid % NXCD, off = wgid / NXCD; wgid = (xcd < r ? xcd * (q + 1) : r * (q + 1) + (xcd - r) * q) + off; }
        const int nig = WGM * nN, gid = wgid / nig, fm = gid * WGM, gsz = (nM - fm) < WGM ? (nM - fm) : WGM;
        u.pm = fm + ((wgid % nig) % gsz); u.pn = (wgid % nig) / gsz; return true;
    }
    __device__ __forceinline__ size_t a_off(const Unit& u) const { return (size_t)u.pm * BM * K; }
    __device__ __forceinline__ size_t b_off(const Unit& u) const { return (size_t)u.pn * BM * K; }
    __device__ __forceinline__ const int* rows(const Unit&) const { return nullptr; }
};
struct MoeOrder {
    int ntiles, nN, G, c, K, N; const int* pad_start; const int* rowtok; const LAS unsigned char* texp;
    __device__ __forceinline__ int expert_of(int pm) const { return (int)texp[pm]; }
    __device__ __forceinline__ void build_texp(LAS unsigned char* lds) { LAS unsigned char* t = lds + TEXP_OFF;
        for (int pm = (int)threadIdx.x; pm < MAXROWS / BM; pm += 512) { const int r0 = pm * BM; int e = 0;
            for (int j = 1; j < NEXP; ++j) if (pad_start[j] <= r0) e = j;
            t[pm] = (unsigned char)e; }
        texp = t; WG_BAR(); }
    __device__ bool next(int i, Unit& u) const { const long L = (long)i * G + c; if (L >= (long)ntiles * nN) return false; u.pm = (int)(L / nN); u.pn = (int)(L % nN); return true; }
    __device__ __forceinline__ size_t a_off(const Unit& u) const { return (size_t)u.pm * BM * K; }
    __device__ __forceinline__ size_t b_off(const Unit& u) const { return ((size_t)expert_of(u.pm) * N + (size_t)u.pn * BM) * K; }
    __device__ __forceinline__ const int* rows(const Unit& u) const { return rowtok + u.pm * BM; }
};

__device__ __forceinline__ unsigned cvt_pk_bf16(float lo, float hi) { unsigned r; asm volatile("v_cvt_pk_bf16_f32 %0, %1, %2" : "=v"(r) : "v"(lo), "v"(hi)); return r; }
__device__ __forceinline__ f32x2 gelu_pk(f32x2 v) {
    const f32x2 av = __builtin_elementwise_abs(v), d = av * 0.2316418882f + 1.0f;
    f32x2 t; t.x = __builtin_amdgcn_rcpf(d.x); t.y = __builtin_amdgcn_rcpf(d.y);
    f32x2 q = t * 0.5307027145f + (-0.7265760135f); q = q * t + 0.7107068705f; q = q * t + (-0.142248368f); q = q * t + 0.127414796f; q = q * t;
    const f32x2 s = (v * v) * (-0.72134752044f);
    f32x2 e; e.x = __builtin_amdgcn_exp2f(s.x); e.y = __builtin_amdgcn_exp2f(s.y);
    const f32x2 m = v * (q * e), r = v - m;
    f32x2 o; o.x = v.x < 0.f ? m.x : r.x; o.y = v.y < 0.f ? m.y : r.y; return o;
}
struct EpiProj {
    static constexpr bool PERM = true;
    bf16_t* O; int ldc; int ngelu;
    __device__ __forceinline__ void operator()(const f32x4 (&acc)[2][2][4][2], const Unit& u, int wr, int wc, int fr, int fq) const {
        const int row0 = u.pm * BM + wr * 64 + fr, col0 = u.pn * BM + wc * 32 + 8 * fq; const bool act = u.pn < ngelu;
#pragma unroll
        for (int ai = 0; ai < 2; ++ai)
#pragma unroll
            for (int m = 0; m < 4; ++m) { bf16_t* rowp = O + (size_t)(row0 + ai * HALF + m * 16) * ldc + col0;
#pragma unroll
                for (int bj = 0; bj < 2; ++bj) { f32x4 v0 = acc[ai][bj][m][0], v1 = acc[ai][bj][m][1];
                    if (act) { f32x2 a = gelu_pk((f32x2){v0[0], v0[1]}), b = gelu_pk((f32x2){v0[2], v0[3]}), c = gelu_pk((f32x2){v1[0], v1[1]}), d = gelu_pk((f32x2){v1[2], v1[3]});
                        v0 = (f32x4){a.x, a.y, b.x, b.y}; v1 = (f32x4){c.x, c.y, d.x, d.y}; }
                    u32x4 w; w.x = cvt_pk_bf16(v0[0], v0[1]); w.y = cvt_pk_bf16(v0[2], v0[3]); w.z = cvt_pk_bf16(v1[0], v1[1]); w.w = cvt_pk_bf16(v1[2], v1[3]);
                    *(u32x4*)(rowp + bj * HALF) = w; } }
    }
};
struct EpiResF32 {
    static constexpr bool PERM = false;
    const float* base; float* out; int ldc;
    __device__ __forceinline__ void operator()(const f32x4 (&acc)[2][2][4][2], const Unit& u, int wr, int wc, int fr, int fq) const {
        const int col0 = u.pn * BM + wc * 32 + 4 * fq;
#pragma unroll
        for (int ai = 0; ai < 2; ++ai)
#pragma unroll
            for (int m = 0; m < 4; ++m) { const size_t off = (size_t)(u.pm * BM + ai * HALF + wr * 64 + m * 16 + fr) * ldc + col0;
#pragma unroll
                for (int bj = 0; bj < 2; ++bj)
#pragma unroll
                    for (int n = 0; n < 2; ++n) { const f32x4 bs = *(const f32x4*)(base + off + bj * HALF + n * 16); *(f32x4*)(out + off + bj * HALF + n * 16) = bs + acc[ai][bj][m][n]; } }
    }
};
struct EpiSwiglu {
    static constexpr bool PERM = true;
    unsigned char* O; const float* b1; const MoeOrder* S;
    __device__ __forceinline__ void operator()(const f32x4 (&acc)[2][2][4][2], const Unit& u, int wr, int wc, int fr, int fq) const {
        const int e = S->expert_of(u.pm); const int row0 = u.pm * BM + wr * 64 + fr, oc0 = u.pn * HALF + wc * 32 + 8 * fq;
        const float* bp = b1 + (size_t)e * NHID + 2 * oc0;
        f32x4 bg[2], bl[2];
#pragma unroll
        for (int n = 0; n < 2; ++n) { const f32x4 x0 = *(const f32x4*)(bp + 8 * n), x1 = *(const f32x4*)(bp + 8 * n + 4); bg[n] = (f32x4){x0[0], x0[2], x1[0], x1[2]}; bl[n] = (f32x4){x0[1], x0[3], x1[1], x1[3]}; }
#pragma unroll
        for (int ai = 0; ai < 2; ++ai)
#pragma unroll
            for (int m = 0; m < 4; ++m) { unsigned char* rowp = O + (size_t)(row0 + ai * HALF + m * 16) * DEXP + oc0; float o[8];
#pragma unroll
                for (int n = 0; n < 2; ++n) { const f32x4 g = acc[ai][0][m][n] * (1.0f / FP8_SW) + bg[n], l = acc[ai][1][m][n] * (1.0f / FP8_SW) + bl[n];
#pragma unroll
                    for (int q = 0; q < 4; ++q) { const float gg = fminf(g[q], 7.0f), ll = __builtin_amdgcn_fmed3f(l[q], -7.0f, 7.0f);
                        const float sg = gg * __builtin_amdgcn_rcpf(1.0f + __builtin_amdgcn_exp2f(gg * (-1.702f * 1.4426950408889634f)));
                        o[4 * n + q] = sg * __builtin_fmaf(ll, FP8_SA, FP8_SA); } }
                u32x2 w; { unsigned w0 = 0u; w0 = __builtin_amdgcn_cvt_pk_fp8_f32(o[0], o[1], w0, false); w0 = __builtin_amdgcn_cvt_pk_fp8_f32(o[2], o[3], w0, true); w.x = w0; }
                { unsigned w1 = 0u; w1 = __builtin_amdgcn_cvt_pk_fp8_f32(o[4], o[5], w1, false); w1 = __builtin_amdgcn_cvt_pk_fp8_f32(o[6], o[7], w1, true); w.y = w1; }
                *(u32x2*)rowp = w; }
    }
};
struct EpiGate {
    static constexpr bool PERM = true;
    unsigned char* O; const float* b2; const float* rowgate; const MoeOrder* S;
    __device__ __forceinline__ void operator()(const f32x4 (&acc)[2][2][4][2], const Unit& u, int wr, int wc, int fr, int fq) const {
        const int e = S->expert_of(u.pm); const int row0 = u.pm * BM + wr * 64 + fr, col0 = u.pn * BM + wc * 32 + 8 * fq;
        f32x4 bv[2][2];
#pragma unroll
        for (int bj = 0; bj < 2; ++bj)
#pragma unroll
            for (int n = 0; n < 2; ++n) bv[bj][n] = *(const f32x4*)(b2 + (size_t)e * D + col0 + bj * HALF + 4 * n);
#pragma unroll
        for (int ai = 0; ai < 2; ++ai)
#pragma unroll
            for (int m = 0; m < 4; ++m) { const int row = row0 + ai * HALF + m * 16; const float gt = rowgate[row] * FP8_SY; unsigned char* rowp = O + (size_t)row * D + col0;
#pragma unroll
                for (int bj = 0; bj < 2; ++bj) { const f32x4 v0 = (acc[ai][bj][m][0] * (1.0f / (FP8_SW * FP8_SA)) + bv[bj][0]) * gt, v1 = (acc[ai][bj][m][1] * (1.0f / (FP8_SW * FP8_SA)) + bv[bj][1]) * gt;
                    u32x2 w; w.x = pk4_fp8(v0[0], v0[1], v0[2], v0[3]); w.y = pk4_fp8(v1[0], v1[1], v1[2], v1[3]);
                    *(u32x2*)(rowp + bj * HALF) = w; } }
    }
};

typedef int v8i32 __attribute__((ext_vector_type(8)));
template <class Epi, class Sched, bool GATHER, bool FP8 = false>
__device__ __forceinline__ void gemm_phase(LAS unsigned char* lds, const Gemm g, const Sched& S, const Epi& E) {
    const int tid = threadIdx.x, wid = __builtin_amdgcn_readfirstlane(tid >> 6), lane = tid & 63, wr = wid >> 2, wc = wid & 3, fr = lane & 15, fq = lane >> 4;
    const int K = FP8 ? g.K : g.K * 2  , nt = K / (BK * 2);
    unsigned voffA[2], voffB[2]; int rA[2];
#pragma unroll
    for (int i = 0; i < 2; ++i) { int R, C; stage_rc(tid * 16 + i * 8192, R, C); const int Rb = Epi::PERM ? ((R & ~31) + perm32(R & 31)) : R;
        voffA[i] = GATHER ? (unsigned)(C * 2) : (unsigned)(R * K + C * 2); voffB[i] = (unsigned)(Rb * K + C * 2); rA[i] = R; }
    const size_t kstep = (size_t)(BK * 2);
    const size_t hstep = (size_t)HALF * K;
    const unsigned ldsw = (unsigned)wid * 1024u;
    const int aoff0 = FP8 ? lds_byte(wr * 64 + fr, 16 * fq) : lds_byte(wr * 64 + fr, fq * 8), aoff1 = FP8 ? lds_byte(wr * 64 + fr, 16 * fq + 8) : aoff0 + 1024;
    const int boff0 = FP8 ? lds_byte(wc * 32 + fr, 16 * fq) : lds_byte(wc * 32 + fr, fq * 8), boff1 = FP8 ? lds_byte(wc * 32 + fr, 16 * fq + 8) : boff0 + 1024;
    LAS unsigned* tab = (LAS unsigned*)(lds + TAB_OFF);
#define PG8_SA(b, h) (((b) * 2 + (h)) * HTB)
#define PG8_SB(b, h) ((4 + (b) * 2 + (h)) * HTB)
#define PG8_STAGE(bufoff, gbase, voff) do { _Pragma("unroll") for (int _i = 0; _i < 2; ++_i) \
        __builtin_amdgcn_global_load_lds((const unsigned*)((const char*)(gbase) + (voff)[_i]), (LAS unsigned*)(lds + (bufoff) + ldsw + _i * 8192), 16, 0, 0); } while (0)
#define PG8_STAGE_A(bufoff, gbase, h, sl) do { if constexpr (GATHER) { _Pragma("unroll") for (int _i = 0; _i < 2; ++_i) { const unsigned _ro = tab[(sl) * 256 + (h) * 128 + rA[_i]]; \
        __builtin_amdgcn_global_load_lds((const unsigned*)((const char*)(gbase) + _ro + voffA[_i]), (LAS unsigned*)(lds + (bufoff) + ldsw + _i * 8192), 16, 0, 0); } } \
        else { PG8_STAGE(bufoff, (const char*)(gbase) + (h) * hstep, voffA); } } while (0)
#define PG8_LDA(dst, b, h) do { _Pragma("unroll") for (int m = 0; m < 4; ++m) { dst[m][0] = *(const LAS bf16x8*)(lds + PG8_SA(b, h) + aoff0 + m * 2048); dst[m][1] = *(const LAS bf16x8*)(lds + PG8_SA(b, h) + aoff1 + m * 2048); } } while (0)
#define PG8_LDB(dst, b, h) do { _Pragma("unroll") for (int n = 0; n < 2; ++n) { dst[n][0] = *(const LAS bf16x8*)(lds + PG8_SB(b, h) + boff0 + n * 2048); dst[n][1] = *(const LAS bf16x8*)(lds + PG8_SB(b, h) + boff1 + n * 2048); } } while (0)
#define PG8_CAT(x) __builtin_bit_cast(v8i32, __builtin_shufflevector((x)[0], (x)[1], 0, 1, 2, 3, 4, 5, 6, 7, 8, 9, 10, 11, 12, 13, 14, 15))
#define PG8_MMA(ai, bj, At, Bt) do { __builtin_amdgcn_s_setprio(1); _Pragma("unroll") for (int m = 0; m < 4; ++m) _Pragma("unroll") for (int n = 0; n < 2; ++n) { \
        if constexpr (FP8) acc[ai][bj][m][n] = __builtin_amdgcn_mfma_scale_f32_16x16x128_f8f6f4(PG8_CAT(Bt[n]), PG8_CAT(At[m]), acc[ai][bj][m][n], 0, 0, 0, 0x7f7f7f7f, 0, 0x7f7f7f7f); \
        else { _Pragma("unroll") for (int k = 0; k < 2; ++k) acc[ai][bj][m][n] = __builtin_amdgcn_mfma_f32_16x16x32_bf16(Bt[n][k], At[m][k], acc[ai][bj][m][n], 0, 0, 0); } } \
        __builtin_amdgcn_s_setprio(0); \
        if constexpr (FP8) { _Pragma("unroll") for (int m = 0; m < 4; ++m) asm volatile("" : "+v"(acc[ai][bj][m][0]), "+v"(acc[ai][bj][m][1])); } } while (0)
#define PG8_WAIT_V(n) asm volatile("s_waitcnt vmcnt(" #n ")" ::: "memory")
#define PG8_WAIT_L(n) asm volatile("s_waitcnt lgkmcnt(" #n ")" ::: "memory")
#define PG8_BAR __builtin_amdgcn_s_barrier()
#define PG8_SCHED __builtin_amdgcn_sched_barrier(0)
#define PG8_SCHF do { if constexpr (FP8) __builtin_amdgcn_sched_barrier(0); } while (0)
    Unit cur, nxt; int ui = 0;
    if (!S.next(0, cur)) return;
    f32x4 acc[2][2][4][2];
#pragma unroll
    for (int a = 0; a < 2; ++a)
#pragma unroll
        for (int b = 0; b < 2; ++b)
#pragma unroll
            for (int m = 0; m < 4; ++m)
#pragma unroll
                for (int n = 0; n < 2; ++n) acc[a][b][m][n] = (f32x4){0.f, 0.f, 0.f, 0.f};
    bf16x8 At[4][2], B0[2][2], B1[2][2];
    const char* cA = (const char*)g.A + (GATHER ? (size_t)0 : S.a_off(cur)); const char* cB = (const char*)g.Bt + S.b_off(cur);
    if constexpr (GATHER) {
        if (tid < 256) tab[tid] = (unsigned)S.rows(cur)[tid] * (unsigned)K;
        WG_BAR();
    }
    PG8_STAGE(PG8_SB(0, 0), cB, voffB); PG8_STAGE(PG8_SB(0, 1), cB + hstep, voffB); PG8_STAGE_A(PG8_SA(0, 0), cA, 0, 0); PG8_STAGE_A(PG8_SA(0, 1), cA, 1, 0);
    if (wr == 1) PG8_BAR;
    PG8_WAIT_V(2); PG8_BAR;
    PG8_STAGE(PG8_SB(1, 0), cB + kstep, voffB); PG8_STAGE_A(PG8_SA(1, 0), cA + kstep, 0, 0); PG8_STAGE(PG8_SB(1, 1), cB + hstep + kstep, voffB);
    PG8_WAIT_V(6); PG8_BAR;
    for (;;) {
        const bool has_next = S.next(ui + 1, nxt);
        const int sc = ui & 1, sn = has_next ? ((ui + 1) & 1) : sc;
        if constexpr (GATHER) { if (has_next && tid < 256) tab[sn * 256 + tid] = (unsigned)S.rows(nxt)[tid] * (unsigned)K; }
        const char* nA = has_next ? (const char*)g.A + (GATHER ? (size_t)0 : S.a_off(nxt)) : cA; const char* nB = has_next ? (const char*)g.Bt + S.b_off(nxt) : cB;
        for (int t = 0; t < nt; t += 2) {
            const bool last = (t == nt - 2);
            const char* a1 = cA + (size_t)(t + 1) * kstep;
            const char* a2 = last ? nA : cA + (size_t)(t + 2) * kstep; const char* b2 = last ? nB : cB + (size_t)(t + 2) * kstep;
            const char* a3 = a2 + kstep; const char* b3 = b2 + kstep;
            const int s2 = last ? sn : sc;
            PG8_LDB(B0, 0, 0); PG8_LDB(B1, 0, 1); PG8_SCHED; PG8_LDA(At, 0, 0); PG8_STAGE_A(PG8_SA(1, 1), a1, 1, sc);
            PG8_WAIT_V(8); PG8_WAIT_L(0); PG8_BAR; PG8_SCHF; PG8_MMA(0, 0, At, B0); PG8_MMA(0, 1, At, B1); PG8_BAR; PG8_SCHED;
            PG8_LDA(At, 0, 1); PG8_STAGE(PG8_SB(0, 0), b2, voffB); PG8_STAGE(PG8_SB(0, 1), b2 + hstep, voffB); PG8_STAGE_A(PG8_SA(0, 0), a2, 0, s2);
            PG8_WAIT_V(8); PG8_WAIT_L(0); PG8_BAR; PG8_SCHF; PG8_MMA(1, 0, At, B0); PG8_MMA(1, 1, At, B1); PG8_BAR; PG8_SCHED;
            PG8_LDB(B0, 1, 0); PG8_LDB(B1, 1, 1); PG8_SCHED; PG8_LDA(At, 1, 0); PG8_STAGE_A(PG8_SA(0, 1), a2, 1, s2);
            PG8_WAIT_V(8); PG8_WAIT_L(0); PG8_BAR; PG8_SCHF; PG8_MMA(0, 0, At, B0); PG8_MMA(0, 1, At, B1); PG8_BAR; PG8_SCHED;
            PG8_LDA(At, 1, 1); PG8_STAGE(PG8_SB(1, 0), b3, voffB); PG8_STAGE(PG8_SB(1, 1), b3 + hstep, voffB); PG8_STAGE_A(PG8_SA(1, 0), a3, 0, s2);
            PG8_WAIT_V(8); PG8_WAIT_L(0); PG8_BAR; PG8_SCHF; PG8_MMA(1, 0, At, B0); PG8_MMA(1, 1, At, B1); PG8_BAR; PG8_SCHED;
        }
        if (wr == 0) PG8_BAR;
        E(acc, cur, wr, wc, fr, fq);
        if (!has_next) break;
#pragma unroll
        for (int a = 0; a < 2; ++a)
#pragma unroll
            for (int b = 0; b < 2; ++b)
#pragma unroll
                for (int m = 0; m < 4; ++m)
#pragma unroll
                    for (int n = 0; n < 2; ++n) acc[a][b][m][n] = (f32x4){0.f, 0.f, 0.f, 0.f};
        cur = nxt; cA = nA; cB = nB; ++ui;
        if (wr == 1) PG8_BAR;
    }
    PG8_WAIT_V(0);
    PG8_BAR;
#undef PG8_SA
#undef PG8_SB
#undef PG8_STAGE
#undef PG8_STAGE_A
#undef PG8_LDA
#undef PG8_LDB
#undef PG8_MMA
#undef PG8_CAT
#undef PG8_WAIT_V
#undef PG8_WAIT_L
#undef PG8_BAR
#undef PG8_SCHED
#undef PG8_SCHF
}
}

#define XB_TMO      128
#define XB_XCNT(j)  (256  + 64 * (j))
#define XB_XSUB(j)  (1280 + 64 * (j))
#define XB_XGEN(j)  (2304 + 64 * (j))
#define XB_TOP      3328
#define XB_TOPGEN   3392
#define XCD_BAR_WORDS 3456
#define XB_SPIN_CAP (1u << 18)
__device__ __forceinline__ unsigned xb_ld(unsigned* p)              { return __hip_atomic_load(p, __ATOMIC_RELAXED, __HIP_MEMORY_SCOPE_AGENT); }
__device__ __forceinline__ unsigned xb_add(unsigned* p, unsigned v) { return __hip_atomic_fetch_add(p, v, __ATOMIC_RELAXED, __HIP_MEMORY_SCOPE_AGENT); }
__device__ __forceinline__ unsigned xb_xcc_id() { return (unsigned)__builtin_amdgcn_s_getreg((3 << 11) | 20) & 0xFu; }
#define XB_SPIN(cond, bar) do { unsigned _sp = 0; while (cond) { __builtin_amdgcn_s_sleep(1); \
    if ((++_sp & 255u) == 0u) { if (xb_ld(&(bar)[XB_TMO])) break; if (_sp > XB_SPIN_CAP) { atomicAdd(&(bar)[XB_TMO], 1u); break; } } } } while (0)
struct XcdBarrier { unsigned* bar; unsigned x; volatile LAS unsigned* st; };
__device__ __forceinline__ XcdBarrier xcd_barrier_post(unsigned* bar, volatile LAS unsigned* st) {
    XcdBarrier b; b.bar = bar; b.x = xb_xcc_id(); b.st = st;
    if (threadIdx.x == 0) (void)xb_add(&bar[XB_XCNT(b.x)], 1u);
    return b;
}
__device__ __forceinline__ void xcd_barrier_complete(unsigned* bar, unsigned x, unsigned& nloc, unsigned& nx) {
    const unsigned G = gridDim.x * gridDim.y * gridDim.z;
    unsigned sum, cnt, mine, sp = 0u;
    for (;;) {
        sum = 0u; cnt = 0u; mine = 0u;
#pragma unroll
        for (unsigned j = 0; j < 16; ++j) { const unsigned c = xb_ld(&bar[XB_XCNT(j)]); sum += c; cnt += (c > 0u) ? 1u : 0u; mine = (j == x) ? c : mine; }
        if (sum == G) break;
        __builtin_amdgcn_s_sleep(1);
        if ((++sp & 255u) == 0u) { if (xb_ld(&bar[XB_TMO])) break; if (sp > XB_SPIN_CAP) { atomicAdd(&bar[XB_TMO], 1u); break; } }
    }
    nloc = mine > 0u ? mine : 1u; nx = cnt > 0u ? cnt : 1u;
}
__device__ __forceinline__ void xcd_barrier(const XcdBarrier& b) {
    asm volatile("s_waitcnt vmcnt(0)" ::: "memory");
    __syncthreads();
    if (threadIdx.x == 0) {
        unsigned* bar = b.bar;
        __builtin_amdgcn_s_waitcnt(0);
        unsigned nloc = b.st[0], nx = b.st[1];
        if (nloc == 0u) { xcd_barrier_complete(bar, b.x, nloc, nx); b.st[0] = nloc; b.st[1] = nx; }
        const unsigned old = xb_add(&bar[XB_XSUB(b.x)], 1u);
        const unsigned gen = old / nloc;
        if (old + 1u == (gen + 1u) * nloc) {
            __builtin_amdgcn_fence(__ATOMIC_RELEASE, "agent");
            asm volatile("s_waitcnt vmcnt(0)" ::: "memory");
            const unsigned og = xb_add(&bar[XB_TOP], 1u);
            const unsigned tg = og / nx;
            if (og + 1u == (tg + 1u) * nx) xb_add(&bar[XB_TOPGEN], 1u);
            else XB_SPIN(xb_ld(&bar[XB_TOPGEN]) == tg, bar);
            __builtin_amdgcn_fence(__ATOMIC_ACQUIRE, "agent");
            xb_add(&bar[XB_XGEN(b.x)], 1u);
            asm volatile("s_waitcnt vmcnt(0)" ::: "memory");
        } else {
            XB_SPIN(xb_ld(&bar[XB_XGEN(b.x)]) == gen, bar);
            __builtin_amdgcn_fence(__ATOMIC_ACQUIRE, "agent");
            asm volatile("s_waitcnt vmcnt(0)" ::: "memory");
        }
    }
    __syncthreads();
}

struct Args {
    const float* in[31]; float* out; unsigned char* ws;
    int ph_lo, ph_hi, li, pad;
};
enum { I_X = 0, I_N1G, I_WIN, I_SLNG, I_SLNB, I_SGUW, I_SGUB, I_MURKV, I_MUWAG, I_W0, I_W1, I_W2, I_A0, I_A1, I_A2, I_G1, I_G2, I_KK, I_KA, I_RK, I_LNXG, I_LNXB, I_WOUT, I_N2G, I_RW, I_RB,
       I_MW1, I_MB1, I_MW2, I_MB2, I_FG };

struct Ctx { LAS unsigned char* lds; int tid, lane, wave, G, vcu; unsigned char* ws; const float* const* in; };

template <int KS> __device__ __forceinline__ void mma_nt(f32x4& acc, const LAS bf16_t* X, int ldx, const LAS bf16_t* Y, int ldy, int lane) {
    const LAS bf16_t* xp = X + (lane & 15) * ldx + 8 * (lane >> 4); const LAS bf16_t* yp = Y + (lane & 15) * ldy + 8 * (lane >> 4);
#pragma unroll
    for (int ks = 0; ks < KS; ++ks) { const bf16x8 a = *(const LAS bf16x8*)(xp + 32 * ks), b = *(const LAS bf16x8*)(yp + 32 * ks); acc = __builtin_amdgcn_mfma_f32_16x16x32_bf16(a, b, acc, 0, 0, 0); }
}
template <int KS> __device__ __forceinline__ void mma_nt_gx(f32x4& acc, const bf16_t* X, int ldx, const LAS bf16_t* Y, int ldy, int lane) {
    const bf16_t* xp = X + (size_t)(lane & 15) * ldx + 8 * (lane >> 4); const LAS bf16_t* yp = Y + (lane & 15) * ldy + 8 * (lane >> 4);
#pragma unroll
    for (int ks = 0; ks < KS; ++ks) { const bf16x8 a = *(const bf16x8*)(xp + 32 * ks), b = *(const LAS bf16x8*)(yp + 32 * ks); acc = __builtin_amdgcn_mfma_f32_16x16x32_bf16(a, b, acc, 0, 0, 0); }
}
__device__ __forceinline__ void st4bf(LAS bf16_t* p, const f32x4 v) { u32x2 w; w.x = pk2(v[0], v[1]); w.y = pk2(v[2], v[3]); *(LAS u32x2*)p = w; }

__device__ __forceinline__ void p0_transpose_item(const float* W, int N, bf16_t* WT, int ldo, int row_off, const float* sc, int mode, bool remap, LAS float* scr, int item, int lane) {
    const int nblk = N / 32, kb = item / nblk, nb = item % nblk, k0 = 64 * kb, n0 = 32 * nb;
#pragma unroll 8
    for (int i = 0; i < 32; ++i) { const int kk = 2 * i + (lane >> 5); float v = __builtin_nontemporal_load(W + (size_t)(k0 + kk) * N + n0 + (lane & 31));
        if (mode) { const float s = sc[k0 + kk]; v *= (mode == 1) ? s : (1.0f - s); }
        scr[kk * 33 + (lane & 31)] = v; }
    LDS_WAIT(); asm volatile("" ::: "memory");
    const int c = lane & 7;
#pragma unroll
    for (int j = 0; j < 4; ++j) { const int n = (lane >> 3) + 8 * j; const LAS float* s = scr + (8 * c) * 33 + n;
        u32x4 o; o.x = pk2(s[0 * 33], s[1 * 33]); o.y = pk2(s[2 * 33], s[3 * 33]); o.z = pk2(s[4 * 33], s[5 * 33]); o.w = pk2(s[6 * 33], s[7 * 33]);
        int orow = n0 + n; if (remap) { const int oc = orow >> 1; orow = 256 * (oc >> 7) + 128 * (orow & 1) + (oc & 127); }
        *(u32x4*)(WT + (size_t)(row_off + orow) * ldo + k0 + 8 * c) = o; }
    LDS_WAIT(); asm volatile("" ::: "memory");
}
__device__ __forceinline__ void p0_transpose_item_fp8(const float* W, int N, unsigned char* WT, int ldo, bool remap, LAS float* scr, int item, int lane) {
    const int nblk = N / 32, kb = item / nblk, nb = item % nblk, k0 = 64 * kb, n0 = 32 * nb;
    float tv[32];
#pragma unroll
    for (int i = 0; i < 32; ++i) tv[i] = __builtin_nontemporal_load(W + (size_t)(k0 + 2 * i + (lane >> 5)) * N + n0 + (lane & 31));
#pragma unroll
    for (int i = 0; i < 32; ++i) scr[(2 * i + (lane >> 5)) * 33 + (lane & 31)] = tv[i] * FP8_SW;
    LDS_WAIT(); asm volatile("" ::: "memory");
    const int c = lane & 3;
#pragma unroll
    for (int j = 0; j < 2; ++j) { const int n = (lane >> 2) + 16 * j; const LAS float* sp = scr + (16 * c) * 33 + n;
        u32x4 o; o.x = pk4_fp8(sp[0 * 33], sp[1 * 33], sp[2 * 33], sp[3 * 33]); o.y = pk4_fp8(sp[4 * 33], sp[5 * 33], sp[6 * 33], sp[7 * 33]);
        o.z = pk4_fp8(sp[8 * 33], sp[9 * 33], sp[10 * 33], sp[11 * 33]); o.w = pk4_fp8(sp[12 * 33], sp[13 * 33], sp[14 * 33], sp[15 * 33]);
        int orow = n0 + n; if (remap) { const int oc = orow >> 1; orow = 256 * (oc >> 7) + 128 * (orow & 1) + (oc & 127); }
        *(u32x4*)(WT + (size_t)orow * ldo + k0 + 16 * c) = o; }
    LDS_WAIT(); asm volatile("" ::: "memory");
}
__device__ __forceinline__ void moe_weight_phase(const Ctx& F) {
    LAS float* scr = (LAS float*)(F.lds + 4096 + F.wave * 16384);
    const int gw = F.vcu * 8 + F.wave, NGW = F.G * 8, lane = F.lane;
    unsigned char* ws = F.ws;
    constexpr int I_M1 = 16 * 64, I_M2 = 16 * 32;
    for (int it = gw; it < NEXP * (I_M1 + I_M2); it += NGW) {
        int r = it; const int e = r / (I_M1 + I_M2); r -= e * (I_M1 + I_M2);
        if (r < I_M1) p0_transpose_item_fp8(F.in[I_MW1] + (size_t)e * D * NHID, NHID, ws + WS_W1T + (size_t)e * NHID * D, D, true, scr, r, lane);
        else p0_transpose_item_fp8(F.in[I_MW2] + (size_t)e * DEXP * D, D, ws + WS_W2T + (size_t)e * D * DEXP, DEXP, false, scr, r - I_M1, lane);
    }
}
__device__ __forceinline__ void p0_prologue(const Ctx& F) {
    LAS float* scr = (LAS float*)(F.lds + F.wave * 16384);
    const int gw = F.vcu * 8 + F.wave, NGW = F.G * 8, lane = F.lane;
    unsigned char* ws = F.ws;
    bf16_t* WCAT = (bf16_t*)(ws + WS_WCAT);
    constexpr int I_WIN_N = 16 * 80, I_L64 = 16 * 2, I_L128 = 16 * 4, I_WO = 16 * 32, I_M1 = 16 * 64, I_M2 = 16 * 32, I_S64 = 1 * 16, I_S128 = 2 * 16;
    constexpr int N_SMALL = I_WIN_N + 4 * I_L64 + 2 * I_L128 + I_WO + 2 * I_S64 + I_S128;
    constexpr int NITEMS = N_SMALL;
    const float* mu_wag = F.in[I_MUWAG];
    for (int it = gw; it < NITEMS; it += NGW) {
        int r = it;
        if (r < I_WIN_N) { p0_transpose_item(F.in[I_WIN], 2560, WCAT, D, 0, nullptr, 0, false, scr, r, lane); continue; } r -= I_WIN_N;
        if (r < I_L64) { p0_transpose_item(F.in[I_W1], 64, WCAT, D, COL_LA + 0, mu_wag + 0 * D, 2, false, scr, r, lane); continue; } r -= I_L64;
        if (r < I_L64) { p0_transpose_item(F.in[I_W1], 64, WCAT, D, COL_LB + 0, mu_wag + 0 * D, 1, false, scr, r, lane); continue; } r -= I_L64;
        if (r < I_L64) { p0_transpose_item(F.in[I_A1], 64, WCAT, D, COL_LA + 64, mu_wag + 1 * D, 2, false, scr, r, lane); continue; } r -= I_L64;
        if (r < I_L64) { p0_transpose_item(F.in[I_A1], 64, WCAT, D, COL_LB + 64, mu_wag + 1 * D, 1, false, scr, r, lane); continue; } r -= I_L64;
        if (r < I_L128) { p0_transpose_item(F.in[I_G1], 128, WCAT, D, COL_LA + 128, mu_wag + 2 * D, 2, false, scr, r, lane); continue; } r -= I_L128;
        if (r < I_L128) { p0_transpose_item(F.in[I_G1], 128, WCAT, D, COL_LB + 128, mu_wag + 2 * D, 1, false, scr, r, lane); continue; } r -= I_L128;
        if (r < I_WO) { p0_transpose_item(F.in[I_WOUT], D, (bf16_t*)(ws + WS_WOUT), D, 0, nullptr, 0, false, scr, r, lane); continue; } r -= I_WO;
        if (r < I_S64) { p0_transpose_item(F.in[I_W2], 512, (bf16_t*)(ws + WS_LW2), 64, 0, nullptr, 0, false, scr, r, lane); continue; } r -= I_S64;
        if (r < I_S64) { p0_transpose_item(F.in[I_A2], 512, (bf16_t*)(ws + WS_LA2), 64, 0, nullptr, 0, false, scr, r, lane); continue; } r -= I_S64;
        p0_transpose_item(F.in[I_G2], 512, (bf16_t*)(ws + WS_LG2), 128, 0, nullptr, 0, false, scr, r, lane);
    }
    const int gt = F.vcu * 512 + F.tid, NGT = F.G * 512;
    { bf16_t* SW = (bf16_t*)(ws + WS_SGUW); const float* w = F.in[I_SGUW];
      for (int i = gt; i < 8 * 128 * 128; i += NGT) { const int qi = (i >> 7) & 127, kj = i & 127; SW[i] = (bf16_t)(((kj >> 6) <= (qi >> 6)) ? f2bf(w[i]) : 0u); } }
    { float* RW = (float*)(ws + WS_RW); const float* w = F.in[I_RW]; const float* g = F.in[I_N2G];
      for (int i = gt; i < D * NEXP; i += NGT) RW[i] = w[i] * g[i >> 5]; }
    { int* rt = (int*)(ws + WS_ROWTOK); float* rg = (float*)(ws + WS_ROWGATE);
      for (int i = gt; i < MAXROWS; i += NGT) { rt[i] = 0; rg[i] = 0.f; } }
    { const float* g1 = F.in[I_N1G]; f32x4 gv[4];
#pragma unroll
      for (int j = 0; j < 4; ++j) gv[j] = *((const f32x4*)g1 + lane + 64 * j);
      for (int m = gw; m < M; m += NGW) {
          const f32x4* xr = (const f32x4*)(F.in[I_X] + (size_t)m * D) + lane; f32x4 v[4]; float s = 0.f;
#pragma unroll
          for (int j = 0; j < 4; ++j) { v[j] = __builtin_nontemporal_load(xr + 64 * j); s += (v[j].x * v[j].x + v[j].y * v[j].y) + (v[j].z * v[j].z + v[j].w * v[j].w); }
          const float rstd = __builtin_amdgcn_rsqf(wave_sum(s) * (1.0f / D) + 1e-5f);
          u32x2* o8 = (u32x2*)((bf16_t*)(ws + WS_XN) + (size_t)m * D) + lane;
#pragma unroll
          for (int j = 0; j < 4; ++j) { u32x2 w; w.x = pk2(v[j].x * rstd * gv[j].x, v[j].y * rstd * gv[j].y); w.y = pk2(v[j].z * rstd * gv[j].z, v[j].w * rstd * gv[j].w); o8[64 * j] = w; }
      } }
}

#define LB() do { asm volatile("s_waitcnt lgkmcnt(0)" ::: "memory"); __builtin_amdgcn_s_barrier(); asm volatile("" ::: "memory"); } while (0)
typedef short v4i16_t __attribute__((ext_vector_type(4)));
__device__ __forceinline__ bf16x8 tr_frag(const LAS bf16_t* base, int ld, int lane) {
    const LAS bf16_t* a = base + (8 * (lane >> 4) + ((lane & 15) >> 2)) * ld + 4 * (lane & 3);
    const v4i16_t lo = __builtin_amdgcn_ds_read_tr16_b64_v4i16((LAS v4i16_t*)a), hi = __builtin_amdgcn_ds_read_tr16_b64_v4i16((LAS v4i16_t*)(a + 4 * ld));
    return __builtin_shufflevector(lo, hi, 0, 1, 2, 3, 4, 5, 6, 7);
}
template <int KS> __device__ __forceinline__ void mma_tx(f32x4& acc, const LAS bf16_t* XR, int ldx, const LAS bf16_t* Y, int ldy, int lane) {
    const LAS bf16_t* yp = Y + (lane & 15) * ldy + 8 * (lane >> 4);
#pragma unroll
    for (int ks = 0; ks < KS; ++ks) { const bf16x8 a = tr_frag(XR + 32 * ks * ldx, ldx, lane), b = *(const LAS bf16x8*)(yp + 32 * ks); acc = __builtin_amdgcn_mfma_f32_16x16x32_bf16(a, b, acc, 0, 0, 0); }
}
template <int KS> __device__ __forceinline__ void mma_ty(f32x4& acc, const LAS bf16_t* X, int ldx, const LAS bf16_t* YR, int ldy, int lane) {
    const LAS bf16_t* xp = X + (lane & 15) * ldx + 8 * (lane >> 4);
#pragma unroll
    for (int ks = 0; ks < KS; ++ks) { const bf16x8 a = *(const LAS bf16x8*)(xp + 32 * ks), b = tr_frag(YR + 32 * ks * ldy, ldy, lane); acc = __builtin_amdgcn_mfma_f32_16x16x32_bf16(a, b, acc, 0, 0, 0); }
}
template <int KS> __device__ __forceinline__ void mma_rx(f32x4& acc, const bf16x8 (&xf)[KS], const LAS bf16_t* Y, int ldy, int lane) {
    const LAS bf16_t* yp = Y + (lane & 15) * ldy + 8 * (lane >> 4);
#pragma unroll
    for (int ks = 0; ks < KS; ++ks) { const bf16x8 b = *(const LAS bf16x8*)(yp + 32 * ks); acc = __builtin_amdgcn_mfma_f32_16x16x32_bf16(xf[ks], b, acc, 0, 0, 0); }
}

__device__ __forceinline__ void sgu_phase(const Ctx& F) {
    const int w = F.wave;
    const bf16_t* PROJ = (const bf16_t*)(F.ws + WS_PROJ); bf16_t* YCAT = (bf16_t*)(F.ws + WS_YCAT); const bf16_t* SW = (const bf16_t*)(F.ws + WS_SGUW);
    LAS bf16_t* vn = (LAS bf16_t*)F.lds;
    constexpr int LDV = 264;
    for (int unit = F.vcu; unit < 256; unit += F.G) {
        int tv_ = F.tid; asm volatile("" : "+v"(tv_)); const int lane = tv_ & 63;
        const int nb = unit >> 1, hh = unit & 1, m0 = nb * 128;
        float lg[8], lb[8];
#pragma unroll
        for (int q = 0; q < 8; ++q) { lg[q] = F.in[I_SLNG][lane * 8 + q]; lb[q] = F.in[I_SLNB][lane * 8 + q]; }
        const int hl = w >> 1, ih = w & 1, h = hh * 4 + hl;
        u32x4 raw[16];
#pragma unroll
        for (int rr = 0; rr < 16; ++rr) raw[rr] = *(const u32x4*)(PROJ + (size_t)(m0 + w * 16 + rr) * NPROJ + COL_V + lane * 8);
        bf16x8 bfr[4][4]; u32x2 ur[4][4]; float bsv[4];
#pragma unroll
        for (int ks = 0; ks < 4; ++ks)
#pragma unroll
            for (int it = 0; it < 4; ++it) bfr[ks][it] = *(const bf16x8*)(SW + (size_t)h * 16384 + (ih * 64 + it * 16 + (lane & 15)) * 128 + ks * 32 + 8 * (lane >> 4));
#pragma unroll
        for (int it = 0; it < 4; ++it) { const int i = ih * 64 + it * 16 + (lane & 15); bsv[it] = F.in[I_SGUB][h * 128 + i];
#pragma unroll
            for (int ct = 0; ct < 4; ++ct) ur[it][ct] = *(const u32x2*)(PROJ + (size_t)(m0 + i) * NPROJ + h * 64 + ct * 16 + 4 * (lane >> 4)); }
#pragma unroll
        for (int rr = 0; rr < 16; ++rr) {
            const int pos = w * 16 + rr; float v[8]; unpack8(raw[rr], v);
            float s = 0.f;
#pragma unroll
            for (int q = 0; q < 8; ++q) s += v[q];
            const float mean = wave_sum(s) * (1.0f / 512.0f); float qq = 0.f;
#pragma unroll
            for (int q = 0; q < 8; ++q) { v[q] -= mean; qq += v[q] * v[q]; }
            const float rstd = __builtin_amdgcn_rsqf(wave_sum(qq) * (1.0f / 512.0f) + 1e-5f);
            if ((lane >> 5) == hh) { float o[8];
#pragma unroll
                for (int q = 0; q < 8; ++q) o[q] = v[q] * rstd * lg[q] + lb[q];
                *(LAS u32x4*)(vn + pos * LDV + (lane & 31) * 8) = pack8(o); }
        }
        LB();
        f32x4 acc[4][4];
#pragma unroll
        for (int a = 0; a < 4; ++a)
#pragma unroll
            for (int b = 0; b < 4; ++b) acc[a][b] = (f32x4){0.f, 0.f, 0.f, 0.f};
#pragma unroll
        for (int ks = 0; ks < 4; ++ks) {
            bf16x8 af[4];
#pragma unroll
            for (int ct = 0; ct < 4; ++ct) af[ct] = tr_frag(vn + (32 * ks) * LDV + hl * 64 + ct * 16, LDV, lane);
#pragma unroll
            for (int ct = 0; ct < 4; ++ct)
#pragma unroll
                for (int it = 0; it < 4; ++it) acc[ct][it] = __builtin_amdgcn_mfma_f32_16x16x32_bf16(af[ct], bfr[ks][it], acc[ct][it], 0, 0, 0);
        }
#pragma unroll
        for (int it = 0; it < 4; ++it) { const int i = ih * 64 + it * 16 + (lane & 15); const float bs = bsv[it]; const size_t row = (size_t)(m0 + i);
#pragma unroll
            for (int ct = 0; ct < 4; ++ct) { const int c = h * 64 + ct * 16 + 4 * (lane >> 4); const u32x2 uu = ur[it][ct];
                const f32x4 a = acc[ct][it]; u32x2 o; o.x = pk2(bflo(uu.x) * (a[0] + bs), bfhi(uu.x) * (a[1] + bs)); o.y = pk2(bflo(uu.y) * (a[2] + bs), bfhi(uu.y) * (a[3] + bs));
                *(u32x2*)(YCAT + row * D + c) = o; } }
        LB();
    }
}

namespace rk {
constexpr int LD = 72, LDF = 68, LDG = 136, MBY = 64 * LD * 2;
constexpr int O_AT = 0, O_RT = MBY, O_BH = 2 * MBY, O_KH = 3 * MBY, O_V = 4 * MBY, O_TB = 5 * MBY, O_LAK = 6 * MBY, O_MRB = 7 * MBY, O_MRK = 8 * MBY,
              O_ST = 9 * MBY, O_XT = 11 * MBY, O_UT = 13 * MBY, O_WC = 15 * MBY, O_WT = O_WC + 512, O_PAR = O_WT + 2048, O_END = O_PAR + 2560;
static_assert(O_END <= MISC_OFF, "RWKV LDS map");
enum { P_MUR = 0, P_MUK, P_MUV, P_W0, P_A0, P_KK, P_KA, P_RK, P_LG, P_LB };
constexpr size_t CHB = 6 * 4096;
template <int KS> __device__ __forceinline__ void mma_txy(f32x4& acc, const LAS bf16_t* XR, int ldx, const LAS bf16_t* YR, int ldy, int lane) {
#pragma unroll
    for (int ks = 0; ks < KS; ++ks) { const bf16x8 a = tr_frag(XR + 32 * ks * ldx, ldx, lane), b = tr_frag(YR + 32 * ks * ldy, ldy, lane); acc = __builtin_amdgcn_mfma_f32_16x16x32_bf16(a, b, acc, 0, 0, 0); }
}
__device__ __forceinline__ void state_yfrags(const f32x4 (&acc)[4], bf16x8 (&yf)[2]) {
#pragma unroll
    for (int ks = 0; ks < 2; ++ks) { u32x4 wv; wv.x = pk2(acc[2 * ks][0], acc[2 * ks][1]); wv.y = pk2(acc[2 * ks][2], acc[2 * ks][3]); wv.z = pk2(acc[2 * ks + 1][0], acc[2 * ks + 1][1]); wv.w = pk2(acc[2 * ks + 1][2], acc[2 * ks + 1][3]);
        yf[ks] = __builtin_bit_cast(bf16x8, wv); }
}
__device__ __forceinline__ void load_xfrags(u32x2 (&xr)[4][2][2], const bf16_t* mt, int ldm, int lane) {
#pragma unroll
    for (int ct = 0; ct < 4; ++ct)
#pragma unroll
        for (int ks = 0; ks < 2; ++ks)
#pragma unroll
            for (int hf = 0; hf < 2; ++hf) xr[ct][ks][hf] = *(const u32x2*)(mt + (size_t)(16 * ct + (lane & 15)) * ldm + 32 * ks + 16 * hf + 4 * (lane >> 4));
}
__device__ __forceinline__ void load_xfrags_lds(u32x2 (&xr)[4][2][2], const LAS bf16_t* mt, int ldm, int lane) {
#pragma unroll
    for (int ct = 0; ct < 4; ++ct)
#pragma unroll
        for (int ks = 0; ks < 2; ++ks)
#pragma unroll
            for (int hf = 0; hf < 2; ++hf) xr[ct][ks][hf] = *(const LAS u32x2*)(mt + (16 * ct + (lane & 15)) * ldm + 32 * ks + 16 * hf + 4 * (lane >> 4));
}
__device__ __forceinline__ void state_step(f32x4 (&acc)[4], const u32x2 (&xr)[4][2][2]) {
    bf16x8 yf[2]; state_yfrags(acc, yf);
#pragma unroll
    for (int ct = 0; ct < 4; ++ct) { f32x4 d = (f32x4){0.f, 0.f, 0.f, 0.f};
#pragma unroll
        for (int ks = 0; ks < 2; ++ks) { u32x4 xw; xw.x = xr[ct][ks][0].x; xw.y = xr[ct][ks][0].y; xw.z = xr[ct][ks][1].x; xw.w = xr[ct][ks][1].y;
            d = __builtin_amdgcn_mfma_f32_16x16x32_bf16(__builtin_bit_cast(bf16x8, xw), yf[ks], d, 0, 0, 0); }
        acc[ct] = d; }
}
__device__ __forceinline__ f32x4 bf4(const u32x2 w) { return (f32x4){bflo(w.x), bfhi(w.x), bflo(w.y), bfhi(w.y)}; }
__device__ __forceinline__ int frag_off(int row, int col) { return (((row >> 4) * 64 + ((col >> 2) & 3) * 16 + (row & 15)) * 4 + (col >> 4)) * 4 + (col & 3); }
}

__device__ __forceinline__ void rwkv_prep_unit(const Ctx& F, int unit) {
    using namespace rk;
    const int w = F.wave;
    const int b = unit >> 7, h = (unit >> 4) & 7, seg = unit & 15;
    constexpr int NL = 4;
    LAS unsigned char* L = F.lds;
    LAS bf16_t *AT = (LAS bf16_t*)(L + O_AT), *RT = (LAS bf16_t*)(L + O_RT), *BH = (LAS bf16_t*)(L + O_BH), *KH = (LAS bf16_t*)(L + O_KH), *V = (LAS bf16_t*)(L + O_V), *TB = (LAS bf16_t*)(L + O_TB),
                *LAK = (LAS bf16_t*)(L + O_LAK), *MRB = (LAS bf16_t*)(L + O_MRB), *MRK = (LAS bf16_t*)(L + O_MRK), *ST = (LAS bf16_t*)(L + O_ST), *XT = (LAS bf16_t*)(L + O_XT), *UT = (LAS bf16_t*)(L + O_UT);
    LAS bf16_t *DECP = ST, *ICLP = ST + 64 * LD, *LW = XT, *LA = XT + 64 * LD, *BT = XT, *KT = XT + 64 * LD, *LG = UT, *AH = ST, *XL = ST + 64 * LD, *UL = XT, *PHL = UT, *PSL = UT + 64 * LD;
    LAS float *LF = (LAS float*)(L + O_ST), *TF = (LAS float*)(L + O_XT), *TMP = (LAS float*)(L + O_UT), *WC = (LAS float*)(L + O_WC), *WT = (LAS float*)(L + O_WT), *PAR = (LAS float*)(L + O_PAR);
    const bf16_t* PROJ = (const bf16_t*)(F.ws + WS_PROJ);
    bf16_t* SEGP = (bf16_t*)(F.ws + WS_SEGP); float* SEGQ = (float*)(F.ws + WS_SEGQ);
    bf16_t *PHIT = (bf16_t*)(F.ws + WS_PHIT), *PSI = (bf16_t*)(F.ws + WS_PSI), *YSG = (bf16_t*)(F.ws + WS_YS), *YLG = (bf16_t*)(F.ws + WS_YL), *GTG = (bf16_t*)(F.ws + WS_GT), *BVG = (bf16_t*)(F.ws + WS_BV);

    { int tid = F.tid; asm volatile("" : "+v"(tid));
      for (int i = tid; i < 640; i += 512) { const int pv = i >> 6, cc = h * 64 + (i & 63); const float* src;
          switch (pv) { case P_MUR: src = F.in[I_MURKV] + 0 * 512; break; case P_MUK: src = F.in[I_MURKV] + 1 * 512; break; case P_MUV: src = F.in[I_MURKV] + 2 * 512; break; case P_W0: src = F.in[I_W0]; break;
                        case P_A0: src = F.in[I_A0]; break; case P_KK: src = F.in[I_KK]; break; case P_KA: src = F.in[I_KA]; break; case P_RK: src = F.in[I_RK]; break; case P_LG: src = F.in[I_LNXG]; break; default: src = F.in[I_LNXB]; break; }
          PAR[i] = src[cc]; }
    }
    const bf16_t* LW2 = (const bf16_t*)(F.ws + WS_LW2); const bf16_t* LA2 = (const bf16_t*)(F.ws + WS_LA2); const bf16_t* LG2 = (const bf16_t*)(F.ws + WS_LG2);

    f32x4 acc[4];
#pragma unroll
    for (int ct = 0; ct < 4; ++ct) acc[ct] = (f32x4){0.f, 0.f, 0.f, 0.f};
    if (w < 4) { int tv0_ = F.tid; asm volatile("" : "+v"(tv0_)); const int lane = tv0_ & 63;
#pragma unroll
        for (int ct = 0; ct < 4; ++ct)
#pragma unroll
            for (int r = 0; r < 4; ++r) acc[ct][r] = (16 * ct + 4 * (lane >> 4) + r == 16 * w + (lane & 15)) ? 1.0f : 0.0f; }
    LB();

    u32x4 rw_c[3 + NL], rw_p[3 + NL];
    auto load_raw = [&](int c, int tv) {
        const int t = tv >> 3, c0 = (tv & 7) * 8, hc = h * 64 + c0; const int tq0 = (seg * SEGC + c) * CH;
        const bf16_t* rowc = PROJ + ((size_t)b * SEQ + tq0 + t) * NPROJ; const bool hasp = (tq0 + t) > 0; const bf16_t* rowp = hasp ? rowc - NPROJ : rowc;
        rw_c[0] = *(const u32x4*)(rowc + COL_R + hc); rw_c[1] = *(const u32x4*)(rowc + COL_K + hc); rw_c[2] = *(const u32x4*)(rowc + COL_VR + hc);
        rw_p[0] = *(const u32x4*)(rowp + COL_R + hc); rw_p[1] = *(const u32x4*)(rowp + COL_K + hc); rw_p[2] = *(const u32x4*)(rowp + COL_VR + hc);
#pragma unroll
        for (int q4 = 0; q4 < NL; ++q4) { rw_c[3 + q4] = *(const u32x4*)(rowc + COL_LA + q4 * 64 + c0); rw_p[3 + q4] = *(const u32x4*)(rowp + COL_LB + q4 * 64 + c0); }
    };
    bf16x8 fW[2], fA[2], fG[4];
    { int tvw_ = F.tid; asm volatile("" : "+v"(tvw_)); const int g_ = (tvw_ & 63) >> 4, ln_ = tvw_ & 15; const size_t row = (size_t)(h * 64 + (w & 3) * 16 + ln_);
#pragma unroll
      for (int ks = 0; ks < 2; ++ks) { fW[ks] = *(const bf16x8*)(LW2 + row * 64 + 32 * ks + 8 * g_); fA[ks] = *(const bf16x8*)(LA2 + row * 64 + 32 * ks + 8 * g_); }
#pragma unroll
      for (int ks = 0; ks < 4; ++ks) fG[ks] = *(const bf16x8*)(LG2 + row * 128 + 32 * ks + 8 * g_); }
    { int tv0_ = F.tid; asm volatile("" : "+v"(tv0_)); load_raw(0, tv0_); }

    for (int c = 0; c < SEGC; ++c) {
        int tv_ = F.tid; asm volatile("" : "+v"(tv_));
        const int lane = tv_ & 63, t = tv_ >> 3, cg = tv_ & 7, c0 = cg * 8, g = lane >> 4, ln = lane & 15;
        const size_t cu = (size_t)((b * 8 + h) * NCHUNK + seg * SEGC + c) * CHB;
        float r_[8], k_[8], v_[8], a_[8], b_[8], ld_[8], pf_[8];
        {
            float cv[8], pv[8];
            { const unsigned km = ((seg * SEGC + c) * CH + t) > 0 ? 0xffffffffu : 0u;
#pragma unroll
              for (int i = 0; i < 3 + NL; ++i) { rw_p[i].x &= km; rw_p[i].y &= km; rw_p[i].z &= km; rw_p[i].w &= km; } }
            unpack8(rw_c[0], cv); unpack8(rw_p[0], pv);
#pragma unroll
            for (int q = 0; q < 8; ++q) r_[q] = cv[q] + (pv[q] - cv[q]) * PAR[P_MUR * 64 + c0 + q];
            unpack8(rw_c[1], cv); unpack8(rw_p[1], pv);
#pragma unroll
            for (int q = 0; q < 8; ++q) k_[q] = cv[q] + (pv[q] - cv[q]) * PAR[P_MUK * 64 + c0 + q];
            unpack8(rw_c[2], cv); unpack8(rw_p[2], pv);
#pragma unroll
            for (int q = 0; q < 8; ++q) v_[q] = cv[q] + (pv[q] - cv[q]) * PAR[P_MUV * 64 + c0 + q];
#pragma unroll
            for (int q4 = 0; q4 < NL; ++q4) { float o[8];
                unpack8(rw_c[3 + q4], cv); unpack8(rw_p[3 + q4], pv);
#pragma unroll
                for (int q = 0; q < 8; ++q) { const float x = cv[q] + pv[q]; o[q] = (q4 == 0) ? (1.0f - 2.0f * __builtin_amdgcn_rcpf(1.0f + __expf(2.0f * x))) : (q4 == 1 ? x : fsigmoid(x)); }
                LAS bf16_t* dst = (q4 == 0) ? (LW + t * LD + c0) : (q4 == 1) ? (LA + t * LD + c0) : (LG + t * LDG + (q4 - 2) * 64 + c0);
                *(LAS u32x4*)dst = pack8(o);
            }
        }
        LB();
        {
            const int ct = w & 3, tp = (w >> 2) * 2;
#pragma unroll
            for (int j = 0; j < 2; ++j) { const int tt = tp + j; const int so = (tt * 16 + ln) * LD + ct * 16 + 4 * g;
                f32x4 d = (f32x4){0.f, 0.f, 0.f, 0.f}; mma_rx<2>(d, fW, LW + tt * 16 * LD, LD, lane); st4bf(DECP + so, d);
                d = (f32x4){0.f, 0.f, 0.f, 0.f}; mma_rx<2>(d, fA, LA + tt * 16 * LD, LD, lane); st4bf(ICLP + so, d);
                d = (f32x4){0.f, 0.f, 0.f, 0.f}; mma_rx<4>(d, fG, LG + tt * 16 * LDG, LDG, lane);
                u32x2 gw; gw.x = pk2(d[0], d[1]); gw.y = pk2(d[2], d[3]); *(u32x2*)(GTG + cu + frag_off(tt * 16 + ln, ct * 16 + 4 * g)) = gw; }
        }
        LB();
        {
            float dp[8], ip[8]; unpack8(*(const LAS u32x4*)(DECP + t * LD + c0), dp); unpack8(*(const LAS u32x4*)(ICLP + t * LD + c0), ip);
            float kk[8], ss = 0.f, bonus = 0.f;
#pragma unroll
            for (int q = 0; q < 8; ++q) {
                const float xw = dp[q] + PAR[P_W0 * 64 + c0 + q]; const float z = -xw;
                const float sp = fmaxf(z, 0.f) + __logf(1.0f + __expf(-fabsf(z)));
                const float wl = -sp - 0.5f; ld_[q] = -__expf(wl);
                ip[q] = fsigmoid(ip[q] + PAR[P_A0 * 64 + c0 + q]);
                kk[q] = k_[q] * PAR[P_KK * 64 + c0 + q]; ss += kk[q] * kk[q];
            }
            ss += __shfl_xor(ss, 1); ss += __shfl_xor(ss, 2); ss += __shfl_xor(ss, 4);
            const float inv = __builtin_amdgcn_rsqf(fmaxf(ss, 1e-24f));
#pragma unroll
            for (int q = 0; q < 8; ++q) { kk[q] *= inv; k_[q] = k_[q] * (1.0f + (ip[q] - 1.0f) * PAR[P_KA * 64 + c0 + q]); a_[q] = -kk[q]; b_[q] = kk[q] * ip[q];
                bonus += r_[q] * k_[q] * PAR[P_RK * 64 + c0 + q]; }
            bonus += __shfl_xor(bonus, 1); bonus += __shfl_xor(bonus, 2); bonus += __shfl_xor(bonus, 4);
            { float o[8];
#pragma unroll
              for (int q = 0; q < 8; ++q) o[q] = bonus * v_[q];
              const u32x4 pw = pack8(o); u32x2 lo_, hi_; lo_.x = pw.x; lo_.y = pw.y; hi_.x = pw.z; hi_.y = pw.w;
              *(u32x2*)(BVG + cu + frag_off(t, c0)) = lo_; *(u32x2*)(BVG + cu + frag_off(t, c0 + 4)) = hi_; }
#pragma unroll
            for (int q = 0; q < 8; ++q) { float x = ld_[q];
#pragma unroll
                for (int dsh = 8; dsh < 64; dsh <<= 1) { const float y = __shfl_up(x, dsh); x += (lane >= dsh) ? y : 0.f; }
                pf_[q] = x; }
            if ((lane >> 3) == 7) { *(LAS f32x4*)(WT + w * 64 + c0) = (f32x4){pf_[0], pf_[1], pf_[2], pf_[3]}; *(LAS f32x4*)(WT + w * 64 + c0 + 4) = (f32x4){pf_[4], pf_[5], pf_[6], pf_[7]}; }
        }
        LB();
        REP(16) {
        {
            float off[8], tot[8];
#pragma unroll
            for (int q = 0; q < 8; ++q) { off[q] = 0.f; tot[q] = 0.f; }
#pragma unroll
            for (int ww = 0; ww < 8; ++ww) { const f32x4 x0 = *(const LAS f32x4*)(WT + ww * 64 + c0), x1 = *(const LAS f32x4*)(WT + ww * 64 + c0 + 4); const float m = (ww < w) ? 1.0f : 0.0f;
#pragma unroll
                for (int q = 0; q < 4; ++q) { tot[q] += x0[q]; tot[q + 4] += x1[q]; off[q] += m * x0[q]; off[q + 4] += m * x1[q]; } }
            float o1[8], o2[8], o3[8], o4[8], o5[8], o6[8];
#pragma unroll
            for (int q = 0; q < 8; ++q) { const float cu_ = pf_[q] + off[q]; const float ec = __expf(cu_), en = __builtin_amdgcn_rcpf(ec), wc = __expf(tot[q]), er = wc * en;
                o1[q] = a_[q] * __expf(cu_ - ld_[q]); o2[q] = r_[q] * ec; o3[q] = b_[q] * en; o4[q] = k_[q] * en; o5[q] = b_[q] * er; o6[q] = k_[q] * er;
                if (t == 63) WC[c0 + q] = wc; }
            *(LAS u32x4*)(AT + t * LD + c0) = pack8(o1); *(LAS u32x4*)(RT + t * LD + c0) = pack8(o2); *(LAS u32x4*)(BT + t * LD + c0) = pack8(o3); *(LAS u32x4*)(KT + t * LD + c0) = pack8(o4);
            *(LAS u32x4*)(BH + t * LD + c0) = pack8(o5); *(LAS u32x4*)(KH + t * LD + c0) = pack8(o6); *(LAS u32x4*)(V + t * LD + c0) = pack8(v_);
        }
        LB();
        {
            const int tt = w & 3, ip0 = (w >> 2) * 2;
#pragma unroll
            for (int j = 0; j < 2; ++j) { const int it = ip0 + j; const int i0 = it * 16 + 4 * g, tq = tt * 16 + ln;
                f32x4 d0 = (f32x4){0.f, 0.f, 0.f, 0.f}, d1 = d0, d2 = d0, d3 = d0;
                if (it <= tt) {
                    mma_nt<2>(d0, BT + it * 16 * LD, LD, AT + tt * 16 * LD, LD, lane); mma_nt<2>(d1, KT + it * 16 * LD, LD, AT + tt * 16 * LD, LD, lane);
                    mma_nt<2>(d2, BT + it * 16 * LD, LD, RT + tt * 16 * LD, LD, lane); mma_nt<2>(d3, KT + it * 16 * LD, LD, RT + tt * 16 * LD, LD, lane);
                    if (it == tt) {
#pragma unroll
                        for (int r = 0; r < 4; ++r) { const int i = i0 + r; if (!(i < tq)) { d0[r] = 0.f; d1[r] = 0.f; } if (!(i <= tq)) { d2[r] = 0.f; d3[r] = 0.f; } } }
                }
                *(LAS f32x4*)(LF + tq * LDF + i0) = d0; st4bf(LAK + tq * LD + i0, d1); st4bf(MRB + tq * LD + i0, d2); st4bf(MRK + tq * LD + i0, d3); }
        }
        LB();
        }
        load_raw(c + 1 < SEGC ? c + 1 : c, tv_);
        REP(14) {
        if (w == 0) { const int bk = lane >> 4, j = lane & 15; float x[16];
            const LAS float* Lb = LF + (16 * bk) * LDF + 16 * bk; LAS float* Tb = TF + (16 * bk) * LDF + 16 * bk + j;
            f32x4 ra[4], rb[4];
#pragma unroll
            for (int q = 0; q < 4; ++q) ra[q] = *(const LAS f32x4*)(Lb + 1 * LDF + 4 * q);
            x[0] = (j == 0) ? 1.0f : 0.0f; Tb[0] = x[0];
#pragma unroll
            for (int tr = 1; tr < 16; ++tr) {
                f32x4 (&cur)[4] = (tr & 1) ? ra : rb; f32x4 (&nxt)[4] = (tr & 1) ? rb : ra;
                if (tr < 15) {
#pragma unroll
                    for (int q = 0; q < 4; ++q) nxt[q] = *(const LAS f32x4*)(Lb + (tr + 1) * LDF + 4 * q); }
                float s0 = (tr == j) ? 1.0f : 0.0f, s1 = 0.f;
#pragma unroll
                for (int i = 0; i < tr; ++i) { if (i & 1) s1 += cur[i >> 2][i & 3] * x[i]; else s0 += cur[i >> 2][i & 3] * x[i]; }
                x[tr] = s0 + s1; Tb[tr * LDF] = x[tr]; } }
        LB();
        if (w < 2) { const int p = w, lr = lane & 15, lk = lane >> 4; f32x4 d = (f32x4){0.f, 0.f, 0.f, 0.f};
#pragma unroll
            for (int ks = 0; ks < 4; ++ks) d = __builtin_amdgcn_mfma_f32_16x16x4f32(LF[(32 * p + 16 + lr) * LDF + 32 * p + 4 * ks + lk], TF[(32 * p + 4 * ks + lk) * LDF + 32 * p + lr], d, 0, 0, 0);
#pragma unroll
            for (int r = 0; r < 4; ++r) TMP[(32 * p + 16 + 4 * lk + r) * LDF + 32 * p + lr] = d[r];
            LDS_WAIT(); f32x4 e = (f32x4){0.f, 0.f, 0.f, 0.f};
#pragma unroll
            for (int ks = 0; ks < 4; ++ks) e = __builtin_amdgcn_mfma_f32_16x16x4f32(TF[(32 * p + 16 + lr) * LDF + 32 * p + 16 + 4 * ks + lk], TMP[(32 * p + 16 + 4 * ks + lk) * LDF + 32 * p + lr], e, 0, 0, 0);
#pragma unroll
            for (int r = 0; r < 4; ++r) TF[(32 * p + 16 + 4 * lk + r) * LDF + 32 * p + lr] = e[r]; }
        LB();
        if (w < 4) { const int ri = w >> 1, cj = w & 1, lr = lane & 15, lk = lane >> 4; f32x4 d = (f32x4){0.f, 0.f, 0.f, 0.f};
#pragma unroll
            for (int ks = 0; ks < 8; ++ks) { const int k = 4 * ks + lk; const float bb = ((k >> 4) >= cj) ? TF[k * LDF + 16 * cj + lr] : 0.0f;
                d = __builtin_amdgcn_mfma_f32_16x16x4f32(LF[(32 + 16 * ri + lr) * LDF + k], bb, d, 0, 0, 0); }
#pragma unroll
            for (int r = 0; r < 4; ++r) TMP[(32 + 16 * ri + 4 * lk + r) * LDF + 16 * cj + lr] = d[r]; }
        LB();
        if (w < 4) { const int ri = w >> 1, cj = w & 1, lr = lane & 15, lk = lane >> 4; f32x4 d = (f32x4){0.f, 0.f, 0.f, 0.f};
#pragma unroll
            for (int ks = 0; ks < 8; ++ks) { const int k = 4 * ks + lk; const float aa = (ri >= (k >> 4)) ? TF[(32 + 16 * ri + lr) * LDF + 32 + k] : 0.0f;
                d = __builtin_amdgcn_mfma_f32_16x16x4f32(aa, TMP[(32 + k) * LDF + 16 * cj + lr], d, 0, 0, 0); }
#pragma unroll
            for (int r = 0; r < 4; ++r) TF[(32 + 16 * ri + 4 * lk + r) * LDF + 16 * cj + lr] = d[r]; }
        LB();
        { float o[8];
#pragma unroll
          for (int q = 0; q < 8; ++q) { const int i = c0 + q; o[q] = ((i >> 4) <= (t >> 4)) ? TF[t * LDF + i] : 0.0f; }
          *(LAS u32x4*)(TB + t * LD + c0) = pack8(o); }
        LB();
        }
        const int tt = w & 3, pr = (w >> 2) * 2;
        REP(15) {
#pragma unroll
        for (int j = 0; j < 2; ++j) { const int mt = pr + j; const int so = (tt * 16 + ln) * LD + mt * 16 + 4 * g;
            f32x4 d = (f32x4){0.f, 0.f, 0.f, 0.f}; mma_tx<2>(d, AT + 16 * mt, LD, TB + tt * 16 * LD, LD, lane); st4bf(AH + so, d);
            d = (f32x4){0.f, 0.f, 0.f, 0.f}; mma_tx<2>(d, V + 16 * mt, LD, LAK + tt * 16 * LD, LD, lane); st4bf(XL + so, d); }
        LB();
#pragma unroll
        for (int j = 0; j < 2; ++j) { const int mt = pr + j; const int so = (tt * 16 + ln) * LD + mt * 16 + 4 * g;
            f32x4 d = (f32x4){0.f, 0.f, 0.f, 0.f}; mma_tx<2>(d, XL + 16 * mt, LD, TB + tt * 16 * LD, LD, lane); st4bf(UL + so, d);
            d = bf4(*(const LAS u32x2*)(RT + so)); mma_tx<2>(d, AH + 16 * mt, LD, MRB + tt * 16 * LD, LD, lane);
            { u32x2 o; o.x = pk2(d[0], d[1]); o.y = pk2(d[2], d[3]); *(u32x2*)(YSG + cu + frag_off(tt * 16 + ln, mt * 16 + 4 * g)) = o; }
            d = (f32x4){0.f, 0.f, 0.f, 0.f}; mma_txy<2>(d, AH + 16 * mt, LD, BH + 16 * tt, LD, lane);
            { const f32x4 wc4 = *(const LAS f32x4*)(WC + mt * 16 + 4 * g);
#pragma unroll
              for (int r = 0; r < 4; ++r) d[r] += (mt * 16 + 4 * g + r == tt * 16 + ln) ? wc4[r] : 0.0f;
              u32x2 o; o.x = pk2(d[0], d[1]); o.y = pk2(d[2], d[3]); *(LAS u32x2*)(PHL + so) = o; } }
        LB();
#pragma unroll
        for (int j = 0; j < 2; ++j) { const int mt = pr + j; const int so = (tt * 16 + ln) * LD + mt * 16 + 4 * g;
            f32x4 d = (f32x4){0.f, 0.f, 0.f, 0.f}; mma_txy<2>(d, BH + 16 * mt, LD, UL + 16 * tt, LD, lane); mma_txy<2>(d, KH + 16 * mt, LD, V + 16 * tt, LD, lane);
            { u32x2 o; o.x = pk2(d[0], d[1]); o.y = pk2(d[2], d[3]); *(LAS u32x2*)(PSL + so) = o; }
            d = (f32x4){0.f, 0.f, 0.f, 0.f}; mma_tx<2>(d, UL + 16 * mt, LD, MRB + tt * 16 * LD, LD, lane); mma_tx<2>(d, V + 16 * mt, LD, MRK + tt * 16 * LD, LD, lane);
            { u32x2 o; o.x = pk2(d[0], d[1]); o.y = pk2(d[2], d[3]); *(u32x2*)(YLG + cu + frag_off(tt * 16 + ln, mt * 16 + 4 * g)) = o; } }
        LB();
        }
        { u32x2 xr[4][2][2]; load_xfrags_lds(xr, PHL, LD, lane); state_step(acc, xr);
          if (w >= 4) {
#pragma unroll
              for (int ct = 0; ct < 4; ++ct) { acc[ct] += bf4(*(const LAS u32x2*)(PSL + (16 * (w - 4) + ln) * LD + 16 * ct + 4 * g));
                  u32x2 o; o.x = pk2(acc[ct][0], acc[ct][1]); o.y = pk2(acc[ct][2], acc[ct][3]); *(u32x2*)(PSI + cu + frag_off(16 * (w - 4) + ln, 16 * ct + 4 * g)) = o; }
          } else {
#pragma unroll
              for (int ct = 0; ct < 4; ++ct) { float v0 = acc[ct][0], v1 = acc[ct][1], v2 = acc[ct][2], v3 = acc[ct][3];
                  { const bool od = lane & 1; float t0 = od ? v0 : v1, t1 = od ? v2 : v3; t0 = __shfl_xor(t0, 1); t1 = __shfl_xor(t1, 1); if (od) { v0 = t0; v2 = t1; } else { v1 = t0; v3 = t1; } }
                  { const bool od = lane & 2; float t0 = od ? v0 : v2, t1 = od ? v1 : v3; t0 = __shfl_xor(t0, 2); t1 = __shfl_xor(t1, 2); if (od) { v0 = t0; v1 = t1; } else { v2 = t0; v3 = t1; } }
                  u32x2 o; o.x = pk2(v0, v1); o.y = pk2(v2, v3); *(u32x2*)(PHIT + cu + frag_off(16 * ct + 4 * g + (ln & 3), 16 * w + (ln & 12))) = o; } } }
        LB();
    }
    LB();
}

namespace rk {
struct FoldRegs { u32x2 x[4][2][2]; f32x4 q[4]; };
__device__ __forceinline__ void fold_load(FoldRegs& R, const bf16_t* RP, const bf16_t* RQ, int up, int rt, int lane) {
    const size_t cu = ((size_t)up * SEGC + (SEGC - 1)) * CHB;
#pragma unroll
    for (int ct = 0; ct < 4; ++ct)
#pragma unroll
        for (int ks = 0; ks < 2; ++ks) { const u32x4 v = *(const u32x4*)(RP + cu + (size_t)(ct * 64 + lane) * 16 + 8 * ks); R.x[ct][ks][0] = (u32x2){v.x, v.y}; R.x[ct][ks][1] = (u32x2){v.z, v.w}; }
#pragma unroll
    for (int ks = 0; ks < 2; ++ks) { const u32x4 v = *(const u32x4*)(RQ + cu + (size_t)(rt * 64 + lane) * 16 + 8 * ks); R.q[2 * ks] = bf4((u32x2){v.x, v.y}); R.q[2 * ks + 1] = bf4((u32x2){v.z, v.w}); }
}
__device__ __forceinline__ void fold_step(const FoldRegs& R, f32x4 (&acc)[4]) { state_step(acc, R.x);
#pragma unroll
    for (int ct = 0; ct < 4; ++ct) acc[ct] += R.q[ct]; }
}
__device__ __forceinline__ void rwkv_scan_unit(const Ctx& F, int unit) {
    using namespace rk;
    const int w = F.wave;
    const int b = unit >> 7, h = (unit >> 4) & 7, seg = unit & 15;
    int tv_ = F.tid; asm volatile("" : "+v"(tv_));
    const int lane = tv_ & 63, g = lane >> 4, ln = lane & 15;
    LAS bf16_t* ST = (LAS bf16_t*)F.lds;
    LAS float* PG = (LAS float*)(F.lds + MBY);
    const bf16_t *RP = (const bf16_t*)(F.ws + WS_PHIT), *RQ = (const bf16_t*)(F.ws + WS_PSI), *YSG = (const bf16_t*)(F.ws + WS_YS), *YLG = (const bf16_t*)(F.ws + WS_YL), *GTG = (const bf16_t*)(F.ws + WS_GT), *BVG = (const bf16_t*)(F.ws + WS_BV);
    bf16_t* YCAT = (bf16_t*)(F.ws + WS_YCAT);
    const bf16_t* SEGP = (const bf16_t*)(F.ws + WS_SEGP); const float* SEGQ = (const float*)(F.ws + WS_SEGQ);
    if (tv_ < 128) PG[tv_] = (tv_ < 64) ? F.in[I_LNXG][h * 64 + tv_] : F.in[I_LNXB][h * 64 + tv_ - 64];
    const int c = w;
    const size_t cu = (size_t)((b * 8 + h) * NCHUNK + seg * SEGC + c) * CHB, cp = c > 0 ? cu - CHB : cu;
    bf16x8 ptx[4][2]; u32x4 qv[4][2]; bf16x8 ysr[4][2];
#define SCAN_LOADS() do { \
_Pragma("unroll") \
    for (int ct = 0; ct < 4; ++ct) \
_Pragma("unroll") \
        for (int ks = 0; ks < 2; ++ks) { ptx[ct][ks] = *(const bf16x8*)(RP + cp + (size_t)(ct * 64 + lane) * 16 + 8 * ks); qv[ct][ks] = *(const u32x4*)(RQ + cp + (size_t)(ct * 64 + lane) * 16 + 8 * ks); \
            ysr[ct][ks] = *(const bf16x8*)(YSG + cu + (size_t)(ct * 64 + lane) * 16 + 8 * ks); } \
    } while (0)
    if (w < 4) SCAN_LOADS();
    if (w >= 4) {
        f32x4 acc[4];
#pragma unroll
        for (int ct = 0; ct < 4; ++ct) acc[ct] = (f32x4){0.f, 0.f, 0.f, 0.f};
        const int rt = w - 4, u0 = unit - seg; FoldRegs F0, F1, F2, F3;
        const int ul = unit > 0 ? unit - 1 : 0;
#define FLD(R, k) do { const int un_ = u0 + (k); fold_load(R, RP, RQ, un_ < ul ? un_ : ul, rt, lane); } while (0)
        FLD(F0, 0); FLD(F1, 1); FLD(F2, 2);
        for (int sp = 0; sp < seg; sp += 4) {
            FLD(F3, sp + 3); fold_step(F0, acc);
            FLD(F0, sp + 4); if (sp + 1 < seg) fold_step(F1, acc);
            FLD(F1, sp + 5); if (sp + 2 < seg) fold_step(F2, acc);
            FLD(F2, sp + 6); if (sp + 3 < seg) fold_step(F3, acc);
        }
#undef FLD
#pragma unroll
        for (int ct = 0; ct < 4; ++ct) st4bf(ST + (16 * rt + ln) * LD + 16 * ct + 4 * g, acc[ct]);
        SCAN_LOADS();
    }
#undef SCAN_LOADS
    LB();
    bf16x8 xs[4][2];
#pragma unroll
    for (int rt = 0; rt < 4; ++rt) {
        f32x4 sc[4];
        if (c > 0) {
            bf16x8 yf[2];
#pragma unroll
            for (int ks = 0; ks < 2; ++ks) { const u32x2 lo_ = *(const LAS u32x2*)(ST + (16 * rt + ln) * LD + 32 * ks + 4 * g), hi_ = *(const LAS u32x2*)(ST + (16 * rt + ln) * LD + 32 * ks + 16 + 4 * g);
                u32x4 wv; wv.x = lo_.x; wv.y = lo_.y; wv.z = hi_.x; wv.w = hi_.y; yf[ks] = __builtin_bit_cast(bf16x8, wv); }
#pragma unroll
            for (int ct = 0; ct < 4; ++ct) { u32x2 q2; if (ct & 1) { q2.x = qv[rt][ct >> 1].z; q2.y = qv[rt][ct >> 1].w; } else { q2.x = qv[rt][ct >> 1].x; q2.y = qv[rt][ct >> 1].y; } f32x4 d = bf4(q2);
#pragma unroll
                for (int ks = 0; ks < 2; ++ks) d = __builtin_amdgcn_mfma_f32_16x16x32_bf16(ptx[ct][ks], yf[ks], d, 0, 0, 0);
                sc[ct] = d; }
        } else {
#pragma unroll
            for (int ct = 0; ct < 4; ++ct) sc[ct] = bf4(*(const LAS u32x2*)(ST + (16 * rt + ln) * LD + 16 * ct + 4 * g));
        }
        state_yfrags(sc, xs[rt]);
    }
    const size_t orow0 = ((size_t)b * SEQ + (size_t)(seg * SEGC + c) * CH) * D + 512 + h * 64;
    u32x4 yl[4][2], gt[4][2], bv[4][2];
#pragma unroll
    for (int tt = 0; tt < 4; ++tt)
#pragma unroll
        for (int ks = 0; ks < 2; ++ks) { const size_t ro = cu + (size_t)(tt * 64 + lane) * 16 + 8 * ks; yl[tt][ks] = *(const u32x4*)(YLG + ro); gt[tt][ks] = *(const u32x4*)(GTG + ro); bv[tt][ks] = *(const u32x4*)(BVG + ro); }
#define H2(a, vt) (((vt) & 1) ? (u32x2){(a)[(vt) >> 1].z, (a)[(vt) >> 1].w} : (u32x2){(a)[(vt) >> 1].x, (a)[(vt) >> 1].y})
#pragma unroll
    for (int tt = 0; tt < 4; ++tt) {
        f32x4 y[4]; float s = 0.f;
#pragma unroll
        for (int vt = 0; vt < 4; ++vt) { f32x4 d = bf4(H2(yl[tt], vt));
#pragma unroll
            for (int ks = 0; ks < 2; ++ks) d = __builtin_amdgcn_mfma_f32_16x16x32_bf16(xs[vt][ks], ysr[tt][ks], d, 0, 0, 0);
            y[vt] = d; s += (d[0] + d[1]) + (d[2] + d[3]); }
        s += __shfl_xor(s, 16); s += __shfl_xor(s, 32);
        const float mean = s * (1.0f / 64.0f); float qq = 0.f;
#pragma unroll
        for (int vt = 0; vt < 4; ++vt) { y[vt] = y[vt] - mean; qq += (y[vt][0] * y[vt][0] + y[vt][1] * y[vt][1]) + (y[vt][2] * y[vt][2] + y[vt][3] * y[vt][3]); }
        qq += __shfl_xor(qq, 16); qq += __shfl_xor(qq, 32);
        const float rstd = __builtin_amdgcn_rsqf(qq * (1.0f / 64.0f) + 64e-5f);
        const size_t orow = orow0 + (size_t)(16 * tt + ln) * D;
#pragma unroll
        for (int vt = 0; vt < 4; ++vt) { const f32x4 lg4 = *(const LAS f32x4*)(PG + 16 * vt + 4 * g), lb4 = *(const LAS f32x4*)(PG + 64 + 16 * vt + 4 * g);
            const f32x4 o = (y[vt] * rstd * lg4 + lb4 + bf4(H2(bv[tt], vt))) * bf4(H2(gt[tt], vt)); u32x2 ow; ow.x = pk2(o[0], o[1]); ow.y = pk2(o[2], o[3]);
            *(u32x2*)(YCAT + orow + 16 * vt + 4 * g) = ow; }
    }
#undef H2
    LB();
}

__device__ __forceinline__ void router_phase(const Ctx& F) {
    const int tid = F.tid, lane = F.lane, w = F.wave;
    constexpr int LDX = 1028;
    LAS float* X = (LAS float*)F.lds;
    LAS float* RS = (LAS float*)(F.lds + 32 * LDX * 4);
    LAS float* LOG = RS + 32;
    LAS int* LCNT = (LAS int*)(LOG + 32 * 33);
    const float* H1 = (const float*)(F.ws + WS_H1); unsigned char* HN2 = F.ws + WS_HN2; const float* RW = (const float*)(F.ws + WS_RW);
    int* CNT = (int*)(F.ws + WS_CNT); int* RIDX = (int*)(F.ws + WS_RIDX); float* RGATE = (float*)(F.ws + WS_RGATE); int* RRANK = (int*)(F.ws + WS_RRANK);
    f32x4 gv[4];
#pragma unroll
    for (int j = 0; j < 4; ++j) gv[j] = *((const f32x4*)F.in[I_N2G] + lane + 64 * j);
    for (int tile = F.vcu; tile < NRT; tile += F.G) {
        f32x4 vr[4][4];
#pragma unroll
        for (int rr = 0; rr < 4; ++rr) { const f32x4* xr = (const f32x4*)(H1 + ((size_t)tile * RT_TOK + w * 4 + rr) * D) + lane;
#pragma unroll
            for (int j = 0; j < 4; ++j) vr[rr][j] = xr[64 * j]; }
#pragma unroll
        for (int rr = 0; rr < 4; ++rr) { const int row = w * 4 + rr; const size_t m = (size_t)tile * RT_TOK + row;
            f32x4 v[4]; float s = 0.f;
#pragma unroll
            for (int j = 0; j < 4; ++j) { v[j] = vr[rr][j]; s += (v[j].x * v[j].x + v[j].y * v[j].y) + (v[j].z * v[j].z + v[j].w * v[j].w); }
            const float rstd = __builtin_amdgcn_rsqf(wave_sum(s) * (1.0f / D) + 1e-5f);
            unsigned* o4 = (unsigned*)(HN2 + m * D) + lane;
#pragma unroll
            for (int j = 0; j < 4; ++j) { o4[64 * j] = pk4_fp8(v[j].x * rstd * gv[j].x, v[j].y * rstd * gv[j].y, v[j].z * rstd * gv[j].z, v[j].w * rstd * gv[j].w);
                *(LAS f32x4*)(X + row * LDX + 4 * (lane + 64 * j)) = v[j]; }
            if (lane == 0) RS[row] = rstd; }
        WG_BAR();
        f32x16 acc;
#pragma unroll
        for (int r = 0; r < 16; ++r) acc[r] = 0.f;
        { const int i = lane & 31, hh = lane >> 5;
#pragma unroll 4
          for (int kg = 0; kg < 16; ++kg) { const int kb = 128 * w + 8 * kg + 4 * hh; const f32x4 xa = *(const LAS f32x4*)(X + i * LDX + kb);
#pragma unroll
              for (int j = 0; j < 4; ++j) acc = __builtin_amdgcn_mfma_f32_32x32x2f32(xa[j], RW[(kb + j) * NEXP + i], acc, 0, 0, 0); } }
        WG_BAR();
#pragma unroll
        for (int r = 0; r < 16; ++r) { const int tok = (r & 3) + 8 * (r >> 2) + 4 * (lane >> 5); X[(w * 32 + tok) * 33 + (lane & 31)] = acc[r]; }
        WG_BAR();
#pragma unroll
        for (int q = 0; q < 2; ++q) { const int idx = tid + 512 * q, tok = idx >> 5, e = idx & 31; float s = 0.f;
#pragma unroll
            for (int ww = 0; ww < 8; ++ww) s += X[(ww * 32 + tok) * 33 + e];
            LOG[tok * 33 + e] = s * RS[tok] + F.in[I_RB][e]; }
        if (tid < 32) LCNT[tid] = 0;
        WG_BAR();
        {
            const int e = lane & 31;
#pragma unroll
            for (int it = 0; it < 2; ++it) { const int tok = w * 4 + 2 * it + (lane >> 5); float val = LOG[tok * 33 + e]; float tv[4]; int ti[4];
#pragma unroll
                for (int p = 0; p < 4; ++p) { float cand = val; int idx = e;
#pragma unroll
                    for (int d = 1; d < 32; d <<= 1) { const float ov = __shfl_xor(cand, d); const int oi = __shfl_xor(idx, d); const bool take = (ov > cand) || (ov == cand && oi < idx); cand = take ? ov : cand; idx = take ? oi : idx; }
                    tv[p] = cand; ti[p] = idx; if (e == idx) val = -3.0e38f; }
                float ex[4], es = 0.f;
#pragma unroll
                for (int p = 0; p < 4; ++p) { ex[p] = __expf(tv[p] - tv[0]); es += ex[p]; }
                const float inv = __builtin_amdgcn_rcpf(es); const size_t m = (size_t)tile * RT_TOK + tok;
#pragma unroll
                for (int p = 0; p < 4; ++p) if (e == ti[p]) { const int rk = atomicAdd((int*)(LCNT + e), 1); RIDX[m * 4 + p] = e; RGATE[m * 4 + p] = ex[p] * inv; RRANK[m * 4 + p] = rk; }
            }
        }
        WG_BAR();
        if (tid < 32) CNT[tile * 32 + tid] = LCNT[tid];
        WG_BAR();
    }
}

__device__ __forceinline__ void scatter_phase(const Ctx& F) {
    const int tid = F.tid;
    LAS int* PS = (LAS int*)F.lds;
    LAS int* PAD = PS + 512;
    LAS int* BASE = PAD + 64;
    const int* CNT = (const int*)(F.ws + WS_CNT); const int* RIDX = (const int*)(F.ws + WS_RIDX); const float* RGATE = (const float*)(F.ws + WS_RGATE); const int* RRANK = (const int*)(F.ws + WS_RRANK);
    int* TDEST = (int*)(F.ws + WS_TDEST); int* ROWTOK = (int*)(F.ws + WS_ROWTOK); float* ROWGATE = (float*)(F.ws + WS_ROWGATE); int* ETAB = (int*)(F.ws + WS_ETAB);
    { const int e = tid & 31, p = tid >> 5; int sm = 0;
#pragma unroll
      for (int j = 0; j < 32; ++j) sm += CNT[(32 * p + j) * 32 + e];
      PS[p * 32 + e] = sm; }
    WG_BAR();
    if (tid < 64) { const int e = tid & 31; int tot = 0;
#pragma unroll
        for (int p = 0; p < 16; ++p) tot += PS[p * 32 + e];
        const int padn = (tot + 255) & ~255; int inc = padn;
#pragma unroll
        for (int d = 1; d < 32; d <<= 1) { const int o = __shfl_up(inc, d, 32); inc += (e >= d) ? o : 0; }
        if (tid < 32) { PAD[e] = inc - padn; if (e == 31) PAD[32] = inc; } }
    WG_BAR();
    if (F.vcu == 0 && tid < 33) ETAB[tid] = PAD[tid];
    for (int tile = F.vcu; tile < NRT; tile += F.G) {
        if (tid < 32) { const int p = tile >> 5; int sm = PAD[tid];
#pragma unroll
            for (int pp = 0; pp < 16; ++pp) sm += (pp < p) ? PS[pp * 32 + tid] : 0;
#pragma unroll
            for (int j = 0; j < 32; ++j) { const int v = CNT[(32 * p + j) * 32 + tid]; sm += (32 * p + j < tile) ? v : 0; }
            BASE[tid] = sm; }
        WG_BAR();
        if (tid < 128) { const size_t ix = (size_t)tile * 128 + tid; const int e = RIDX[ix]; const int dest = BASE[e] + RRANK[ix];
            ROWTOK[dest] = (int)(ix >> 2); ROWGATE[dest] = RGATE[ix]; TDEST[ix] = dest; }
        WG_BAR();
    }
}

struct CombRows { f32x4 v[4]; unsigned y[4][4]; };
__device__ __forceinline__ void comb_load(CombRows& R, const float* H1, const unsigned char* YOUT, const int4 td, int m, int lane) {
    const f32x4* xr = (const f32x4*)(H1 + (size_t)m * D) + lane;
#pragma unroll
    for (int j = 0; j < 4; ++j) R.v[j] = __builtin_nontemporal_load(xr + 64 * j);
    const int dd[4] = {td.x, td.y, td.z, td.w};
#pragma unroll
    for (int p = 0; p < 4; ++p) { const unsigned* yr = (const unsigned*)(YOUT + (size_t)dd[p] * D) + lane;
#pragma unroll
        for (int j = 0; j < 4; ++j) R.y[p][j] = __builtin_nontemporal_load(yr + 64 * j); }
}
__device__ __forceinline__ void comb_store(const CombRows& R, const f32x4 (&gv)[4], float* out, int m, int lane) {
    f32x4 v[4]; float s = 0.f;
#pragma unroll
    for (int j = 0; j < 4; ++j) { v[j] = R.v[j];
#pragma unroll
        for (int p = 0; p < 4; ++p) { const unsigned y = R.y[p][j]; const f32x2 lo = __builtin_amdgcn_cvt_pk_f32_fp8(y, false), hi = __builtin_amdgcn_cvt_pk_f32_fp8(y, true);
            v[j].x += lo.x * (1.0f / FP8_SY); v[j].y += lo.y * (1.0f / FP8_SY); v[j].z += hi.x * (1.0f / FP8_SY); v[j].w += hi.y * (1.0f / FP8_SY); }
        s += (v[j].x * v[j].x + v[j].y * v[j].y) + (v[j].z * v[j].z + v[j].w * v[j].w); }
    const float rstd = __builtin_amdgcn_rsqf(wave_sum(s) * (1.0f / D) + 1e-5f);
    f32x4* o = (f32x4*)(out + (size_t)m * D) + lane;
#pragma unroll
    for (int j = 0; j < 4; ++j) __builtin_nontemporal_store(v[j] * rstd * gv[j], o + 64 * j);
}
__device__ __forceinline__ void combine_phase(const Ctx& F, float* out) {
    const int lane = F.lane; const int gw = F.vcu * 8 + F.wave, NGW = F.G * 8;
    const float* H1 = (const float*)(F.ws + WS_H1); const unsigned char* YOUT = F.ws + WS_YOUT; const int4* TDEST = (const int4*)(F.ws + WS_TDEST);
    f32x4 gv[4];
#pragma unroll
    for (int j = 0; j < 4; ++j) gv[j] = *((const f32x4*)F.in[I_FG] + lane + 64 * j);
    for (int m0 = gw; m0 < M; m0 += 8 * NGW) {
        int4 td[8];
#pragma unroll
        for (int i = 0; i < 8; ++i) { const int m = m0 + i * NGW; td[i] = TDEST[m < M ? m : M - 1]; }
        CombRows A, B;
        comb_load(A, H1, YOUT, td[0], m0, lane);
#pragma unroll
        for (int i = 0; i < 8; i += 2) {
            { const int m = m0 + (i + 1) * NGW; comb_load(B, H1, YOUT, td[i + 1], m < M ? m : M - 1, lane); }
            { const int m = m0 + i * NGW; if (m < M) comb_store(A, gv, out, m, lane); }
            if (i + 2 < 8) { const int m = m0 + (i + 2) * NGW; comb_load(A, H1, YOUT, td[i + 2], m < M ? m : M - 1, lane); }
            { const int m = m0 + (i + 1) * NGW; if (m < M) comb_store(B, gv, out, m, lane); }
        }
    }
}

__global__ void __launch_bounds__(512, 2) mk_fwd(Args args) {
    extern __shared__ __attribute__((aligned(16))) unsigned char lds_raw[];
    Ctx F;
    F.lds = (LAS unsigned char*)lds_raw;
    F.tid = threadIdx.x; F.lane = F.tid & 63; F.wave = __builtin_amdgcn_readfirstlane(F.tid >> 6);
    F.G = gridDim.x; { const int bx = blockIdx.x; F.vcu = (F.G % 8 == 0) ? (bx % 8) * (F.G / 8) + bx / 8 : bx; }
    F.ws = args.ws; F.in = args.in;
    volatile LAS unsigned* MISC = (volatile LAS unsigned*)(F.lds + MISC_OFF);
    if (F.tid < 64) MISC[F.tid] = 0u;
    __syncthreads();
    unsigned* ctl = (unsigned*)(args.ws + WS_CTL);
    XcdBarrier bar; bar.bar = ctl + CW_BAR; bar.x = 0; bar.st = nullptr;
    const int lo = args.ph_lo, hi = args.ph_hi;
    if (hi - lo > 1) bar = xcd_barrier_post(ctl + CW_BAR + args.li * XCD_BAR_WORDS, MISC + 8);
#define IN(k) (lo <= (k) && (k) < hi)
#define SEAM(k) do { if (IN(k) && IN((k) + 1)) xcd_barrier(bar); } while (0)
    unsigned char* ws = args.ws;

    if (IN(0)) REP(0) { p0_prologue(F); } SEAM(0);
    if (IN(1)) REP(1) {
        pg8::Gemm g{(const bf16_t*)(ws + WS_XN), (const bf16_t*)(ws + WS_WCAT), M, NPROJ, D}; pg8::StaticOrder S; S.init(M, NPROJ, D, F.G, (int)blockIdx.x);
        pg8::EpiProj E{(bf16_t*)(ws + WS_PROJ), NPROJ, 4};
        pg8::gemm_phase<pg8::EpiProj, pg8::StaticOrder, false>(F.lds, g, S, E);
    } SEAM(1);
    if (IN(2)) REP(2) { REP(10) sgu_phase(F); for (int u = F.vcu; u < NRU; u += F.G) rwkv_prep_unit(F, u); } SEAM(2);
    if (IN(3)) REP(3) { for (int u = F.vcu; u < NRU; u += F.G) rwkv_scan_unit(F, u); } SEAM(3);
    if (IN(4)) REP(4) {
        pg8::Gemm g{(const bf16_t*)(ws + WS_YCAT), (const bf16_t*)(ws + WS_WOUT), M, D, D}; pg8::StaticOrder S; S.init(M, D, D, F.G, (int)blockIdx.x);
        pg8::EpiResF32 E{F.in[I_X], (float*)(ws + WS_H1), D};
        pg8::gemm_phase<pg8::EpiResF32, pg8::StaticOrder, false>(F.lds, g, S, E);
    } SEAM(4);
    if (IN(5)) REP(5) { router_phase(F); } SEAM(5);
    if (IN(6)) REP(6) { scatter_phase(F); moe_weight_phase(F); } SEAM(6);
    if (IN(7)) REP(7) {
        const int* etab = (const int*)(ws + WS_ETAB);
        pg8::MoeOrder S; S.ntiles = etab[32] >> 8; S.nN = NHID / 256; S.G = F.G; S.c = (int)blockIdx.x; S.K = D; S.N = NHID; S.pad_start = etab; S.rowtok = (const int*)(ws + WS_ROWTOK); S.build_texp(F.lds);
        pg8::Gemm g{(const bf16_t*)(ws + WS_HN2), (const bf16_t*)(ws + WS_W1T), MAXROWS, NHID, D};
        pg8::EpiSwiglu E{ws + WS_ACT, F.in[I_MB1], &S};
        pg8::gemm_phase<pg8::EpiSwiglu, pg8::MoeOrder, true, true>(F.lds, g, S, E);
    } SEAM(7);
    if (IN(8)) REP(8) {
        const int* etab = (const int*)(ws + WS_ETAB);
        pg8::MoeOrder S; S.ntiles = etab[32] >> 8; S.nN = D / 256; S.G = F.G; S.c = (int)blockIdx.x; S.K = DEXP; S.N = D; S.pad_start = etab; S.rowtok = nullptr; S.build_texp(F.lds);
        pg8::Gemm g{(const bf16_t*)(ws + WS_ACT), (const bf16_t*)(ws + WS_W2T), MAXROWS, D, DEXP};
        pg8::EpiGate E{ws + WS_YOUT, F.in[I_MB2], (const float*)(ws + WS_ROWGATE), &S};
        pg8::gemm_phase<pg8::EpiGate, pg8::MoeOrder, false, true>(F.lds, g, S, E);
    } SEAM(8);
    if (IN(9)) REP(9) { combine_phase(F, args.out); }
#undef IN
#undef SEAM
}

extern "C" void kernel_launch(void* const* d_in, const int* in_sizes, int n_in, void* d_out, int out_size, void* d_ws, size_t ws_size, hipStream_t stream) {
    static int grid = 0;
    if (grid == 0) {
        if (n_in != 31 || in_sizes[0] != M * D || out_size != M * D || ws_size < WS_END) { fprintf(stderr, "kernel_launch: unexpected problem (n_in %d, out %d, ws %zu); nothing launched\n", n_in, out_size, ws_size); grid = -1; return; }
        int dev = 0, cus = 0, per_cu = 0;
        if (hipGetDevice(&dev) != hipSuccess || hipDeviceGetAttribute(&cus, hipDeviceAttributeMultiprocessorCount, dev) != hipSuccess) { grid = -1; return; }
        if (hipFuncSetAttribute((const void*)mk_fwd, hipFuncAttributeMaxDynamicSharedMemorySize, LDS_BYTES) != hipSuccess) { fprintf(stderr, "kernel_launch: hipFuncSetAttribute failed\n"); grid = -1; return; }
        if (hipOccupancyMaxActiveBlocksPerMultiprocessor(&per_cu, (const void*)mk_fwd, 512, LDS_BYTES) != hipSuccess || per_cu < 1) fprintf(stderr, "kernel_launch: occupancy query reports %d\n", per_cu);
        (void)hipGetLastError();
        grid = cus;
    }
    if (grid < 0) return;
    if (hipMemsetAsync((char*)d_ws + WS_CTL, 0, CTL_ZERO_BYTES, stream) != hipSuccess) return;
    Args a; memset(&a, 0, sizeof(a));
    for (int i = 0; i < 31; ++i) a.in[i] = (const float*)d_in[i];
    a.out = (float*)d_out; a.ws = (unsigned char*)d_ws;
    constexpr int NL = MK_N_LAUNCHES;
    static_assert(NL == 1 || NL == N_PHASES, "MK_N_LAUNCHES: 1 (one launch) or 10 (one launch per phase)");
    for (int li = 0; li < NL; ++li) {
        a.ph_lo = (NL == 1) ? 0 : li; a.ph_hi = (NL == 1) ? N_PHASES : li + 1; a.li = 0; a.pad = 0;
        hipLaunchKernelGGL(mk_fwd, dim3(grid), dim3(512), LDS_BYTES, stream, a);
    }
}
```

```cpp
#include <hip/hip_runtime.h>
#include <cstdio>
#include <cstdint>
#include <cstring>

#ifndef MK_N_LAUNCHES
#define MK_N_LAUNCHES 1
#endif
constexpr int N_PHASES = 10;
#ifndef PROBE_MASK
#define PROBE_MASK 0
#endif
#define REP(k) for (int rep_ = 0; rep_ < (((PROBE_MASK >> (k)) & 1) ? 2 : 1); ++rep_)

#define LAS __attribute__((address_space(3)))
#define GAS __attribute__((address_space(1)))
typedef unsigned short bf16_t;
typedef short bf16x8 __attribute__((ext_vector_type(8)));
typedef float f32x4 __attribute__((ext_vector_type(4)));
typedef float f32x2 __attribute__((ext_vector_type(2)));
typedef float f32x16 __attribute__((ext_vector_type(16)));
typedef unsigned u32x4 __attribute__((ext_vector_type(4)));
typedef unsigned u32x2 __attribute__((ext_vector_type(2)));
typedef GAS unsigned gu32;
#define RLX_AGENT __ATOMIC_RELAXED, __HIP_MEMORY_SCOPE_AGENT
#define LDS_WAIT() asm volatile("s_waitcnt lgkmcnt(0)" ::: "memory")
#define VM_WAIT() asm volatile("s_waitcnt vmcnt(0)" ::: "memory")
#define WG_BAR() do { asm volatile("s_waitcnt vmcnt(0) lgkmcnt(0)" ::: "memory"); __builtin_amdgcn_s_barrier(); asm volatile("" ::: "memory"); } while (0)

constexpr int BATCH = 2, SEQ = 8192, D = 1024, M = BATCH * SEQ;
constexpr int NPROJ = 3072;
constexpr int COL_V = 512, COL_R = 1024, COL_K = 1536, COL_VR = 2048, COL_LA = 2560, COL_LB = 2816;
constexpr int NEXP = 32, TOPK = 4, DEXP = 1024, NHID = 2048;
constexpr int NASSIGN = M * TOPK;
constexpr int MAXROWS = NASSIGN + NEXP * 256;
constexpr int RT_TOK = 32, NRT = M / RT_TOK;
constexpr int CH = 64, NCHUNK = SEQ / CH, SEGC = 8, NSEG = NCHUNK / SEGC;
constexpr int NRU = BATCH * 8 * NSEG;

constexpr size_t MiB = 1u << 20;
constexpr size_t WS_CTL = 0, CTL_ZERO_BYTES = 13824;
constexpr size_t WS_WCAT = 2 * MiB;
constexpr size_t WS_WOUT = 8 * MiB;
constexpr size_t WS_SMALL = 10 * MiB;
constexpr size_t WS_LW2 = WS_SMALL;
constexpr size_t WS_LA2 = WS_LW2 + 512 * 64 * 2;
constexpr size_t WS_LG2 = WS_LA2 + 512 * 64 * 2;
constexpr size_t WS_SGUW = WS_LG2 + 512 * 128 * 2;
constexpr size_t WS_RW = WS_SGUW + 8 * 128 * 128 * 2;
constexpr size_t WS_ETAB = WS_RW + 1024 * 32 * 4;
constexpr size_t WS_CNT = WS_ETAB + 1024;
constexpr size_t WS_RIDX = WS_CNT + NRT * 32 * 4;
constexpr size_t WS_RGATE = WS_RIDX + (size_t)M * 4 * 4;
constexpr size_t WS_RRANK = WS_RGATE + (size_t)M * 4 * 4;
constexpr size_t WS_TDEST = WS_RRANK + (size_t)M * 4 * 4;
static_assert(WS_TDEST + (size_t)M * 4 * 4 <= 12 * MiB, "small region");
constexpr size_t WS_ROWTOK = 12 * MiB;
constexpr size_t WS_ROWGATE = 13 * MiB;
constexpr size_t WS_SEGP = 14 * MiB;
constexpr size_t WS_SEGQ = 16 * MiB;
constexpr size_t WS_XN = 32 * MiB;
constexpr size_t WS_YCAT = 64 * MiB;
constexpr size_t WS_HN2 = 96 * MiB;
constexpr size_t WS_H1 = 128 * MiB;
constexpr size_t WS_PROJ = 192 * MiB;
constexpr size_t WS_W1T = 288 * MiB;
constexpr size_t WS_W2T = 416 * MiB;
constexpr size_t WS_ACT = 480 * MiB;
constexpr size_t WS_YOUT = 624 * MiB;
constexpr size_t WS_RK = 768 * MiB;
constexpr size_t WS_PHIT = WS_RK, WS_PSI = WS_RK + 8192, WS_YS = WS_RK + 16384, WS_YL = WS_RK + 24576, WS_GT = WS_RK + 32768, WS_BV = WS_RK + 40960;
constexpr size_t WS_END = 864 * MiB;
constexpr int CW_BAR = 0;

constexpr int RING_BYTES = 131072;
constexpr int TAB_OFF = 151552;
constexpr int TEXP_OFF = TAB_OFF + 2048;
constexpr int LDS_BYTES = 155648;
constexpr int MISC_OFF = LDS_BYTES - 256;

typedef __bf16 bf16v2_t __attribute__((ext_vector_type(2)));
__device__ __forceinline__ unsigned pk2(float lo, float hi) { const f32x2 v = {lo, hi}; return __builtin_bit_cast(unsigned, __builtin_convertvector(v, bf16v2_t)); }
__device__ __forceinline__ unsigned f2bf(float f) { return pk2(f, 0.f) & 0xffffu; }
__device__ __forceinline__ float bf2f(unsigned short b) { return __builtin_bit_cast(float, (unsigned)b << 16); }
__device__ __forceinline__ float bflo(unsigned w) { return __builtin_bit_cast(float, w << 16); }
__device__ __forceinline__ float bfhi(unsigned w) { return __builtin_bit_cast(float, w & 0xffff0000u); }
__device__ __forceinline__ void unpack8(const u32x4 w, float (&o)[8]) { o[0] = bflo(w.x); o[1] = bfhi(w.x); o[2] = bflo(w.y); o[3] = bfhi(w.y); o[4] = bflo(w.z); o[5] = bfhi(w.z); o[6] = bflo(w.w); o[7] = bfhi(w.w); }
__device__ __forceinline__ u32x4 pack8(const float (&v)[8]) { u32x4 w; w.x = pk2(v[0], v[1]); w.y = pk2(v[2], v[3]); w.z = pk2(v[4], v[5]); w.w = pk2(v[6], v[7]); return w; }
__device__ __forceinline__ float fsigmoid(float x) { return __builtin_amdgcn_rcpf(1.0f + __expf(-x)); }
__device__ __forceinline__ unsigned pk4_fp8(float a, float b, float c, float d) {
    a = fminf(fmaxf(a, -448.f), 448.f); b = fminf(fmaxf(b, -448.f), 448.f); c = fminf(fmaxf(c, -448.f), 448.f); d = fminf(fmaxf(d, -448.f), 448.f);
    unsigned w = 0u; w = __builtin_amdgcn_cvt_pk_fp8_f32(a, b, w, false); w = __builtin_amdgcn_cvt_pk_fp8_f32(c, d, w, true); return w; }
constexpr float FP8_SW = 64.0f;
constexpr float FP8_SA = 4.0f;
constexpr float FP8_SY = 16.0f;
__device__ __forceinline__ float wave_sum(float v) {
#pragma unroll
    for (int o = 1; o < 64; o <<= 1) v += __shfl_xor(v, o);
    return v;
}

namespace pg8 {
constexpr int BM = 256, BK = 64, HALF = 128, HTB = HALF * BK * 2, STAGE_BYTES = 8 * HTB, NXCD = 8, WGM = 8;
__host__ __device__ __forceinline__ int lds_byte(int r, int c) { const int st = (r >> 4) * 2 + (c >> 5), rr = r & 15, cc = c & 31, ob = rr * 64 + cc * 2; return st * 1024 + (ob ^ (((ob >> 9) & 1) << 5)); }
__host__ __device__ __forceinline__ void stage_rc(int b, int& R, int& C) { const int st = b / 1024, sb = b % 1024, swz = sb ^ (((sb >> 9) & 1) << 5); R = (st >> 1) * 16 + swz / 64; C = (st & 1) * 32 + (swz % 64) / 2; }
__host__ __device__ __forceinline__ int perm32(int rho) { const int n = rho >> 4, i = rho & 15; return 8 * (i >> 2) + 4 * n + (i & 3); }

struct Unit { int pm, pn; };
struct Gemm { const bf16_t* A; const bf16_t* Bt; int M, N, K; };

struct StaticOrder {
    int nM, nN, nwg, G, c, K;
    __device__ void init(int M_, int N_, int K_, int G_, int c_) { nM = M_ / BM; nN = N_ / BM; nwg = nM * nN; G = G_; c = c_; K = K_ * 2; }
    __device__ bool next(int i, Unit& u) const {
        const long L = (long)i * G + c; if (L >= nwg) return false;
        int wgid = (int)L; { const int q = nwg / NXCD, r = nwg % NXCD, xcd = wgid % NXCD, off = wgid / NXCD; wgid = (xcd < r ? xcd * (q + 1) : r * (q + 1) + (xcd - r) * q) + off; }
        const int nig = WGM * nN, gid = wgid / nig, fm = gid * WGM, gsz = (nM - fm) < WGM ? (nM - fm) : WGM;
        u.pm = fm + ((wgid % nig) % gsz); u.pn = (wgid % nig) / gsz; return true;
    }
    __device__ __forceinline__ size_t a_off(const Unit& u) const { return (size_t)u.pm * BM * K; }
    __device__ __forceinline__ size_t b_off(const Unit& u) const { return (size_t)u.pn * BM * K; }
    __device__ __forceinline__ const int* rows(const Unit&) const { return nullptr; }
};
struct MoeOrder {
    int ntiles, nN, G, c, K, N; const int* pad_start; const int* rowtok; const LAS unsigned char* texp;
    __device__ __forceinline__ int expert_of(int pm) const { return (int)texp[pm]; }
    __device__ __forceinline__ void build_texp(LAS unsigned char* lds) { LAS unsigned char* t = lds + TEXP_OFF;
        for (int pm = (int)threadIdx.x; pm < MAXROWS / BM; pm += 512) { const int r0 = pm * BM; int e = 0;
            for (int j = 1; j < NEXP; ++j) if (pad_start[j] <= r0) e = j;
            t[pm] = (unsigned char)e; }
        texp = t; WG_BAR(); }
    __device__ bool next(int i, Unit& u) const { const long L = (long)i * G + c; if (L >= (long)ntiles * nN) return false; u.pm = (int)(L / nN); u.pn = (int)(L % nN); return true; }
    __device__ __forceinline__ size_t a_off(const Unit& u) const { return (size_t)u.pm * BM * K; }
    __device__ __forceinline__ size_t b_off(const Unit& u) const { return ((size_t)expert_of(u.pm) * N + (size_t)u.pn * BM) * K; }
    __device__ __forceinline__ const int* rows(const Unit& u) const { return rowtok + u.pm * BM; }
};

__device__ __forceinline__ unsigned cvt_pk_bf16(float lo, float hi) { unsigned r; asm volatile("v_cvt_pk_bf16_f32 %0, %1, %2" : "=v"(r) : "v"(lo), "v"(hi)); return r; }
__device__ __forceinline__ f32x2 gelu_pk(f32x2 v) {
    const f32x2 av = __builtin_elementwise_abs(v), d = av * 0.2316418882f + 1.0f;
    f32x2 t; t.x = __builtin_amdgcn_rcpf(d.x); t.y = __builtin_amdgcn_rcpf(d.y);
    f32x2 q = t * 0.5307027145f + (-0.7265760135f); q = q * t + 0.7107068705f; q = q * t + (-0.142248368f); q = q * t + 0.127414796f; q = q * t;
    const f32x2 s = (v * v) * (-0.72134752044f);
    f32x2 e; e.x = __builtin_amdgcn_exp2f(s.x); e.y = __builtin_amdgcn_exp2f(s.y);
    const f32x2 m = v * (q * e), r = v - m;
    f32x2 o; o.x = v.x < 0.f ? m.x : r.x; o.y = v.y < 0.f ? m.y : r.y; return o;
}
struct EpiProj {
    static constexpr bool PERM = true;
    bf16_t* O; int ldc; int ngelu;
    __device__ __forceinline__ void operator()(const f32x4 (&acc)[2][2][4][2], const Unit& u, int wr, int wc, int fr, int fq) const {
        const int row0 = u.pm * BM + wr * 64 + fr, col0 = u.pn * BM + wc * 32 + 8 * fq; const bool act = u.pn < ngelu;
#pragma unroll
        for (int ai = 0; ai < 2; ++ai)
#pragma unroll
            for (int m = 0; m < 4; ++m) { bf16_t* rowp = O + (size_t)(row0 + ai * HALF + m * 16) * ldc + col0;
#pragma unroll
                for (int bj = 0; bj < 2; ++bj) { f32x4 v0 = acc[ai][bj][m][0], v1 = acc[ai][bj][m][1];
                    if (act) { f32x2 a = gelu_pk((f32x2){v0[0], v0[1]}), b = gelu_pk((f32x2){v0[2], v0[3]}), c = gelu_pk((f32x2){v1[0], v1[1]}), d = gelu_pk((f32x2){v1[2], v1[3]});
                        v0 = (f32x4){a.x, a.y, b.x, b.y}; v1 = (f32x4){c.x, c.y, d.x, d.y}; }
                    u32x4 w; w.x = cvt_pk_bf16(v0[0], v0[1]); w.y = cvt_pk_bf16(v0[2], v0[3]); w.z = cvt_pk_bf16(v1[0], v1[1]); w.w = cvt_pk_bf16(v1[2], v1[3]);
                    *(u32x4*)(rowp + bj * HALF) = w; } }
    }
};
struct EpiResF32 {
    static constexpr bool PERM = false;
    const float* base; float* out; int ldc;
    __device__ __forceinline__ void operator()(const f32x4 (&acc)[2][2][4][2], const Unit& u, int wr, int wc, int fr, int fq) const {
        const int col0 = u.pn * BM + wc * 32 + 4 * fq;
#pragma unroll
        for (int ai = 0; ai < 2; ++ai)
#pragma unroll
            for (int m = 0; m < 4; ++m) { const size_t off = (size_t)(u.pm * BM + ai * HALF + wr * 64 + m * 16 + fr) * ldc + col0;
#pragma unroll
                for (int bj = 0; bj < 2; ++bj)
#pragma unroll
                    for (int n = 0; n < 2; ++n) { const f32x4 bs = *(const f32x4*)(base + off + bj * HALF + n * 16); *(f32x4*)(out + off + bj * HALF + n * 16) = bs + acc[ai][bj][m][n]; } }
    }
};
struct EpiSwiglu {
    static constexpr bool PERM = true;
    unsigned char* O; const float* b1; const MoeOrder* S;
    __device__ __forceinline__ void operator()(const f32x4 (&acc)[2][2][4][2], const Unit& u, int wr, int wc, int fr, int fq) const {
        const int e = S->expert_of(u.pm); const int row0 = u.pm * BM + wr * 64 + fr, oc0 = u.pn * HALF + wc * 32 + 8 * fq;
        const float* bp = b1 + (size_t)e * NHID + 2 * oc0;
        f32x4 bg[2], bl[2];
#pragma unroll
        for (int n = 0; n < 2; ++n) { const f32x4 x0 = *(const f32x4*)(bp + 8 * n), x1 = *(const f32x4*)(bp + 8 * n + 4); bg[n] = (f32x4){x0[0], x0[2], x1[0], x1[2]}; bl[n] = (f32x4){x0[1], x0[3], x1[1], x1[3]}; }
#pragma unroll
        for (int ai = 0; ai < 2; ++ai)
#pragma unroll
            for (int m = 0; m < 4; ++m) { unsigned char* rowp = O + (size_t)(row0 + ai * HALF + m * 16) * DEXP + oc0; float o[8];
#pragma unroll
                for (int n = 0; n < 2; ++n) { const f32x4 g = acc[ai][0][m][n] * (1.0f / FP8_SW) + bg[n], l = acc[ai][1][m][n] * (1.0f / FP8_SW) + bl[n];
#pragma unroll
                    for (int q = 0; q < 4; ++q) { const float gg = fminf(g[q], 7.0f), ll = __builtin_amdgcn_fmed3f(l[q], -7.0f, 7.0f);
                        const float sg = gg * __builtin_amdgcn_rcpf(1.0f + __builtin_amdgcn_exp2f(gg * (-1.702f * 1.4426950408889634f)));
                        o[4 * n + q] = sg * __builtin_fmaf(ll, FP8_SA, FP8_SA); } }
                u32x2 w; { unsigned w0 = 0u; w0 = __builtin_amdgcn_cvt_pk_fp8_f32(o[0], o[1], w0, false); w0 = __builtin_amdgcn_cvt_pk_fp8_f32(o[2], o[3], w0, true); w.x = w0; }
                { unsigned w1 = 0u; w1 = __builtin_amdgcn_cvt_pk_fp8_f32(o[4], o[5], w1, false); w1 = __builtin_amdgcn_cvt_pk_fp8_f32(o[6], o[7], w1, true); w.y = w1; }
                *(u32x2*)rowp = w; }
    }
};
struct EpiGate {
    static constexpr bool PERM = true;
    unsigned char* O; const float* b2; const float* rowgate; const MoeOrder* S;
    __device__ __forceinline__ void operator()(const f32x4 (&acc)[2][2][4][2], const Unit& u, int wr, int wc, int fr, int fq) const {
        const int e = S->expert_of(u.pm); const int row0 = u.pm * BM + wr * 64 + fr, col0 = u.pn * BM + wc * 32 + 8 * fq;
        f32x4 bv[2][2];
#pragma unroll
        for (int bj = 0; bj < 2; ++bj)
#pragma unroll
            for (int n = 0; n < 2; ++n) bv[bj][n] = *(const f32x4*)(b2 + (size_t)e * D + col0 + bj * HALF + 4 * n);
#pragma unroll
        for (int ai = 0; ai < 2; ++ai)
#pragma unroll
            for (int m = 0; m < 4; ++m) { const int row = row0 + ai * HALF + m * 16; const float gt = rowgate[row] * FP8_SY; unsigned char* rowp = O + (size_t)row * D + col0;
#pragma unroll
                for (int bj = 0; bj < 2; ++bj) { const f32x4 v0 = (acc[ai][bj][m][0] * (1.0f / (FP8_SW * FP8_SA)) + bv[bj][0]) * gt, v1 = (acc[ai][bj][m][1] * (1.0f / (FP8_SW * FP8_SA)) + bv[bj][1]) * gt;
                    u32x2 w; w.x = pk4_fp8(v0[0], v0[1], v0[2], v0[3]); w.y = pk4_fp8(v1[0], v1[1], v1[2], v1[3]);
                    *(u32x2*)(rowp + bj * HALF) = w; } }
    }
};

typedef int v8i32 __attribute__((ext_vector_type(8)));
template <class Epi, class Sched, bool GATHER, bool FP8 = false>
__device__ __forceinline__ void gemm_phase(LAS unsigned char* lds, const Gemm g, const Sched& S, const Epi& E) {
    const int tid = threadIdx.x, wid = __builtin_amdgcn_readfirstlane(tid >> 6), lane = tid & 63, wr = wid >> 2, wc = wid & 3, fr = lane & 15, fq = lane >> 4;
    const int K = FP8 ? g.K : g.K * 2  , nt = K / (BK * 2);
    unsigned voffA[2], voffB[2]; int rA[2];
#pragma unroll
    for (int i = 0; i < 2; ++i) { int R, C; stage_rc(tid * 16 + i * 8192, R, C); const int Rb = Epi::PERM ? ((R & ~31) + perm32(R & 31)) : R;
        voffA[i] = GATHER ? (unsigned)(C * 2) : (unsigned)(R * K + C * 2); voffB[i] = (unsigned)(Rb * K + C * 2); rA[i] = R; }
    const size_t kstep = (size_t)(BK * 2);
    const size_t hstep = (size_t)HALF * K;
    const unsigned ldsw = (unsigned)wid * 1024u;
    const int aoff0 = lds_byte(wr * 64 + fr, fq * 8), aoff1 = aoff0 + 1024;
    const int boff0 = lds_byte(wc * 32 + fr, fq * 8), boff1 = boff0 + 1024;
    LAS unsigned* tab = (LAS unsigned*)(lds + TAB_OFF);
#define PG8_SA(b, h) (((b) * 2 + (h)) * HTB)
#define PG8_SB(b, h) ((4 + (b) * 2 + (h)) * HTB)
#define PG8_STAGE(bufoff, gbase, voff) do { _Pragma("unroll") for (int _i = 0; _i < 2; ++_i) \
        __builtin_amdgcn_global_load_lds((const unsigned*)((const char*)(gbase) + (voff)[_i]), (LAS unsigned*)(lds + (bufoff) + ldsw + _i * 8192), 16, 0, 0); } while (0)
#define PG8_STAGE_A(bufoff, gbase, h, sl) do { if constexpr (GATHER) { _Pragma("unroll") for (int _i = 0; _i < 2; ++_i) { const unsigned _ro = tab[(sl) * 256 + (h) * 128 + rA[_i]]; \
        __builtin_amdgcn_global_load_lds((const unsigned*)((const char*)(gbase) + _ro + voffA[_i]), (LAS unsigned*)(lds + (bufoff) + ldsw + _i * 8192), 16, 0, 0); } } \
        else { PG8_STAGE(bufoff, (const char*)(gbase) + (h) * hstep, voffA); } } while (0)
#define PG8_LDA(dst, b, h) do { _Pragma("unroll") for (int m = 0; m < 4; ++m) { dst[m][0] = *(const LAS bf16x8*)(lds + PG8_SA(b, h) + aoff0 + m * 2048); dst[m][1] = *(const LAS bf16x8*)(lds + PG8_SA(b, h) + aoff1 + m * 2048); } } while (0)
#define PG8_LDB(dst, b, h) do { _Pragma("unroll") for (int n = 0; n < 2; ++n) { dst[n][0] = *(const LAS bf16x8*)(lds + PG8_SB(b, h) + boff0 + n * 2048); dst[n][1] = *(const LAS bf16x8*)(lds + PG8_SB(b, h) + boff1 + n * 2048); } } while (0)
#define PG8_CAT(x) __builtin_bit_cast(v8i32, __builtin_shufflevector((x)[0], (x)[1], 0, 1, 2, 3, 4, 5, 6, 7, 8, 9, 10, 11, 12, 13, 14, 15))
#define PG8_MMA(ai, bj, At, Bt) do { __builtin_amdgcn_s_setprio(1); _Pragma("unroll") for (int m = 0; m < 4; ++m) _Pragma("unroll") for (int n = 0; n < 2; ++n) { \
        if constexpr (FP8) acc[ai][bj][m][n] = __builtin_amdgcn_mfma_scale_f32_16x16x128_f8f6f4(PG8_CAT(Bt[n]), PG8_CAT(At[m]), acc[ai][bj][m][n], 0, 0, 0, 0x7f7f7f7f, 0, 0x7f7f7f7f); \
        else { _Pragma("unroll") for (int k = 0; k < 2; ++k) acc[ai][bj][m][n] = __builtin_amdgcn_mfma_f32_16x16x32_bf16(Bt[n][k], At[m][k], acc[ai][bj][m][n], 0, 0, 0); } } \
        __builtin_amdgcn_s_setprio(0); \
        if constexpr (FP8) { _Pragma("unroll") for (int m = 0; m < 4; ++m) asm volatile("" : "+v"(acc[ai][bj][m][0]), "+v"(acc[ai][bj][m][1])); } } while (0)
#define PG8_WAIT_V(n) asm volatile("s_waitcnt vmcnt(" #n ")" ::: "memory")
#define PG8_WAIT_L(n) asm volatile("s_waitcnt lgkmcnt(" #n ")" ::: "memory")
#define PG8_BAR __builtin_amdgcn_s_barrier()
#define PG8_SCHED __builtin_amdgcn_sched_barrier(0)
#define PG8_SCHF do { if constexpr (FP8) __builtin_amdgcn_sched_barrier(0); } while (0)
    Unit cur, nxt; int ui = 0;
    if (!S.next(0, cur)) return;
    f32x4 acc[2][2][4][2];
#pragma unroll
    for (int a = 0; a < 2; ++a)
#pragma unroll
        for (int b = 0; b < 2; ++b)
#pragma unroll
            for (int m = 0; m < 4; ++m)
#pragma unroll
                for (int n = 0; n < 2; ++n) acc[a][b][m][n] = (f32x4){0.f, 0.f, 0.f, 0.f};
    bf16x8 At[4][2], B0[2][2], B1[2][2];
    const char* cA = (const char*)g.A + (GATHER ? (size_t)0 : S.a_off(cur)); const char* cB = (const char*)g.Bt + S.b_off(cur);
    if constexpr (GATHER) {
        if (tid < 256) tab[tid] = (unsigned)S.rows(cur)[tid] * (unsigned)K;
        WG_BAR();
    }
    PG8_STAGE(PG8_SB(0, 0), cB, voffB); PG8_STAGE(PG8_SB(0, 1), cB + hstep, voffB); PG8_STAGE_A(PG8_SA(0, 0), cA, 0, 0); PG8_STAGE_A(PG8_SA(0, 1), cA, 1, 0);
    if (wr == 1) PG8_BAR;
    PG8_WAIT_V(2); PG8_BAR;
    PG8_STAGE(PG8_SB(1, 0), cB + kstep, voffB); PG8_STAGE_A(PG8_SA(1, 0), cA + kstep, 0, 0); PG8_STAGE(PG8_SB(1, 1), cB + hstep + kstep, voffB);
    PG8_WAIT_V(6); PG8_BAR;
    for (;;) {
        const bool has_next = S.next(ui + 1, nxt);
        const int sc = ui & 1, sn = has_next ? ((ui + 1) & 1) : sc;
        if constexpr (GATHER) { if (has_next && tid < 256) tab[sn * 256 + tid] = (unsigned)S.rows(nxt)[tid] * (unsigned)K; }
        const char* nA = has_next ? (const char*)g.A + (GATHER ? (size_t)0 : S.a_off(nxt)) : cA; const char* nB = has_next ? (const char*)g.Bt + S.b_off(nxt) : cB;
        for (int t = 0; t < nt; t += 2) {
            const bool last = (t == nt - 2);
            const char* a1 = cA + (size_t)(t + 1) * kstep;
            const char* a2 = last ? nA : cA + (size_t)(t + 2) * kstep; const char* b2 = last ? nB : cB + (size_t)(t + 2) * kstep;
            const char* a3 = a2 + kstep; const char* b3 = b2 + kstep;
            const int s2 = last ? sn : sc;
            PG8_LDB(B0, 0, 0); PG8_LDB(B1, 0, 1); PG8_SCHED; PG8_LDA(At, 0, 0); PG8_STAGE_A(PG8_SA(1, 1), a1, 1, sc);
            PG8_WAIT_V(8); PG8_WAIT_L(0); PG8_BAR; PG8_SCHF; PG8_MMA(0, 0, At, B0); PG8_MMA(0, 1, At, B1); PG8_BAR; PG8_SCHED;
            PG8_LDA(At, 0, 1); PG8_STAGE(PG8_SB(0, 0), b2, voffB); PG8_STAGE(PG8_SB(0, 1), b2 + hstep, voffB); PG8_STAGE_A(PG8_SA(0, 0), a2, 0, s2);
            PG8_WAIT_V(8); PG8_WAIT_L(0); PG8_BAR; PG8_SCHF; PG8_MMA(1, 0, At, B0); PG8_MMA(1, 1, At, B1); PG8_BAR; PG8_SCHED;
            PG8_LDB(B0, 1, 0); PG8_LDB(B1, 1, 1); PG8_SCHED; PG8_LDA(At, 1, 0); PG8_STAGE_A(PG8_SA(0, 1), a2, 1, s2);
            PG8_WAIT_V(8); PG8_WAIT_L(0); PG8_BAR; PG8_SCHF; PG8_MMA(0, 0, At, B0); PG8_MMA(0, 1, At, B1); PG8_BAR; PG8_SCHED;
            PG8_LDA(At, 1, 1); PG8_STAGE(PG8_SB(1, 0), b3, voffB); PG8_STAGE(PG8_SB(1, 1), b3 + hstep, voffB); PG8_STAGE_A(PG8_SA(1, 0), a3, 0, s2);
            PG8_WAIT_V(8); PG8_WAIT_L(0); PG8_BAR; PG8_SCHF; PG8_MMA(1, 0, At, B0); PG8_MMA(1, 1, At, B1); PG8_BAR; PG8_SCHED;
        }
        if (wr == 0) PG8_BAR;
        E(acc, cur, wr, wc, fr, fq);
        if (!has_next) break;
#pragma unroll
        for (int a = 0; a < 2; ++a)
#pragma unroll
            for (int b = 0; b < 2; ++b)
#pragma unroll
                for (int m = 0; m < 4; ++m)
#pragma unroll
                    for (int n = 0; n < 2; ++n) acc[a][b][m][n] = (f32x4){0.f, 0.f, 0.f, 0.f};
        cur = nxt; cA = nA; cB = nB; ++ui;
        if (wr == 1) PG8_BAR;
    }
    PG8_WAIT_V(0);
    PG8_BAR;
#undef PG8_SA
#undef PG8_SB
#undef PG8_STAGE
#undef PG8_STAGE_A
#undef PG8_LDA
#undef PG8_LDB
#undef PG8_MMA
#undef PG8_CAT
#undef PG8_WAIT_V
#undef PG8_WAIT_L
#undef PG8_BAR
#undef PG8_SCHED
#undef PG8_SCHF
}
}

#define XB_TMO      128
#define XB_XCNT(j)  (256  + 64 * (j))
#define XB_XSUB(j)  (1280 + 64 * (j))
#define XB_XGEN(j)  (2304 + 64 * (j))
#define XB_TOP      3328
#define XB_TOPGEN   3392
#define XCD_BAR_WORDS 3456
#define XB_SPIN_CAP (1u << 18)
__device__ __forceinline__ unsigned xb_ld(unsigned* p)              { return __hip_atomic_load(p, __ATOMIC_RELAXED, __HIP_MEMORY_SCOPE_AGENT); }
__device__ __forceinline__ unsigned xb_add(unsigned* p, unsigned v) { return __hip_atomic_fetch_add(p, v, __ATOMIC_RELAXED, __HIP_MEMORY_SCOPE_AGENT); }
__device__ __forceinline__ unsigned xb_xcc_id() { return (unsigned)__builtin_amdgcn_s_getreg((3 << 11) | 20) & 0xFu; }
#define XB_SPIN(cond, bar) do { unsigned _sp = 0; while (cond) { __builtin_amdgcn_s_sleep(1); \
    if ((++_sp & 255u) == 0u) { if (xb_ld(&(bar)[XB_TMO])) break; if (_sp > XB_SPIN_CAP) { atomicAdd(&(bar)[XB_TMO], 1u); break; } } } } while (0)
struct XcdBarrier { unsigned* bar; unsigned x; volatile LAS unsigned* st; };
__device__ __forceinline__ XcdBarrier xcd_barrier_post(unsigned* bar, volatile LAS unsigned* st) {
    XcdBarrier b; b.bar = bar; b.x = xb_xcc_id(); b.st = st;
    if (threadIdx.x == 0) (void)xb_add(&bar[XB_XCNT(b.x)], 1u);
    return b;
}
__device__ __forceinline__ void xcd_barrier_complete(unsigned* bar, unsigned x, unsigned& nloc, unsigned& nx) {
    const unsigned G = gridDim.x * gridDim.y * gridDim.z;
    unsigned sum, cnt, mine, sp = 0u;
    for (;;) {
        sum = 0u; cnt = 0u; mine = 0u;
#pragma unroll
        for (unsigned j = 0; j < 16; ++j) { const unsigned c = xb_ld(&bar[XB_XCNT(j)]); sum += c; cnt += (c > 0u) ? 1u : 0u; mine = (j == x) ? c : mine; }
        if (sum == G) break;
        __builtin_amdgcn_s_sleep(1);
        if ((++sp & 255u) == 0u) { if (xb_ld(&bar[XB_TMO])) break; if (sp > XB_SPIN_CAP) { atomicAdd(&bar[XB_TMO], 1u); break; } }
    }
    nloc = mine > 0u ? mine : 1u; nx = cnt > 0u ? cnt : 1u;
}
__device__ __forceinline__ void xcd_barrier(const XcdBarrier& b) {
    asm volatile("s_waitcnt vmcnt(0)" ::: "memory");
    __syncthreads();
    if (threadIdx.x == 0) {
        unsigned* bar = b.bar;
        __builtin_amdgcn_s_waitcnt(0);
        unsigned nloc = b.st[0], nx = b.st[1];
        if (nloc == 0u) { xcd_barrier_complete(bar, b.x, nloc, nx); b.st[0] = nloc; b.st[1] = nx; }
        const unsigned old = xb_add(&bar[XB_XSUB(b.x)], 1u);
        const unsigned gen = old / nloc;
        if (old + 1u == (gen + 1u) * nloc) {
            __builtin_amdgcn_fence(__ATOMIC_RELEASE, "agent");
            asm volatile("s_waitcnt vmcnt(0)" ::: "memory");
            const unsigned og = xb_add(&bar[XB_TOP], 1u);
            const unsigned tg = og / nx;
            if (og + 1u == (tg + 1u) * nx) xb_add(&bar[XB_TOPGEN], 1u);
            else XB_SPIN(xb_ld(&bar[XB_TOPGEN]) == tg, bar);
            __builtin_amdgcn_fence(__ATOMIC_ACQUIRE, "agent");
            xb_add(&bar[XB_XGEN(b.x)], 1u);
            asm volatile("s_waitcnt vmcnt(0)" ::: "memory");
        } else {
            XB_SPIN(xb_ld(&bar[XB_XGEN(b.x)]) == gen, bar);
            __builtin_amdgcn_fence(__ATOMIC_ACQUIRE, "agent");
            asm volatile("s_waitcnt vmcnt(0)" ::: "memory");
        }
    }
    __syncthreads();
}

struct Args {
    const float* in[31]; float* out; unsigned char* ws;
    int ph_lo, ph_hi, li, pad;
};
enum { I_X = 0, I_N1G, I_WIN, I_SLNG, I_SLNB, I_SGUW, I_SGUB, I_MURKV, I_MUWAG, I_W0, I_W1, I_W2, I_A0, I_A1, I_A2, I_G1, I_G2, I_KK, I_KA, I_RK, I_LNXG, I_LNXB, I_WOUT, I_N2G, I_RW, I_RB,
       I_MW1, I_MB1, I_MW2, I_MB2, I_FG };

struct Ctx { LAS unsigned char* lds; int tid, lane, wave, G, vcu; unsigned char* ws; const float* const* in; };

template <int KS> __device__ __forceinline__ void mma_nt(f32x4& acc, const LAS bf16_t* X, int ldx, const LAS bf16_t* Y, int ldy, int lane) {
    const LAS bf16_t* xp = X + (lane & 15) * ldx + 8 * (lane >> 4); const LAS bf16_t* yp = Y + (lane & 15) * ldy + 8 * (lane >> 4);
#pragma unroll
    for (int ks = 0; ks < KS; ++ks) { const bf16x8 a = *(const LAS bf16x8*)(xp + 32 * ks), b = *(const LAS bf16x8*)(yp + 32 * ks); acc = __builtin_amdgcn_mfma_f32_16x16x32_bf16(a, b, acc, 0, 0, 0); }
}
template <int KS> __device__ __forceinline__ void mma_nt_gx(f32x4& acc, const bf16_t* X, int ldx, const LAS bf16_t* Y, int ldy, int lane) {
    const bf16_t* xp = X + (size_t)(lane & 15) * ldx + 8 * (lane >> 4); const LAS bf16_t* yp = Y + (lane & 15) * ldy + 8 * (lane >> 4);
#pragma unroll
    for (int ks = 0; ks < KS; ++ks) { const bf16x8 a = *(const bf16x8*)(xp + 32 * ks), b = *(const LAS bf16x8*)(yp + 32 * ks); acc = __builtin_amdgcn_mfma_f32_16x16x32_bf16(a, b, acc, 0, 0, 0); }
}
__device__ __forceinline__ void st4bf(LAS bf16_t* p, const f32x4 v) { u32x2 w; w.x = pk2(v[0], v[1]); w.y = pk2(v[2], v[3]); *(LAS u32x2*)p = w; }

__device__ __forceinline__ void p0_transpose_item(const float* W, int N, bf16_t* WT, int ldo, int row_off, const float* sc, int mode, bool remap, LAS float* scr, int item, int lane) {
    const int nblk = N / 32, kb = item / nblk, nb = item % nblk, k0 = 64 * kb, n0 = 32 * nb;
#pragma unroll 8
    for (int i = 0; i < 32; ++i) { const int kk = 2 * i + (lane >> 5); float v = __builtin_nontemporal_load(W + (size_t)(k0 + kk) * N + n0 + (lane & 31));
        if (mode) { const float s = sc[k0 + kk]; v *= (mode == 1) ? s : (1.0f - s); }
        scr[kk * 33 + (lane & 31)] = v; }
    LDS_WAIT(); asm volatile("" ::: "memory");
    const int c = lane & 7;
#pragma unroll
    for (int j = 0; j < 4; ++j) { const int n = (lane >> 3) + 8 * j; const LAS float* s = scr + (8 * c) * 33 + n;
        u32x4 o; o.x = pk2(s[0 * 33], s[1 * 33]); o.y = pk2(s[2 * 33], s[3 * 33]); o.z = pk2(s[4 * 33], s[5 * 33]); o.w = pk2(s[6 * 33], s[7 * 33]);
        int orow = n0 + n; if (remap) { const int oc = orow >> 1; orow = 256 * (oc >> 7) + 128 * (orow & 1) + (oc & 127); }
        *(u32x4*)(WT + (size_t)(row_off + orow) * ldo + k0 + 8 * c) = o; }
    LDS_WAIT(); asm volatile("" ::: "memory");
}
__device__ __forceinline__ void p0_transpose_item_fp8(const float* W, int N, unsigned char* WT, int ldo, bool remap, LAS float* scr, int item, int lane) {
    const int nblk = N / 32, kb = item / nblk, nb = item % nblk, k0 = 64 * kb, n0 = 32 * nb;
    float tv[32];
#pragma unroll
    for (int i = 0; i < 32; ++i) tv[i] = __builtin_nontemporal_load(W + (size_t)(k0 + 2 * i + (lane >> 5)) * N + n0 + (lane & 31));
#pragma unroll
    for (int i = 0; i < 32; ++i) scr[(2 * i + (lane >> 5)) * 33 + (lane & 31)] = tv[i] * FP8_SW;
    LDS_WAIT(); asm volatile("" ::: "memory");
    const int c = lane & 3;
#pragma unroll
    for (int j = 0; j < 2; ++j) { const int n = (lane >> 2) + 16 * j; const LAS float* sp = scr + (16 * c) * 33 + n;
        u32x4 o; o.x = pk4_fp8(sp[0 * 33], sp[1 * 33], sp[2 * 33], sp[3 * 33]); o.y = pk4_fp8(sp[4 * 33], sp[5 * 33], sp[6 * 33], sp[7 * 33]);
        o.z = pk4_fp8(sp[8 * 33], sp[9 * 33], sp[10 * 33], sp[11 * 33]); o.w = pk4_fp8(sp[12 * 33], sp[13 * 33], sp[14 * 33], sp[15 * 33]);
        int orow = n0 + n; if (remap) { const int oc = orow >> 1; orow = 256 * (oc >> 7) + 128 * (orow & 1) + (oc & 127); }
        *(u32x4*)(WT + (size_t)orow * ldo + k0 + 16 * c) = o; }
    LDS_WAIT(); asm volatile("" ::: "memory");
}
__device__ __forceinline__ void moe_weight_phase(const Ctx& F) {
    LAS float* scr = (LAS float*)(F.lds + 4096 + F.wave * 16384);
    const int gw = F.vcu * 8 + F.wave, NGW = F.G * 8, lane = F.lane;
    unsigned char* ws = F.ws;
    constexpr int I_M1 = 16 * 64, I_M2 = 16 * 32;
    for (int it = gw; it < NEXP * (I_M1 + I_M2); it += NGW) {
        int r = it; const int e = r / (I_M1 + I_M2); r -= e * (I_M1 + I_M2);
        if (r < I_M1) p0_transpose_item_fp8(F.in[I_MW1] + (size_t)e * D * NHID, NHID, ws + WS_W1T + (size_t)e * NHID * D, D, true, scr, r, lane);
        else p0_transpose_item_fp8(F.in[I_MW2] + (size_t)e * DEXP * D, D, ws + WS_W2T + (size_t)e * D * DEXP, DEXP, false, scr, r - I_M1, lane);
    }
}
__device__ __forceinline__ void p0_prologue(const Ctx& F) {
    LAS float* scr = (LAS float*)(F.lds + F.wave * 16384);
    const int gw = F.vcu * 8 + F.wave, NGW = F.G * 8, lane = F.lane;
    unsigned char* ws = F.ws;
    bf16_t* WCAT = (bf16_t*)(ws + WS_WCAT);
    constexpr int I_WIN_N = 16 * 80, I_L64 = 16 * 2, I_L128 = 16 * 4, I_WO = 16 * 32, I_M1 = 16 * 64, I_M2 = 16 * 32, I_S64 = 1 * 16, I_S128 = 2 * 16;
    constexpr int N_SMALL = I_WIN_N + 4 * I_L64 + 2 * I_L128 + I_WO + 2 * I_S64 + I_S128;
    constexpr int NITEMS = N_SMALL;
    const float* mu_wag = F.in[I_MUWAG];
    for (int it = gw; it < NITEMS; it += NGW) {
        int r = it;
        if (r < I_WIN_N) { p0_transpose_item(F.in[I_WIN], 2560, WCAT, D, 0, nullptr, 0, false, scr, r, lane); continue; } r -= I_WIN_N;
        if (r < I_L64) { p0_transpose_item(F.in[I_W1], 64, WCAT, D, COL_LA + 0, mu_wag + 0 * D, 2, false, scr, r, lane); continue; } r -= I_L64;
        if (r < I_L64) { p0_transpose_item(F.in[I_W1], 64, WCAT, D, COL_LB + 0, mu_wag + 0 * D, 1, false, scr, r, lane); continue; } r -= I_L64;
        if (r < I_L64) { p0_transpose_item(F.in[I_A1], 64, WCAT, D, COL_LA + 64, mu_wag + 1 * D, 2, false, scr, r, lane); continue; } r -= I_L64;
        if (r < I_L64) { p0_transpose_item(F.in[I_A1], 64, WCAT, D, COL_LB + 64, mu_wag + 1 * D, 1, false, scr, r, lane); continue; } r -= I_L64;
        if (r < I_L128) { p0_transpose_item(F.in[I_G1], 128, WCAT, D, COL_LA + 128, mu_wag + 2 * D, 2, false, scr, r, lane); continue; } r -= I_L128;
        if (r < I_L128) { p0_transpose_item(F.in[I_G1], 128, WCAT, D, COL_LB + 128, mu_wag + 2 * D, 1, false, scr, r, lane); continue; } r -= I_L128;
        if (r < I_WO) { p0_transpose_item(F.in[I_WOUT], D, (bf16_t*)(ws + WS_WOUT), D, 0, nullptr, 0, false, scr, r, lane); continue; } r -= I_WO;
        if (r < I_S64) { p0_transpose_item(F.in[I_W2], 512, (bf16_t*)(ws + WS_LW2), 64, 0, nullptr, 0, false, scr, r, lane); continue; } r -= I_S64;
        if (r < I_S64) { p0_transpose_item(F.in[I_A2], 512, (bf16_t*)(ws + WS_LA2), 64, 0, nullptr, 0, false, scr, r, lane); continue; } r -= I_S64;
        p0_transpose_item(F.in[I_G2], 512, (bf16_t*)(ws + WS_LG2), 128, 0, nullptr, 0, false, scr, r, lane);
    }
    const int gt = F.vcu * 512 + F.tid, NGT = F.G * 512;
    { bf16_t* SW = (bf16_t*)(ws + WS_SGUW); const float* w = F.in[I_SGUW];
      for (int i = gt; i < 8 * 128 * 128; i += NGT) { const int qi = (i >> 7) & 127, kj = i & 127; SW[i] = (bf16_t)(((kj >> 6) <= (qi >> 6)) ? f2bf(w[i]) : 0u); } }
    { float* RW = (float*)(ws + WS_RW); const float* w = F.in[I_RW]; const float* g = F.in[I_N2G];
      for (int i = gt; i < D * NEXP; i += NGT) RW[i] = w[i] * g[i >> 5]; }
    { int* rt = (int*)(ws + WS_ROWTOK); float* rg = (float*)(ws + WS_ROWGATE);
      for (int i = gt; i < MAXROWS; i += NGT) { rt[i] = 0; rg[i] = 0.f; } }
    { const float* g1 = F.in[I_N1G]; f32x4 gv[4];
#pragma unroll
      for (int j = 0; j < 4; ++j) gv[j] = *((const f32x4*)g1 + lane + 64 * j);
      for (int m = gw; m < M; m += NGW) {
          const f32x4* xr = (const f32x4*)(F.in[I_X] + (size_t)m * D) + lane; f32x4 v[4]; float s = 0.f;
#pragma unroll
          for (int j = 0; j < 4; ++j) { v[j] = __builtin_nontemporal_load(xr + 64 * j); s += (v[j].x * v[j].x + v[j].y * v[j].y) + (v[j].z * v[j].z + v[j].w * v[j].w); }
          const float rstd = __builtin_amdgcn_rsqf(wave_sum(s) * (1.0f / D) + 1e-5f);
          u32x2* o8 = (u32x2*)((bf16_t*)(ws + WS_XN) + (size_t)m * D) + lane;
#pragma unroll
          for (int j = 0; j < 4; ++j) { u32x2 w; w.x = pk2(v[j].x * rstd * gv[j].x, v[j].y * rstd * gv[j].y); w.y = pk2(v[j].z * rstd * gv[j].z, v[j].w * rstd * gv[j].w); o8[64 * j] = w; }
      } }
}

#define LB() do { asm volatile("s_waitcnt lgkmcnt(0)" ::: "memory"); __builtin_amdgcn_s_barrier(); asm volatile("" ::: "memory"); } while (0)
typedef short v4i16_t __attribute__((ext_vector_type(4)));
__device__ __forceinline__ bf16x8 tr_frag(const LAS bf16_t* base, int ld, int lane) {
    const LAS bf16_t* a = base + (8 * (lane >> 4) + ((lane & 15) >> 2)) * ld + 4 * (lane & 3);
    const v4i16_t lo = __builtin_amdgcn_ds_read_tr16_b64_v4i16((LAS v4i16_t*)a), hi = __builtin_amdgcn_ds_read_tr16_b64_v4i16((LAS v4i16_t*)(a + 4 * ld));
    return __builtin_shufflevector(lo, hi, 0, 1, 2, 3, 4, 5, 6, 7);
}
template <int KS> __device__ __forceinline__ void mma_tx(f32x4& acc, const LAS bf16_t* XR, int ldx, const LAS bf16_t* Y, int ldy, int lane) {
    const LAS bf16_t* yp = Y + (lane & 15) * ldy + 8 * (lane >> 4);
#pragma unroll
    for (int ks = 0; ks < KS; ++ks) { const bf16x8 a = tr_frag(XR + 32 * ks * ldx, ldx, lane), b = *(const LAS bf16x8*)(yp + 32 * ks); acc = __builtin_amdgcn_mfma_f32_16x16x32_bf16(a, b, acc, 0, 0, 0); }
}
template <int KS> __device__ __forceinline__ void mma_ty(f32x4& acc, const LAS bf16_t* X, int ldx, const LAS bf16_t* YR, int ldy, int lane) {
    const LAS bf16_t* xp = X + (lane & 15) * ldx + 8 * (lane >> 4);
#pragma unroll
    for (int ks = 0; ks < KS; ++ks) { const bf16x8 a = *(const LAS bf16x8*)(xp + 32 * ks), b = tr_frag(YR + 32 * ks * ldy, ldy, lane); acc = __builtin_amdgcn_mfma_f32_16x16x32_bf16(a, b, acc, 0, 0, 0); }
}
template <int KS> __device__ __forceinline__ void mma_rx(f32x4& acc, const bf16x8 (&xf)[KS], const LAS bf16_t* Y, int ldy, int lane) {
    const LAS bf16_t* yp = Y + (lane & 15) * ldy + 8 * (lane >> 4);
#pragma unroll
    for (int ks = 0; ks < KS; ++ks) { const bf16x8 b = *(const LAS bf16x8*)(yp + 32 * ks); acc = __builtin_amdgcn_mfma_f32_16x16x32_bf16(xf[ks], b, acc, 0, 0, 0); }
}

__device__ __forceinline__ void sgu_phase(const Ctx& F) {
    const int w = F.wave;
    const bf16_t* PROJ = (const bf16_t*)(F.ws + WS_PROJ); bf16_t* YCAT = (bf16_t*)(F.ws + WS_YCAT); const bf16_t* SW = (const bf16_t*)(F.ws + WS_SGUW);
    LAS bf16_t* vn = (LAS bf16_t*)F.lds;
    constexpr int LDV = 264;
    for (int unit = F.vcu; unit < 256; unit += F.G) {
        int tv_ = F.tid; asm volatile("" : "+v"(tv_)); const int lane = tv_ & 63;
        const int nb = unit >> 1, hh = unit & 1, m0 = nb * 128;
        float lg[8], lb[8];
#pragma unroll
        for (int q = 0; q < 8; ++q) { lg[q] = F.in[I_SLNG][lane * 8 + q]; lb[q] = F.in[I_SLNB][lane * 8 + q]; }
        const int hl = w >> 1, ih = w & 1, h = hh * 4 + hl;
        u32x4 raw[16];
#pragma unroll
        for (int rr = 0; rr < 16; ++rr) raw[rr] = *(const u32x4*)(PROJ + (size_t)(m0 + w * 16 + rr) * NPROJ + COL_V + lane * 8);
        bf16x8 bfr[4][4]; u32x2 ur[4][4]; float bsv[4];
#pragma unroll
        for (int ks = 0; ks < 4; ++ks)
#pragma unroll
            for (int it = 0; it < 4; ++it) bfr[ks][it] = *(const bf16x8*)(SW + (size_t)h * 16384 + (ih * 64 + it * 16 + (lane & 15)) * 128 + ks * 32 + 8 * (lane >> 4));
#pragma unroll
        for (int it = 0; it < 4; ++it) { const int i = ih * 64 + it * 16 + (lane & 15); bsv[it] = F.in[I_SGUB][h * 128 + i];
#pragma unroll
            for (int ct = 0; ct < 4; ++ct) ur[it][ct] = *(const u32x2*)(PROJ + (size_t)(m0 + i) * NPROJ + h * 64 + ct * 16 + 4 * (lane >> 4)); }
#pragma unroll
        for (int rr = 0; rr < 16; ++rr) {
            const int pos = w * 16 + rr; float v[8]; unpack8(raw[rr], v);
            float s = 0.f;
#pragma unroll
            for (int q = 0; q < 8; ++q) s += v[q];
            const float mean = wave_sum(s) * (1.0f / 512.0f); float qq = 0.f;
#pragma unroll
            for (int q = 0; q < 8; ++q) { v[q] -= mean; qq += v[q] * v[q]; }
            const float rstd = __builtin_amdgcn_rsqf(wave_sum(qq) * (1.0f / 512.0f) + 1e-5f);
            if ((lane >> 5) == hh) { float o[8];
#pragma unroll
                for (int q = 0; q < 8; ++q) o[q] = v[q] * rstd * lg[q] + lb[q];
                *(LAS u32x4*)(vn + pos * LDV + (lane & 31) * 8) = pack8(o); }
        }
        LB();
        f32x4 acc[4][4];
#pragma unroll
        for (int a = 0; a < 4; ++a)
#pragma unroll
            for (int b = 0; b < 4; ++b) acc[a][b] = (f32x4){0.f, 0.f, 0.f, 0.f};
#pragma unroll
        for (int ks = 0; ks < 4; ++ks) {
            bf16x8 af[4];
#pragma unroll
            for (int ct = 0; ct < 4; ++ct) af[ct] = tr_frag(vn + (32 * ks) * LDV + hl * 64 + ct * 16, LDV, lane);
#pragma unroll
            for (int ct = 0; ct < 4; ++ct)
#pragma unroll
                for (int it = 0; it < 4; ++it) acc[ct][it] = __builtin_amdgcn_mfma_f32_16x16x32_bf16(af[ct], bfr[ks][it], acc[ct][it], 0, 0, 0);
        }
#pragma unroll
        for (int it = 0; it < 4; ++it) { const int i = ih * 64 + it * 16 + (lane & 15); const float bs = bsv[it]; const size_t row = (size_t)(m0 + i);
#pragma unroll
            for (int ct = 0; ct < 4; ++ct) { const int c = h * 64 + ct * 16 + 4 * (lane >> 4); const u32x2 uu = ur[it][ct];
                const f32x4 a = acc[ct][it]; u32x2 o; o.x = pk2(bflo(uu.x) * (a[0] + bs), bfhi(uu.x) * (a[1] + bs)); o.y = pk2(bflo(uu.y) * (a[2] + bs), bfhi(uu.y) * (a[3] + bs));
                *(u32x2*)(YCAT + row * D + c) = o; } }
        LB();
    }
}

namespace rk {
constexpr int LD = 72, LDF = 68, LDG = 136, MBY = 64 * LD * 2;
constexpr int O_AT = 0, O_RT = MBY, O_BH = 2 * MBY, O_KH = 3 * MBY, O_V = 4 * MBY, O_TB = 5 * MBY, O_LAK = 6 * MBY, O_MRB = 7 * MBY, O_MRK = 8 * MBY,
              O_ST = 9 * MBY, O_XT = 11 * MBY, O_UT = 13 * MBY, O_WC = 15 * MBY, O_WT = O_WC + 512, O_PAR = O_WT + 2048, O_END = O_PAR + 2560;
static_assert(O_END <= MISC_OFF, "RWKV LDS map");
enum { P_MUR = 0, P_MUK, P_MUV, P_W0, P_A0, P_KK, P_KA, P_RK, P_LG, P_LB };
constexpr size_t CHB = 6 * 4096;
template <int KS> __device__ __forceinline__ void mma_txy(f32x4& acc, const LAS bf16_t* XR, int ldx, const LAS bf16_t* YR, int ldy, int lane) {
#pragma unroll
    for (int ks = 0; ks < KS; ++ks) { const bf16x8 a = tr_frag(XR + 32 * ks * ldx, ldx, lane), b = tr_frag(YR + 32 * ks * ldy, ldy, lane); acc = __builtin_amdgcn_mfma_f32_16x16x32_bf16(a, b, acc, 0, 0, 0); }
}
__device__ __forceinline__ void state_yfrags(const f32x4 (&acc)[4], bf16x8 (&yf)[2]) {
#pragma unroll
    for (int ks = 0; ks < 2; ++ks) { u32x4 wv; wv.x = pk2(acc[2 * ks][0], acc[2 * ks][1]); wv.y = pk2(acc[2 * ks][2], acc[2 * ks][3]); wv.z = pk2(acc[2 * ks + 1][0], acc[2 * ks + 1][1]); wv.w = pk2(acc[2 * ks + 1][2], acc[2 * ks + 1][3]);
        yf[ks] = __builtin_bit_cast(bf16x8, wv); }
}
__device__ __forceinline__ void load_xfrags(u32x2 (&xr)[4][2][2], const bf16_t* mt, int ldm, int lane) {
#pragma unroll
    for (int ct = 0; ct < 4; ++ct)
#pragma unroll
        for (int ks = 0; ks < 2; ++ks)
#pragma unroll
            for (int hf = 0; hf < 2; ++hf) xr[ct][ks][hf] = *(const u32x2*)(mt + (size_t)(16 * ct + (lane & 15)) * ldm + 32 * ks + 16 * hf + 4 * (lane >> 4));
}
__device__ __forceinline__ void load_xfrags_lds(u32x2 (&xr)[4][2][2], const LAS bf16_t* mt, int ldm, int lane) {
#pragma unroll
    for (int ct = 0; ct < 4; ++ct)
#pragma unroll
        for (int ks = 0; ks < 2; ++ks)
#pragma unroll
            for (int hf = 0; hf < 2; ++hf) xr[ct][ks][hf] = *(const LAS u32x2*)(mt + (16 * ct + (lane & 15)) * ldm + 32 * ks + 16 * hf + 4 * (lane >> 4));
}
__device__ __forceinline__ void state_step(f32x4 (&acc)[4], const u32x2 (&xr)[4][2][2]) {
    bf16x8 yf[2]; state_yfrags(acc, yf);
#pragma unroll
    for (int ct = 0; ct < 4; ++ct) { f32x4 d = (f32x4){0.f, 0.f, 0.f, 0.f};
#pragma unroll
        for (int ks = 0; ks < 2; ++ks) { u32x4 xw; xw.x = xr[ct][ks][0].x; xw.y = xr[ct][ks][0].y; xw.z = xr[ct][ks][1].x; xw.w = xr[ct][ks][1].y;
            d = __builtin_amdgcn_mfma_f32_16x16x32_bf16(__builtin_bit_cast(bf16x8, xw), yf[ks], d, 0, 0, 0); }
        acc[ct] = d; }
}
__device__ __forceinline__ f32x4 bf4(const u32x2 w) { return (f32x4){bflo(w.x), bfhi(w.x), bflo(w.y), bfhi(w.y)}; }
__device__ __forceinline__ int frag_off(int row, int col) { return (((row >> 4) * 64 + ((col >> 2) & 3) * 16 + (row & 15)) * 4 + (col >> 4)) * 4 + (col & 3); }
}

__device__ __forceinline__ void rwkv_prep_unit(const Ctx& F, int unit) {
    using namespace rk;
    const int w = F.wave;
    const int b = unit >> 7, h = (unit >> 4) & 7, seg = unit & 15;
    constexpr int NL = 4;
    LAS unsigned char* L = F.lds;
    LAS bf16_t *AT = (LAS bf16_t*)(L + O_AT), *RT = (LAS bf16_t*)(L + O_RT), *BH = (LAS bf16_t*)(L + O_BH), *KH = (LAS bf16_t*)(L + O_KH), *V = (LAS bf16_t*)(L + O_V), *TB = (LAS bf16_t*)(L + O_TB),
                *LAK = (LAS bf16_t*)(L + O_LAK), *MRB = (LAS bf16_t*)(L + O_MRB), *MRK = (LAS bf16_t*)(L + O_MRK), *ST = (LAS bf16_t*)(L + O_ST), *XT = (LAS bf16_t*)(L + O_XT), *UT = (LAS bf16_t*)(L + O_UT);
    LAS bf16_t *DECP = ST, *ICLP = ST + 64 * LD, *LW = XT, *LA = XT + 64 * LD, *BT = XT, *KT = XT + 64 * LD, *LG = UT, *AH = ST, *XL = ST + 64 * LD, *UL = XT, *PHL = UT, *PSL = UT + 64 * LD;
    LAS float *LF = (LAS float*)(L + O_ST), *TF = (LAS float*)(L + O_XT), *TMP = (LAS float*)(L + O_UT), *WC = (LAS float*)(L + O_WC), *WT = (LAS float*)(L + O_WT), *PAR = (LAS float*)(L + O_PAR);
    const bf16_t* PROJ = (const bf16_t*)(F.ws + WS_PROJ);
    bf16_t* SEGP = (bf16_t*)(F.ws + WS_SEGP); float* SEGQ = (float*)(F.ws + WS_SEGQ);
    bf16_t *PHIT = (bf16_t*)(F.ws + WS_PHIT), *PSI = (bf16_t*)(F.ws + WS_PSI), *YSG = (bf16_t*)(F.ws + WS_YS), *YLG = (bf16_t*)(F.ws + WS_YL), *GTG = (bf16_t*)(F.ws + WS_GT), *BVG = (bf16_t*)(F.ws + WS_BV);

    { int tid = F.tid; asm volatile("" : "+v"(tid));
      for (int i = tid; i < 640; i += 512) { const int pv = i >> 6, cc = h * 64 + (i & 63); const float* src;
          switch (pv) { case P_MUR: src = F.in[I_MURKV] + 0 * 512; break; case P_MUK: src = F.in[I_MURKV] + 1 * 512; break; case P_MUV: src = F.in[I_MURKV] + 2 * 512; break; case P_W0: src = F.in[I_W0]; break;
                        case P_A0: src = F.in[I_A0]; break; case P_KK: src = F.in[I_KK]; break; case P_KA: src = F.in[I_KA]; break; case P_RK: src = F.in[I_RK]; break; case P_LG: src = F.in[I_LNXG]; break; default: src = F.in[I_LNXB]; break; }
          PAR[i] = src[cc]; }
    }
    const bf16_t* LW2 = (const bf16_t*)(F.ws + WS_LW2); const bf16_t* LA2 = (const bf16_t*)(F.ws + WS_LA2); const bf16_t* LG2 = (const bf16_t*)(F.ws + WS_LG2);

    f32x4 acc[4];
#pragma unroll
    for (int ct = 0; ct < 4; ++ct) acc[ct] = (f32x4){0.f, 0.f, 0.f, 0.f};
    if (w < 4) { int tv0_ = F.tid; asm volatile("" : "+v"(tv0_)); const int lane = tv0_ & 63;
#pragma unroll
        for (int ct = 0; ct < 4; ++ct)
#pragma unroll
            for (int r = 0; r < 4; ++r) acc[ct][r] = (16 * ct + 4 * (lane >> 4) + r == 16 * w + (lane & 15)) ? 1.0f : 0.0f; }
    LB();

    u32x4 rw_c[3 + NL], rw_p[3 + NL];
    auto load_raw = [&](int c, int tv) {
        const int t = tv >> 3, c0 = (tv & 7) * 8, hc = h * 64 + c0; const int tq0 = (seg * SEGC + c) * CH;
        const bf16_t* rowc = PROJ + ((size_t)b * SEQ + tq0 + t) * NPROJ; const bool hasp = (tq0 + t) > 0; const bf16_t* rowp = hasp ? rowc - NPROJ : rowc;
        rw_c[0] = *(const u32x4*)(rowc + COL_R + hc); rw_c[1] = *(const u32x4*)(rowc + COL_K + hc); rw_c[2] = *(const u32x4*)(rowc + COL_VR + hc);
        rw_p[0] = *(const u32x4*)(rowp + COL_R + hc); rw_p[1] = *(const u32x4*)(rowp + COL_K + hc); rw_p[2] = *(const u32x4*)(rowp + COL_VR + hc);
#pragma unroll
        for (int q4 = 0; q4 < NL; ++q4) { rw_c[3 + q4] = *(const u32x4*)(rowc + COL_LA + q4 * 64 + c0); rw_p[3 + q4] = *(const u32x4*)(rowp + COL_LB + q4 * 64 + c0); }
    };
    bf16x8 fW[2], fA[2], fG[4];
    { int tvw_ = F.tid; asm volatile("" : "+v"(tvw_)); const int g_ = (tvw_ & 63) >> 4, ln_ = tvw_ & 15; const size_t row = (size_t)(h * 64 + (w & 3) * 16 + ln_);
#pragma unroll
      for (int ks = 0; ks < 2; ++ks) { fW[ks] = *(const bf16x8*)(LW2 + row * 64 + 32 * ks + 8 * g_); fA[ks] = *(const bf16x8*)(LA2 + row * 64 + 32 * ks + 8 * g_); }
#pragma unroll
      for (int ks = 0; ks < 4; ++ks) fG[ks] = *(const bf16x8*)(LG2 + row * 128 + 32 * ks + 8 * g_); }
    { int tv0_ = F.tid; asm volatile("" : "+v"(tv0_)); load_raw(0, tv0_); }

    for (int c = 0; c < SEGC; ++c) {
        int tv_ = F.tid; asm volatile("" : "+v"(tv_));
        const int lane = tv_ & 63, t = tv_ >> 3, cg = tv_ & 7, c0 = cg * 8, g = lane >> 4, ln = lane & 15;
        const size_t cu = (size_t)((b * 8 + h) * NCHUNK + seg * SEGC + c) * CHB;
        float r_[8], k_[8], v_[8], a_[8], b_[8], ld_[8], pf_[8];
        {
            float cv[8], pv[8];
            { const unsigned km = ((seg * SEGC + c) * CH + t) > 0 ? 0xffffffffu : 0u;
#pragma unroll
              for (int i = 0; i < 3 + NL; ++i) { rw_p[i].x &= km; rw_p[i].y &= km; rw_p[i].z &= km; rw_p[i].w &= km; } }
            unpack8(rw_c[0], cv); unpack8(rw_p[0], pv);
#pragma unroll
            for (int q = 0; q < 8; ++q) r_[q] = cv[q] + (pv[q] - cv[q]) * PAR[P_MUR * 64 + c0 + q];
            unpack8(rw_c[1], cv); unpack8(rw_p[1], pv);
#pragma unroll
            for (int q = 0; q < 8; ++q) k_[q] = cv[q] + (pv[q] - cv[q]) * PAR[P_MUK * 64 + c0 + q];
            unpack8(rw_c[2], cv); unpack8(rw_p[2], pv);
#pragma unroll
            for (int q = 0; q < 8; ++q) v_[q] = cv[q] + (pv[q] - cv[q]) * PAR[P_MUV * 64 + c0 + q];
#pragma unroll
            for (int q4 = 0; q4 < NL; ++q4) { float o[8];
                unpack8(rw_c[3 + q4], cv); unpack8(rw_p[3 + q4], pv);
#pragma unroll
                for (int q = 0; q < 8; ++q) { const float x = cv[q] + pv[q]; o[q] = (q4 == 0) ? (1.0f - 2.0f * __builtin_amdgcn_rcpf(1.0f + __expf(2.0f * x))) : (q4 == 1 ? x : fsigmoid(x)); }
                LAS bf16_t* dst = (q4 == 0) ? (LW + t * LD + c0) : (q4 == 1) ? (LA + t * LD + c0) : (LG + t * LDG + (q4 - 2) * 64 + c0);
                *(LAS u32x4*)dst = pack8(o);
            }
        }
        LB();
        {
            const int ct = w & 3, tp = (w >> 2) * 2;
#pragma unroll
            for (int j = 0; j < 2; ++j) { const int tt = tp + j; const int so = (tt * 16 + ln) * LD + ct * 16 + 4 * g;
                f32x4 d = (f32x4){0.f, 0.f, 0.f, 0.f}; mma_rx<2>(d, fW, LW + tt * 16 * LD, LD, lane); st4bf(DECP + so, d);
                d = (f32x4){0.f, 0.f, 0.f, 0.f}; mma_rx<2>(d, fA, LA + tt * 16 * LD, LD, lane); st4bf(ICLP + so, d);
                d = (f32x4){0.f, 0.f, 0.f, 0.f}; mma_rx<4>(d, fG, LG + tt * 16 * LDG, LDG, lane);
                u32x2 gw; gw.x = pk2(d[0], d[1]); gw.y = pk2(d[2], d[3]); *(u32x2*)(GTG + cu + frag_off(tt * 16 + ln, ct * 16 + 4 * g)) = gw; }
        }
        LB();
        {
            float dp[8], ip[8]; unpack8(*(const LAS u32x4*)(DECP + t * LD + c0), dp); unpack8(*(const LAS u32x4*)(ICLP + t * LD + c0), ip);
            float kk[8], ss = 0.f, bonus = 0.f;
#pragma unroll
            for (int q = 0; q < 8; ++q) {
                const float xw = dp[q] + PAR[P_W0 * 64 + c0 + q]; const float z = -xw;
                const float sp = fmaxf(z, 0.f) + __logf(1.0f + __expf(-fabsf(z)));
                const float wl = -sp - 0.5f; ld_[q] = -__expf(wl);
                ip[q] = fsigmoid(ip[q] + PAR[P_A0 * 64 + c0 + q]);
                kk[q] = k_[q] * PAR[P_KK * 64 + c0 + q]; ss += kk[q] * kk[q];
            }
            ss += __shfl_xor(ss, 1); ss += __shfl_xor(ss, 2); ss += __shfl_xor(ss, 4);
            const float inv = __builtin_amdgcn_rsqf(fmaxf(ss, 1e-24f));
#pragma unroll
            for (int q = 0; q < 8; ++q) { kk[q] *= inv; k_[q] = k_[q] * (1.0f + (ip[q] - 1.0f) * PAR[P_KA * 64 + c0 + q]); a_[q] = -kk[q]; b_[q] = kk[q] * ip[q];
                bonus += r_[q] * k_[q] * PAR[P_RK * 64 + c0 + q]; }
            bonus += __shfl_xor(bonus, 1); bonus += __shfl_xor(bonus, 2); bonus += __shfl_xor(bonus, 4);
            { float o[8];
#pragma unroll
              for (int q = 0; q < 8; ++q) o[q] = bonus * v_[q];
              const u32x4 pw = pack8(o); u32x2 lo_, hi_; lo_.x = pw.x; lo_.y = pw.y; hi_.x = pw.z; hi_.y = pw.w;
              *(u32x2*)(BVG + cu + frag_off(t, c0)) = lo_; *(u32x2*)(BVG + cu + frag_off(t, c0 + 4)) = hi_; }
#pragma unroll
            for (int q = 0; q < 8; ++q) { float x = ld_[q];
#pragma unroll
                for (int dsh = 8; dsh < 64; dsh <<= 1) { const float y = __shfl_up(x, dsh); x += (lane >= dsh) ? y : 0.f; }
                pf_[q] = x; }
            if ((lane >> 3) == 7) { *(LAS f32x4*)(WT + w * 64 + c0) = (f32x4){pf_[0], pf_[1], pf_[2], pf_[3]}; *(LAS f32x4*)(WT + w * 64 + c0 + 4) = (f32x4){pf_[4], pf_[5], pf_[6], pf_[7]}; }
        }
        LB();
        REP(16) {
        {
            float off[8], tot[8];
#pragma unroll
            for (int q = 0; q < 8; ++q) { off[q] = 0.f; tot[q] = 0.f; }
#pragma unroll
            for (int ww = 0; ww < 8; ++ww) { const f32x4 x0 = *(const LAS f32x4*)(WT + ww * 64 + c0), x1 = *(const LAS f32x4*)(WT + ww * 64 + c0 + 4); const float m = (ww < w) ? 1.0f : 0.0f;
#pragma unroll
                for (int q = 0; q < 4; ++q) { tot[q] += x0[q]; tot[q + 4] += x1[q]; off[q] += m * x0[q]; off[q + 4] += m * x1[q]; } }
            float o1[8], o2[8], o3[8], o4[8], o5[8], o6[8];
#pragma unroll
            for (int q = 0; q < 8; ++q) { const float cu_ = pf_[q] + off[q]; const float ec = __expf(cu_), en = __builtin_amdgcn_rcpf(ec), wc = __expf(tot[q]), er = wc * en;
                o1[q] = a_[q] * __expf(cu_ - ld_[q]); o2[q] = r_[q] * ec; o3[q] = b_[q] * en; o4[q] = k_[q] * en; o5[q] = b_[q] * er; o6[q] = k_[q] * er;
                if (t == 63) WC[c0 + q] = wc; }
            *(LAS u32x4*)(AT + t * LD + c0) = pack8(o1); *(LAS u32x4*)(RT + t * LD + c0) = pack8(o2); *(LAS u32x4*)(BT + t * LD + c0) = pack8(o3); *(LAS u32x4*)(KT + t * LD + c0) = pack8(o4);
            *(LAS u32x4*)(BH + t * LD + c0) = pack8(o5); *(LAS u32x4*)(KH + t * LD + c0) = pack8(o6); *(LAS u32x4*)(V + t * LD + c0) = pack8(v_);
        }
        LB();
        {
            const int tt = w & 3, ip0 = (w >> 2) * 2;
#pragma unroll
            for (int j = 0; j < 2; ++j) { const int it = ip0 + j; const int i0 = it * 16 + 4 * g, tq = tt * 16 + ln;
                f32x4 d0 = (f32x4){0.f, 0.f, 0.f, 0.f}, d1 = d0, d2 = d0, d3 = d0;
                if (it <= tt) {
                    mma_nt<2>(d0, BT + it * 16 * LD, LD, AT + tt * 16 * LD, LD, lane); mma_nt<2>(d1, KT + it * 16 * LD, LD, AT + tt * 16 * LD, LD, lane);
                    mma_nt<2>(d2, BT + it * 16 * LD, LD, RT + tt * 16 * LD, LD, lane); mma_nt<2>(d3, KT + it * 16 * LD, LD, RT + tt * 16 * LD, LD, lane);
                    if (it == tt) {
#pragma unroll
                        for (int r = 0; r < 4; ++r) { const int i = i0 + r; if (!(i < tq)) { d0[r] = 0.f; d1[r] = 0.f; } if (!(i <= tq)) { d2[r] = 0.f; d3[r] = 0.f; } } }
                }
                *(LAS f32x4*)(LF + tq * LDF + i0) = d0; st4bf(LAK + tq * LD + i0, d1); st4bf(MRB + tq * LD + i0, d2); st4bf(MRK + tq * LD + i0, d3); }
        }
        LB();
        }
        load_raw(c + 1 < SEGC ? c + 1 : c, tv_);
        REP(14) {
        if (w == 0) { const int bk = lane >> 4, j = lane & 15; float x[16];
            const LAS float* Lb = LF + (16 * bk) * LDF + 16 * bk; LAS float* Tb = TF + (16 * bk) * LDF + 16 * bk + j;
            f32x4 ra[4], rb[4];
#pragma unroll
            for (int q = 0; q < 4; ++q) ra[q] = *(const LAS f32x4*)(Lb + 1 * LDF + 4 * q);
            x[0] = (j == 0) ? 1.0f : 0.0f; Tb[0] = x[0];
#pragma unroll
            for (int tr = 1; tr < 16; ++tr) {
                f32x4 (&cur)[4] = (tr & 1) ? ra : rb; f32x4 (&nxt)[4] = (tr & 1) ? rb : ra;
                if (tr < 15) {
#pragma unroll
                    for (int q = 0; q < 4; ++q) nxt[q] = *(const LAS f32x4*)(Lb + (tr + 1) * LDF + 4 * q); }
                float s0 = (tr == j) ? 1.0f : 0.0f, s1 = 0.f;
#pragma unroll
                for (int i = 0; i < tr; ++i) { if (i & 1) s1 += cur[i >> 2][i & 3] * x[i]; else s0 += cur[i >> 2][i & 3] * x[i]; }
                x[tr] = s0 + s1; Tb[tr * LDF] = x[tr]; } }
        LB();
        if (w < 2) { const int p = w, lr = lane & 15, lk = lane >> 4; f32x4 d = (f32x4){0.f, 0.f, 0.f, 0.f};
#pragma unroll
            for (int ks = 0; ks < 4; ++ks) d = __builtin_amdgcn_mfma_f32_16x16x4f32(LF[(32 * p + 16 + lr) * LDF + 32 * p + 4 * ks + lk], TF[(32 * p + 4 * ks + lk) * LDF + 32 * p + lr], d, 0, 0, 0);
#pragma unroll
            for (int r = 0; r < 4; ++r) TMP[(32 * p + 16 + 4 * lk + r) * LDF + 32 * p + lr] = d[r];
            LDS_WAIT(); f32x4 e = (f32x4){0.f, 0.f, 0.f, 0.f};
#pragma unroll
            for (int ks = 0; ks < 4; ++ks) e = __builtin_amdgcn_mfma_f32_16x16x4f32(TF[(32 * p + 16 + lr) * LDF + 32 * p + 16 + 4 * ks + lk], TMP[(32 * p + 16 + 4 * ks + lk) * LDF + 32 * p + lr], e, 0, 0, 0);
#pragma unroll
            for (int r = 0; r < 4; ++r) TF[(32 * p + 16 + 4 * lk + r) * LDF + 32 * p + lr] = e[r]; }
        LB();
        if (w < 4) { const int ri = w >> 1, cj = w & 1, lr = lane & 15, lk = lane >> 4; f32x4 d = (f32x4){0.f, 0.f, 0.f, 0.f};
#pragma unroll
            for (int ks = 0; ks < 8; ++ks) { const int k = 4 * ks + lk; const float bb = ((k >> 4) >= cj) ? TF[k * LDF + 16 * cj + lr] : 0.0f;
                d = __builtin_amdgcn_mfma_f32_16x16x4f32(LF[(32 + 16 * ri + lr) * LDF + k], bb, d, 0, 0, 0); }
#pragma unroll
            for (int r = 0; r < 4; ++r) TMP[(32 + 16 * ri + 4 * lk + r) * LDF + 16 * cj + lr] = d[r]; }
        LB();
        if (w < 4) { const int ri = w >> 1, cj = w & 1, lr = lane & 15, lk = lane >> 4; f32x4 d = (f32x4){0.f, 0.f, 0.f, 0.f};
#pragma unroll
            for (int ks = 0; ks < 8; ++ks) { const int k = 4 * ks + lk; const float aa = (ri >= (k >> 4)) ? TF[(32 + 16 * ri + lr) * LDF + 32 + k] : 0.0f;
                d = __builtin_amdgcn_mfma_f32_16x16x4f32(aa, TMP[(32 + k) * LDF + 16 * cj + lr], d, 0, 0, 0); }
#pragma unroll
            for (int r = 0; r < 4; ++r) TF[(32 + 16 * ri + 4 * lk + r) * LDF + 16 * cj + lr] = d[r]; }
        LB();
        { float o[8];
#pragma unroll
          for (int q = 0; q < 8; ++q) { const int i = c0 + q; o[q] = ((i >> 4) <= (t >> 4)) ? TF[t * LDF + i] : 0.0f; }
          *(LAS u32x4*)(TB + t * LD + c0) = pack8(o); }
        LB();
        }
        const int tt = w & 3, pr = (w >> 2) * 2;
        REP(15) {
#pragma unroll
        for (int j = 0; j < 2; ++j) { const int mt = pr + j; const int so = (tt * 16 + ln) * LD + mt * 16 + 4 * g;
            f32x4 d = (f32x4){0.f, 0.f, 0.f, 0.f}; mma_tx<2>(d, AT + 16 * mt, LD, TB + tt * 16 * LD, LD, lane); st4bf(AH + so, d);
            d = (f32x4){0.f, 0.f, 0.f, 0.f}; mma_tx<2>(d, V + 16 * mt, LD, LAK + tt * 16 * LD, LD, lane); st4bf(XL + so, d); }
        LB();
#pragma unroll
        for (int j = 0; j < 2; ++j) { const int mt = pr + j; const int so = (tt * 16 + ln) * LD + mt * 16 + 4 * g;
            f32x4 d = (f32x4){0.f, 0.f, 0.f, 0.f}; mma_tx<2>(d, XL + 16 * mt, LD, TB + tt * 16 * LD, LD, lane); st4bf(UL + so, d);
            d = bf4(*(const LAS u32x2*)(RT + so)); mma_tx<2>(d, AH + 16 * mt, LD, MRB + tt * 16 * LD, LD, lane);
            { u32x2 o; o.x = pk2(d[0], d[1]); o.y = pk2(d[2], d[3]); *(u32x2*)(YSG + cu + frag_off(tt * 16 + ln, mt * 16 + 4 * g)) = o; }
            d = (f32x4){0.f, 0.f, 0.f, 0.f}; mma_txy<2>(d, AH + 16 * mt, LD, BH + 16 * tt, LD, lane);
            { const f32x4 wc4 = *(const LAS f32x4*)(WC + mt * 16 + 4 * g);
#pragma unroll
              for (int r = 0; r < 4; ++r) d[r] += (mt * 16 + 4 * g + r == tt * 16 + ln) ? wc4[r] : 0.0f;
              u32x2 o; o.x = pk2(d[0], d[1]); o.y = pk2(d[2], d[3]); *(LAS u32x2*)(PHL + so) = o; } }
        LB();
#pragma unroll
        for (int j = 0; j < 2; ++j) { const int mt = pr + j; const int so = (tt * 16 + ln) * LD + mt * 16 + 4 * g;
            f32x4 d = (f32x4){0.f, 0.f, 0.f, 0.f}; mma_txy<2>(d, BH + 16 * mt, LD, UL + 16 * tt, LD, lane); mma_txy<2>(d, KH + 16 * mt, LD, V + 16 * tt, LD, lane);
            { u32x2 o; o.x = pk2(d[0], d[1]); o.y = pk2(d[2], d[3]); *(LAS u32x2*)(PSL + so) = o; }
            d = (f32x4){0.f, 0.f, 0.f, 0.f}; mma_tx<2>(d, UL + 16 * mt, LD, MRB + tt * 16 * LD, LD, lane); mma_tx<2>(d, V + 16 * mt, LD, MRK + tt * 16 * LD, LD, lane);
            { u32x2 o; o.x = pk2(d[0], d[1]); o.y = pk2(d[2], d[3]); *(u32x2*)(YLG + cu + frag_off(tt * 16 + ln, mt * 16 + 4 * g)) = o; } }
        LB();
        }
        { u32x2 xr[4][2][2]; load_xfrags_lds(xr, PHL, LD, lane); state_step(acc, xr);
          if (w >= 4) {
#pragma unroll
              for (int ct = 0; ct < 4; ++ct) { acc[ct] += bf4(*(const LAS u32x2*)(PSL + (16 * (w - 4) + ln) * LD + 16 * ct + 4 * g));
                  u32x2 o; o.x = pk2(acc[ct][0], acc[ct][1]); o.y = pk2(acc[ct][2], acc[ct][3]); *(u32x2*)(PSI + cu + frag_off(16 * (w - 4) + ln, 16 * ct + 4 * g)) = o; }
          } else {
#pragma unroll
              for (int ct = 0; ct < 4; ++ct) { float v0 = acc[ct][0], v1 = acc[ct][1], v2 = acc[ct][2], v3 = acc[ct][3];
                  { const bool od = lane & 1; float t0 = od ? v0 : v1, t1 = od ? v2 : v3; t0 = __shfl_xor(t0, 1); t1 = __shfl_xor(t1, 1); if (od) { v0 = t0; v2 = t1; } else { v1 = t0; v3 = t1; } }
                  { const bool od = lane & 2; float t0 = od ? v0 : v2, t1 = od ? v1 : v3; t0 = __shfl_xor(t0, 2); t1 = __shfl_xor(t1, 2); if (od) { v0 = t0; v1 = t1; } else { v2 = t0; v3 = t1; } }
                  u32x2 o; o.x = pk2(v0, v1); o.y = pk2(v2, v3); *(u32x2*)(PHIT + cu + frag_off(16 * ct + 4 * g + (ln & 3), 16 * w + (ln & 12))) = o; } } }
        LB();
    }
    LB();
}

namespace rk {
struct FoldRegs { u32x2 x[4][2][2]; f32x4 q[4]; };
__device__ __forceinline__ void fold_load(FoldRegs& R, const bf16_t* RP, const bf16_t* RQ, int up, int rt, int lane) {
    const size_t cu = ((size_t)up * SEGC + (SEGC - 1)) * CHB;
#pragma unroll
    for (int ct = 0; ct < 4; ++ct)
#pragma unroll
        for (int ks = 0; ks < 2; ++ks) { const u32x4 v = *(const u32x4*)(RP + cu + (size_t)(ct * 64 + lane) * 16 + 8 * ks); R.x[ct][ks][0] = (u32x2){v.x, v.y}; R.x[ct][ks][1] = (u32x2){v.z, v.w}; }
#pragma unroll
    for (int ks = 0; ks < 2; ++ks) { const u32x4 v = *(const u32x4*)(RQ + cu + (size_t)(rt * 64 + lane) * 16 + 8 * ks); R.q[2 * ks] = bf4((u32x2){v.x, v.y}); R.q[2 * ks + 1] = bf4((u32x2){v.z, v.w}); }
}
__device__ __forceinline__ void fold_step(const FoldRegs& R, f32x4 (&acc)[4]) { state_step(acc, R.x);
#pragma unroll
    for (int ct = 0; ct < 4; ++ct) acc[ct] += R.q[ct]; }
}
__device__ __forceinline__ void rwkv_scan_unit(const Ctx& F, int unit) {
    using namespace rk;
    const int w = F.wave;
    const int b = unit >> 7, h = (unit >> 4) & 7, seg = unit & 15;
    int tv_ = F.tid; asm volatile("" : "+v"(tv_));
    const int lane = tv_ & 63, g = lane >> 4, ln = lane & 15;
    LAS bf16_t* ST = (LAS bf16_t*)F.lds;
    LAS float* PG = (LAS float*)(F.lds + MBY);
    const bf16_t *RP = (const bf16_t*)(F.ws + WS_PHIT), *RQ = (const bf16_t*)(F.ws + WS_PSI), *YSG = (const bf16_t*)(F.ws + WS_YS), *YLG = (const bf16_t*)(F.ws + WS_YL), *GTG = (const bf16_t*)(F.ws + WS_GT), *BVG = (const bf16_t*)(F.ws + WS_BV);
    bf16_t* YCAT = (bf16_t*)(F.ws + WS_YCAT);
    const bf16_t* SEGP = (const bf16_t*)(F.ws + WS_SEGP); const float* SEGQ = (const float*)(F.ws + WS_SEGQ);
    if (tv_ < 128) PG[tv_] = (tv_ < 64) ? F.in[I_LNXG][h * 64 + tv_] : F.in[I_LNXB][h * 64 + tv_ - 64];
    const int c = w;
    const size_t cu = (size_t)((b * 8 + h) * NCHUNK + seg * SEGC + c) * CHB, cp = c > 0 ? cu - CHB : cu;
    bf16x8 ptx[4][2]; u32x4 qv[4][2]; bf16x8 ysr[4][2];
#define SCAN_LOADS() do { \
_Pragma("unroll") \
    for (int ct = 0; ct < 4; ++ct) \
_Pragma("unroll") \
        for (int ks = 0; ks < 2; ++ks) { ptx[ct][ks] = *(const bf16x8*)(RP + cp + (size_t)(ct * 64 + lane) * 16 + 8 * ks); qv[ct][ks] = *(const u32x4*)(RQ + cp + (size_t)(ct * 64 + lane) * 16 + 8 * ks); \
            ysr[ct][ks] = *(const bf16x8*)(YSG + cu + (size_t)(ct * 64 + lane) * 16 + 8 * ks); } \
    } while (0)
    if (w < 4) SCAN_LOADS();
    if (w >= 4) {
        f32x4 acc[4];
#pragma unroll
        for (int ct = 0; ct < 4; ++ct) acc[ct] = (f32x4){0.f, 0.f, 0.f, 0.f};
        const int rt = w - 4, u0 = unit - seg; FoldRegs F0, F1, F2, F3;
        const int ul = unit > 0 ? unit - 1 : 0;
#define FLD(R, k) do { const int un_ = u0 + (k); fold_load(R, RP, RQ, un_ < ul ? un_ : ul, rt, lane); } while (0)
        FLD(F0, 0); FLD(F1, 1); FLD(F2, 2);
        for (int sp = 0; sp < seg; sp += 4) {
            FLD(F3, sp + 3); fold_step(F0, acc);
            FLD(F0, sp + 4); if (sp + 1 < seg) fold_step(F1, acc);
            FLD(F1, sp + 5); if (sp + 2 < seg) fold_step(F2, acc);
            FLD(F2, sp + 6); if (sp + 3 < seg) fold_step(F3, acc);
        }
#undef FLD
#pragma unroll
        for (int ct = 0; ct < 4; ++ct) st4bf(ST + (16 * rt + ln) * LD + 16 * ct + 4 * g, acc[ct]);
        SCAN_LOADS();
    }
#undef SCAN_LOADS
    LB();
    bf16x8 xs[4][2];
#pragma unroll
    for (int rt = 0; rt < 4; ++rt) {
        f32x4 sc[4];
        if (c > 0) {
            bf16x8 yf[2];
#pragma unroll
            for (int ks = 0; ks < 2; ++ks) { const u32x2 lo_ = *(const LAS u32x2*)(ST + (16 * rt + ln) * LD + 32 * ks + 4 * g), hi_ = *(const LAS u32x2*)(ST + (16 * rt + ln) * LD + 32 * ks + 16 + 4 * g);
                u32x4 wv; wv.x = lo_.x; wv.y = lo_.y; wv.z = hi_.x; wv.w = hi_.y; yf[ks] = __builtin_bit_cast(bf16x8, wv); }
#pragma unroll
            for (int ct = 0; ct < 4; ++ct) { u32x2 q2; if (ct & 1) { q2.x = qv[rt][ct >> 1].z; q2.y = qv[rt][ct >> 1].w; } else { q2.x = qv[rt][ct >> 1].x; q2.y = qv[rt][ct >> 1].y; } f32x4 d = bf4(q2);
#pragma unroll
                for (int ks = 0; ks < 2; ++ks) d = __builtin_amdgcn_mfma_f32_16x16x32_bf16(ptx[ct][ks], yf[ks], d, 0, 0, 0);
                sc[ct] = d; }
        } else {
#pragma unroll
            for (int ct = 0; ct < 4; ++ct) sc[ct] = bf4(*(const LAS u32x2*)(ST + (16 * rt + ln) * LD + 16 * ct + 4 * g));
        }
        state_yfrags(sc, xs[rt]);
    }
    const size_t orow0 = ((size_t)b * SEQ + (size_t)(seg * SEGC + c) * CH) * D + 512 + h * 64;
    u32x4 yl[4][2], gt[4][2], bv[4][2];
#pragma unroll
    for (int tt = 0; tt < 4; ++tt)
#pragma unroll
        for (int ks = 0; ks < 2; ++ks) { const size_t ro = cu + (size_t)(tt * 64 + lane) * 16 + 8 * ks; yl[tt][ks] = *(const u32x4*)(YLG + ro); gt[tt][ks] = *(const u32x4*)(GTG + ro); bv[tt][ks] = *(const u32x4*)(BVG + ro); }
#define H2(a, vt) (((vt) & 1) ? (u32x2){(a)[(vt) >> 1].z, (a)[(vt) >> 1].w} : (u32x2){(a)[(vt) >> 1].x, (a)[(vt) >> 1].y})
#pragma unroll
    for (int tt = 0; tt < 4; ++tt) {
        f32x4 y[4]; float s = 0.f;
#pragma unroll
        for (int vt = 0; vt < 4; ++vt) { f32x4 d = bf4(H2(yl[tt], vt));
#pragma unroll
            for (int ks = 0; ks < 2; ++ks) d = __builtin_amdgcn_mfma_f32_16x16x32_bf16(xs[vt][ks], ysr[tt][ks], d, 0, 0, 0);
            y[vt] = d; s += (d[0] + d[1]) + (d[2] + d[3]); }
        s += __shfl_xor(s, 16); s += __shfl_xor(s, 32);
        const float mean = s * (1.0f / 64.0f); float qq = 0.f;
#pragma unroll
        for (int vt = 0; vt < 4; ++vt) { y[vt] = y[vt] - mean; qq += (y[vt][0] * y[vt][0] + y[vt][1] * y[vt][1]) + (y[vt][2] * y[vt][2] + y[vt][3] * y[vt][3]); }
        qq += __shfl_xor(qq, 16); qq += __shfl_xor(qq, 32);
        const float rstd = __builtin_amdgcn_rsqf(qq * (1.0f / 64.0f) + 64e-5f);
        const size_t orow = orow0 + (size_t)(16 * tt + ln) * D;
#pragma unroll
        for (int vt = 0; vt < 4; ++vt) { const f32x4 lg4 = *(const LAS f32x4*)(PG + 16 * vt + 4 * g), lb4 = *(const LAS f32x4*)(PG + 64 + 16 * vt + 4 * g);
            const f32x4 o = (y[vt] * rstd * lg4 + lb4 + bf4(H2(bv[tt], vt))) * bf4(H2(gt[tt], vt)); u32x2 ow; ow.x = pk2(o[0], o[1]); ow.y = pk2(o[2], o[3]);
            *(u32x2*)(YCAT + orow + 16 * vt + 4 * g) = ow; }
    }
#undef H2
    LB();
}

__device__ __forceinline__ void router_phase(const Ctx& F) {
    const int tid = F.tid, lane = F.lane, w = F.wave;
    constexpr int LDX = 1028;
    LAS float* X = (LAS float*)F.lds;
    LAS float* RS = (LAS float*)(F.lds + 32 * LDX * 4);
    LAS float* LOG = RS + 32;
    LAS int* LCNT = (LAS int*)(LOG + 32 * 33);
    const float* H1 = (const float*)(F.ws + WS_H1); unsigned char* HN2 = F.ws + WS_HN2; const float* RW = (const float*)(F.ws + WS_RW);
    int* CNT = (int*)(F.ws + WS_CNT); int* RIDX = (int*)(F.ws + WS_RIDX); float* RGATE = (float*)(F.ws + WS_RGATE); int* RRANK = (int*)(F.ws + WS_RRANK);
    f32x4 gv[4];
#pragma unroll
    for (int j = 0; j < 4; ++j) gv[j] = *((const f32x4*)F.in[I_N2G] + lane + 64 * j);
    for (int tile = F.vcu; tile < NRT; tile += F.G) {
        f32x4 vr[4][4];
#pragma unroll
        for (int rr = 0; rr < 4; ++rr) { const f32x4* xr = (const f32x4*)(H1 + ((size_t)tile * RT_TOK + w * 4 + rr) * D) + lane;
#pragma unroll
            for (int j = 0; j < 4; ++j) vr[rr][j] = xr[64 * j]; }
#pragma unroll
        for (int rr = 0; rr < 4; ++rr) { const int row = w * 4 + rr; const size_t m = (size_t)tile * RT_TOK + row;
            f32x4 v[4]; float s = 0.f;
#pragma unroll
            for (int j = 0; j < 4; ++j) { v[j] = vr[rr][j]; s += (v[j].x * v[j].x + v[j].y * v[j].y) + (v[j].z * v[j].z + v[j].w * v[j].w); }
            const float rstd = __builtin_amdgcn_rsqf(wave_sum(s) * (1.0f / D) + 1e-5f);
            unsigned* o4 = (unsigned*)(HN2 + m * D) + lane;
#pragma unroll
            for (int j = 0; j < 4; ++j) { o4[64 * j] = pk4_fp8(v[j].x * rstd * gv[j].x, v[j].y * rstd * gv[j].y, v[j].z * rstd * gv[j].z, v[j].w * rstd * gv[j].w);
                *(LAS f32x4*)(X + row * LDX + 4 * (lane + 64 * j)) = v[j]; }
            if (lane == 0) RS[row] = rstd; }
        WG_BAR();
        f32x16 acc;
#pragma unroll
        for (int r = 0; r < 16; ++r) acc[r] = 0.f;
        { const int i = lane & 31, hh = lane >> 5;
#pragma unroll 4
          for (int kg = 0; kg < 16; ++kg) { const int kb = 128 * w + 8 * kg + 4 * hh; const f32x4 xa = *(const LAS f32x4*)(X + i * LDX + kb);
#pragma unroll
              for (int j = 0; j < 4; ++j) acc = __builtin_amdgcn_mfma_f32_32x32x2f32(xa[j], RW[(kb + j) * NEXP + i], acc, 0, 0, 0); } }
        WG_BAR();
#pragma unroll
        for (int r = 0; r < 16; ++r) { const int tok = (r & 3) + 8 * (r >> 2) + 4 * (lane >> 5); X[(w * 32 + tok) * 33 + (lane & 31)] = acc[r]; }
        WG_BAR();
#pragma unroll
        for (int q = 0; q < 2; ++q) { const int idx = tid + 512 * q, tok = idx >> 5, e = idx & 31; float s = 0.f;
#pragma unroll
            for (int ww = 0; ww < 8; ++ww) s += X[(ww * 32 + tok) * 33 + e];
            LOG[tok * 33 + e] = s * RS[tok] + F.in[I_RB][e]; }
        if (tid < 32) LCNT[tid] = 0;
        WG_BAR();
        {
            const int e = lane & 31;
#pragma unroll
            for (int it = 0; it < 2; ++it) { const int tok = w * 4 + 2 * it + (lane >> 5); float val = LOG[tok * 33 + e]; float tv[4]; int ti[4];
#pragma unroll
                for (int p = 0; p < 4; ++p) { float cand = val; int idx = e;
#pragma unroll
                    for (int d = 1; d < 32; d <<= 1) { const float ov = __shfl_xor(cand, d); const int oi = __shfl_xor(idx, d); const bool take = (ov > cand) || (ov == cand && oi < idx); cand = take ? ov : cand; idx = take ? oi : idx; }
                    tv[p] = cand; ti[p] = idx; if (e == idx) val = -3.0e38f; }
                float ex[4], es = 0.f;
#pragma unroll
                for (int p = 0; p < 4; ++p) { ex[p] = __expf(tv[p] - tv[0]); es += ex[p]; }
                const float inv = __builtin_amdgcn_rcpf(es); const size_t m = (size_t)tile * RT_TOK + tok;
#pragma unroll
                for (int p = 0; p < 4; ++p) if (e == ti[p]) { const int rk = atomicAdd((int*)(LCNT + e), 1); RIDX[m * 4 + p] = e; RGATE[m * 4 + p] = ex[p] * inv; RRANK[m * 4 + p] = rk; }
            }
        }
        WG_BAR();
        if (tid < 32) CNT[tile * 32 + tid] = LCNT[tid];
        WG_BAR();
    }
}

__device__ __forceinline__ void scatter_phase(const Ctx& F) {
    const int tid = F.tid;
    LAS int* PS = (LAS int*)F.lds;
    LAS int* PAD = PS + 512;
    LAS int* BASE = PAD + 64;
    const int* CNT = (const int*)(F.ws + WS_CNT); const int* RIDX = (const int*)(F.ws + WS_RIDX); const float* RGATE = (const float*)(F.ws + WS_RGATE); const int* RRANK = (const int*)(F.ws + WS_RRANK);
    int* TDEST = (int*)(F.ws + WS_TDEST); int* ROWTOK = (int*)(F.ws + WS_ROWTOK); float* ROWGATE = (float*)(F.ws + WS_ROWGATE); int* ETAB = (int*)(F.ws + WS_ETAB);
    { const int e = tid & 31, p = tid >> 5; int sm = 0;
#pragma unroll
      for (int j = 0; j < 32; ++j) sm += CNT[(32 * p + j) * 32 + e];
      PS[p * 32 + e] = sm; }
    WG_BAR();
    if (tid < 64) { const int e = tid & 31; int tot = 0;
#pragma unroll
        for (int p = 0; p < 16; ++p) tot += PS[p * 32 + e];
        const int padn = (tot + 255) & ~255; int inc = padn;
#pragma unroll
        for (int d = 1; d < 32; d <<= 1) { const int o = __shfl_up(inc, d, 32); inc += (e >= d) ? o : 0; }
        if (tid < 32) { PAD[e] = inc - padn; if (e == 31) PAD[32] = inc; } }
    WG_BAR();
    if (F.vcu == 0 && tid < 33) ETAB[tid] = PAD[tid];
    for (int tile = F.vcu; tile < NRT; tile += F.G) {
        if (tid < 32) { const int p = tile >> 5; int sm = PAD[tid];
#pragma unroll
            for (int pp = 0; pp < 16; ++pp) sm += (pp < p) ? PS[pp * 32 + tid] : 0;
#pragma unroll
            for (int j = 0; j < 32; ++j) { const int v = CNT[(32 * p + j) * 32 + tid]; sm += (32 * p + j < tile) ? v : 0; }
            BASE[tid] = sm; }
        WG_BAR();
        if (tid < 128) { const size_t ix = (size_t)tile * 128 + tid; const int e = RIDX[ix]; const int dest = BASE[e] + RRANK[ix];
            ROWTOK[dest] = (int)(ix >> 2); ROWGATE[dest] = RGATE[ix]; TDEST[ix] = dest; }
        WG_BAR();
    }
}

struct CombRows { f32x4 v[4]; unsigned y[4][4]; };
__device__ __forceinline__ void comb_load(CombRows& R, const float* H1, const unsigned char* YOUT, const int4 td, int m, int lane) {
    const f32x4* xr = (const f32x4*)(H1 + (size_t)m * D) + lane;
#pragma unroll
    for (int j = 0; j < 4; ++j) R.v[j] = __builtin_nontemporal_load(xr + 64 * j);
    const int dd[4] = {td.x, td.y, td.z, td.w};
#pragma unroll
    for (int p = 0; p < 4; ++p) { const unsigned* yr = (const unsigned*)(YOUT + (size_t)dd[p] * D) + lane;
#pragma unroll
        for (int j = 0; j < 4; ++j) R.y[p][j] = __builtin_nontemporal_load(yr + 64 * j); }
}
__device__ __forceinline__ void comb_store(const CombRows& R, const f32x4 (&gv)[4], float* out, int m, int lane) {
    f32x4 v[4]; float s = 0.f;
#pragma unroll
    for (int j = 0; j < 4; ++j) { v[j] = R.v[j];
#pragma unroll
        for (int p = 0; p < 4; ++p) { const unsigned y = R.y[p][j]; const f32x2 lo = __builtin_amdgcn_cvt_pk_f32_fp8(y, false), hi = __builtin_amdgcn_cvt_pk_f32_fp8(y, true);
            v[j].x += lo.x * (1.0f / FP8_SY); v[j].y += lo.y * (1.0f / FP8_SY); v[j].z += hi.x * (1.0f / FP8_SY); v[j].w += hi.y * (1.0f / FP8_SY); }
        s += (v[j].x * v[j].x + v[j].y * v[j].y) + (v[j].z * v[j].z + v[j].w * v[j].w); }
    const float rstd = __builtin_amdgcn_rsqf(wave_sum(s) * (1.0f / D) + 1e-5f);
    f32x4* o = (f32x4*)(out + (size_t)m * D) + lane;
#pragma unroll
    for (int j = 0; j < 4; ++j) __builtin_nontemporal_store(v[j] * rstd * gv[j], o + 64 * j);
}
__device__ __forceinline__ void combine_phase(const Ctx& F, float* out) {
    const int lane = F.lane; const int gw = F.vcu * 8 + F.wave, NGW = F.G * 8;
    const float* H1 = (const float*)(F.ws + WS_H1); const unsigned char* YOUT = F.ws + WS_YOUT; const int4* TDEST = (const int4*)(F.ws + WS_TDEST);
    f32x4 gv[4];
#pragma unroll
    for (int j = 0; j < 4; ++j) gv[j] = *((const f32x4*)F.in[I_FG] + lane + 64 * j);
    for (int m0 = gw; m0 < M; m0 += 8 * NGW) {
        int4 td[8];
#pragma unroll
        for (int i = 0; i < 8; ++i) { const int m = m0 + i * NGW; td[i] = TDEST[m < M ? m : M - 1]; }
        CombRows A, B;
        comb_load(A, H1, YOUT, td[0], m0, lane);
#pragma unroll
        for (int i = 0; i < 8; i += 2) {
            { const int m = m0 + (i + 1) * NGW; comb_load(B, H1, YOUT, td[i + 1], m < M ? m : M - 1, lane); }
            { const int m = m0 + i * NGW; if (m < M) comb_store(A, gv, out, m, lane); }
            if (i + 2 < 8) { const int m = m0 + (i + 2) * NGW; comb_load(A, H1, YOUT, td[i + 2], m < M ? m : M - 1, lane); }
            { const int m = m0 + (i + 1) * NGW; if (m < M) comb_store(B, gv, out, m, lane); }
        }
    }
}

__global__ void __launch_bounds__(512, 2) mk_fwd(Args args) {
    extern __shared__ __attribute__((aligned(16))) unsigned char lds_raw[];
    Ctx F;
    F.lds = (LAS unsigned char*)lds_raw;
    F.tid = threadIdx.x; F.lane = F.tid & 63; F.wave = __builtin_amdgcn_readfirstlane(F.tid >> 6);
    F.G = gridDim.x; { const int bx = blockIdx.x; F.vcu = (F.G % 8 == 0) ? (bx % 8) * (F.G / 8) + bx / 8 : bx; }
    F.ws = args.ws; F.in = args.in;
    volatile LAS unsigned* MISC = (volatile LAS unsigned*)(F.lds + MISC_OFF);
    if (F.tid < 64) MISC[F.tid] = 0u;
    __syncthreads();
    unsigned* ctl = (unsigned*)(args.ws + WS_CTL);
    XcdBarrier bar; bar.bar = ctl + CW_BAR; bar.x = 0; bar.st = nullptr;
    const int lo = args.ph_lo, hi = args.ph_hi;
    if (hi - lo > 1) bar = xcd_barrier_post(ctl + CW_BAR + args.li * XCD_BAR_WORDS, MISC + 8);
#define IN(k) (lo <= (k) && (k) < hi)
#define SEAM(k) do { if (IN(k) && IN((k) + 1)) xcd_barrier(bar); } while (0)
    unsigned char* ws = args.ws;

    if (IN(0)) REP(0) { p0_prologue(F); } SEAM(0);
    if (IN(1)) REP(1) {
        pg8::Gemm g{(const bf16_t*)(ws + WS_XN), (const bf16_t*)(ws + WS_WCAT), M, NPROJ, D}; pg8::StaticOrder S; S.init(M, NPROJ, D, F.G, (int)blockIdx.x);
        pg8::EpiProj E{(bf16_t*)(ws + WS_PROJ), NPROJ, 4};
        pg8::gemm_phase<pg8::EpiProj, pg8::StaticOrder, false>(F.lds, g, S, E);
    } SEAM(1);
    if (IN(2)) REP(2) { REP(10) sgu_phase(F); for (int u = F.vcu; u < NRU; u += F.G) rwkv_prep_unit(F, u); } SEAM(2);
    if (IN(3)) REP(3) { for (int u = F.vcu; u < NRU; u += F.G) rwkv_scan_unit(F, u); } SEAM(3);
    if (IN(4)) REP(4) {
        pg8::Gemm g{(const bf16_t*)(ws + WS_YCAT), (const bf16_t*)(ws + WS_WOUT), M, D, D}; pg8::StaticOrder S; S.init(M, D, D, F.G, (int)blockIdx.x);
        pg8::EpiResF32 E{F.in[I_X], (float*)(ws + WS_H1), D};
        pg8::gemm_phase<pg8::EpiResF32, pg8::StaticOrder, false>(F.lds, g, S, E);
    } SEAM(4);
    if (IN(5)) REP(5) { router_phase(F); } SEAM(5);
    if (IN(6)) REP(6) { scatter_phase(F); moe_weight_phase(F); } SEAM(6);
    if (IN(7)) REP(7) {
        const int* etab = (const int*)(ws + WS_ETAB);
        pg8::MoeOrder S; S.ntiles = etab[32] >> 8; S.nN = NHID / 256; S.G = F.G; S.c = (int)blockIdx.x; S.K = D; S.N = NHID; S.pad_start = etab; S.rowtok = (const int*)(ws + WS_ROWTOK); S.build_texp(F.lds);
        pg8::Gemm g{(const bf16_t*)(ws + WS_HN2), (const bf16_t*)(ws + WS_W1T), MAXROWS, NHID, D};
        pg8::EpiSwiglu E{ws + WS_ACT, F.in[I_MB1], &S};
        pg8::gemm_phase<pg8::EpiSwiglu, pg8::MoeOrder, true, true>(F.lds, g, S, E);
    } SEAM(7);
    if (IN(8)) REP(8) {
        const int* etab = (const int*)(ws + WS_ETAB);
        pg8::MoeOrder S; S.ntiles = etab[32] >> 8; S.nN = D / 256; S.G = F.G; S.c = (int)blockIdx.x; S.K = DEXP; S.N = D; S.pad_start = etab; S.rowtok = nullptr; S.build_texp(F.lds);
        pg8::Gemm g{(const bf16_t*)(ws + WS_ACT), (const bf16_t*)(ws + WS_W2T), MAXROWS, D, DEXP};
        pg8::EpiGate E{ws + WS_YOUT, F.in[I_MB2], (const float*)(ws + WS_ROWGATE), &S};
        pg8::gemm_phase<pg8::EpiGate, pg8::MoeOrder, false, true>(F.lds, g, S, E);
    } SEAM(8);
    if (IN(9)) REP(9) { combine_phase(F, args.out); }
#undef IN
#undef SEAM
}

extern "C" void kernel_launch(void* const* d_in, const int* in_sizes, int n_in, void* d_out, int out_size, void* d_ws, size_t ws_size, hipStream_t stream) {
    static int grid = 0;
    if (grid == 0) {
        if (n_in != 31 || in_sizes[0] != M * D || out_size != M * D || ws_size < WS_END) { fprintf(stderr, "kernel_launch: unexpected problem (n_in %d, out %d, ws %zu); nothing launched\n", n_in, out_size, ws_size); grid = -1; return; }
        int dev = 0, cus = 0, per_cu = 0;
        if (hipGetDevice(&dev) != hipSuccess || hipDeviceGetAttribute(&cus, hipDeviceAttributeMultiprocessorCount, dev) != hipSuccess) { grid = -1; return; }
        if (hipFuncSetAttribute((const void*)mk_fwd, hipFuncAttributeMaxDynamicSharedMemorySize, LDS_BYTES) != hipSuccess) { fprintf(stderr, "kernel_launch: hipFuncSetAttribute failed\n"); grid = -1; return; }
        if (hipOccupancyMaxActiveBlocksPerMultiprocessor(&per_cu, (const void*)mk_fwd, 512, LDS_BYTES) != hipSuccess || per_cu < 1) fprintf(stderr, "kernel_launch: occupancy query reports %d\n", per_cu);
        (void)hipGetLastError();
        grid = cus;
    }
    if (grid < 0) return;
    if (hipMemsetAsync((char*)d_ws + WS_CTL, 0, CTL_ZERO_BYTES, stream) != hipSuccess) return;
    Args a; memset(&a, 0, sizeof(a));
    for (int i = 0; i < 31; ++i) a.in[i] = (const float*)d_in[i];
    a.out = (float*)d_out; a.ws = (unsigned char*)d_ws;
    constexpr int NL = MK_N_LAUNCHES;
    static_assert(NL == 1 || NL == N_PHASES, "MK_N_LAUNCHES: 1 (one launch) or 10 (one launch per phase)");
    for (int li = 0; li < NL; ++li) {
        a.ph_lo = (NL == 1) ? 0 : li; a.ph_hi = (NL == 1) ? N_PHASES : li + 1; a.li = 0; a.pad = 0;
        hipLaunchKernelGGL(mk_fwd, dim3(grid), dim3(512), LDS_BYTES, stream, a);
    }
}
```

```cpp
#include <hip/hip_runtime.h>
#include <cstdio>
#include <cstdint>
#include <cstring>

#ifndef MK_N_LAUNCHES
#define MK_N_LAUNCHES 1
#endif
constexpr int N_PHASES = 10;
#ifndef PROBE_MASK
#define PROBE_MASK 0
#endif
#define REP(k) for (int rep_ = 0; rep_ < (((PROBE_MASK >> (k)) & 1) ? 2 : 1); ++rep_)

#define LAS __attribute__((address_space(3)))
#define GAS __attribute__((address_space(1)))
typedef unsigned short bf16_t;
typedef short bf16x8 __attribute__((ext_vector_type(8)));
typedef float f32x4 __attribute__((ext_vector_type(4)));
typedef float f32x2 __attribute__((ext_vector_type(2)));
typedef float f32x16 __attribute__((ext_vector_type(16)));
typedef unsigned u32x4 __attribute__((ext_vector_type(4)));
typedef unsigned u32x2 __attribute__((ext_vector_type(2)));
typedef GAS unsigned gu32;
#define RLX_AGENT __ATOMIC_RELAXED, __HIP_MEMORY_SCOPE_AGENT
#define LDS_WAIT() asm volatile("s_waitcnt lgkmcnt(0)" ::: "memory")
#define VM_WAIT() asm volatile("s_waitcnt vmcnt(0)" ::: "memory")
#define WG_BAR() do { asm volatile("s_waitcnt vmcnt(0) lgkmcnt(0)" ::: "memory"); __builtin_amdgcn_s_barrier(); asm volatile("" ::: "memory"); } while (0)

constexpr int BATCH = 2, SEQ = 8192, D = 1024, M = BATCH * SEQ;
constexpr int NPROJ = 3072;
constexpr int COL_V = 512, COL_R = 1024, COL_K = 1536, COL_VR = 2048, COL_LA = 2560, COL_LB = 2816;
constexpr int NEXP = 32, TOPK = 4, DEXP = 1024, NHID = 2048;
constexpr int NASSIGN = M * TOPK;
constexpr int MAXROWS = NASSIGN + NEXP * 256;
constexpr int RT_TOK = 32, NRT = M / RT_TOK;
constexpr int CH = 64, NCHUNK = SEQ / CH, SEGC = 8, NSEG = NCHUNK / SEGC;
constexpr int NRU = BATCH * 8 * NSEG;

constexpr size_t MiB = 1u << 20;
constexpr size_t WS_CTL = 0, CTL_ZERO_BYTES = 13824;
constexpr size_t WS_WCAT = 2 * MiB;
constexpr size_t WS_WOUT = 8 * MiB;
constexpr size_t WS_SMALL = 10 * MiB;
constexpr size_t WS_LW2 = WS_SMALL;
constexpr size_t WS_LA2 = WS_LW2 + 512 * 64 * 2;
constexpr size_t WS_LG2 = WS_LA2 + 512 * 64 * 2;
constexpr size_t WS_SGUW = WS_LG2 + 512 * 128 * 2;
constexpr size_t WS_RW = WS_SGUW + 8 * 128 * 128 * 2;
constexpr size_t WS_ETAB = WS_RW + 1024 * 32 * 4;
constexpr size_t WS_CNT = WS_ETAB + 1024;
constexpr size_t WS_RIDX = WS_CNT + NRT * 32 * 4;
constexpr size_t WS_RGATE = WS_RIDX + (size_t)M * 4 * 4;
constexpr size_t WS_RRANK = WS_RGATE + (size_t)M * 4 * 4;
constexpr size_t WS_TDEST = WS_RRANK + (size_t)M * 4 * 4;
static_assert(WS_TDEST + (size_t)M * 4 * 4 <= 12 * MiB, "small region");
constexpr size_t WS_ROWTOK = 12 * MiB;
constexpr size_t WS_ROWGATE = 13 * MiB;
constexpr size_t WS_SEGP = 14 * MiB;
constexpr size_t WS_SEGQ = 16 * MiB;
constexpr size_t WS_XN = 32 * MiB;
constexpr size_t WS_YCAT = 64 * MiB;
constexpr size_t WS_HN2 = 96 * MiB;
constexpr size_t WS_H1 = 128 * MiB;
constexpr size_t WS_PROJ = 192 * MiB;
constexpr size_t WS_W1T = 288 * MiB;
constexpr size_t WS_W2T = 416 * MiB;
constexpr size_t WS_ACT = 480 * MiB;
constexpr size_t WS_YOUT = 624 * MiB;
constexpr size_t WS_RK = 768 * MiB;
constexpr size_t WS_PHIT = WS_RK, WS_PSI = WS_RK + 8192, WS_YS = WS_RK + 16384, WS_YL = WS_RK + 24576, WS_GT = WS_RK + 32768, WS_BV = WS_RK + 40960;
constexpr size_t WS_END = 864 * MiB;
constexpr int CW_BAR = 0;

constexpr int RING_BYTES = 131072;
constexpr int TAB_OFF = 151552;
constexpr int PRE_OFF = RING_BYTES;
constexpr int TEXP_OFF = TAB_OFF + 2048;
constexpr int LDS_BYTES = 155648;
constexpr int MISC_OFF = LDS_BYTES - 256;

typedef __bf16 bf16v2_t __attribute__((ext_vector_type(2)));
__device__ __forceinline__ unsigned pk2(float lo, float hi) { const f32x2 v = {lo, hi}; return __builtin_bit_cast(unsigned, __builtin_convertvector(v, bf16v2_t)); }
__device__ __forceinline__ unsigned f2bf(float f) { return pk2(f, 0.f) & 0xffffu; }
__device__ __forceinline__ float bf2f(unsigned short b) { return __builtin_bit_cast(float, (unsigned)b << 16); }
__device__ __forceinline__ float bflo(unsigned w) { return __builtin_bit_cast(float, w << 16); }
__device__ __forceinline__ float bfhi(unsigned w) { return __builtin_bit_cast(float, w & 0xffff0000u); }
__device__ __forceinline__ void unpack8(const u32x4 w, float (&o)[8]) { o[0] = bflo(w.x); o[1] = bfhi(w.x); o[2] = bflo(w.y); o[3] = bfhi(w.y); o[4] = bflo(w.z); o[5] = bfhi(w.z); o[6] = bflo(w.w); o[7] = bfhi(w.w); }
__device__ __forceinline__ u32x4 pack8(const float (&v)[8]) { u32x4 w; w.x = pk2(v[0], v[1]); w.y = pk2(v[2], v[3]); w.z = pk2(v[4], v[5]); w.w = pk2(v[6], v[7]); return w; }
__device__ __forceinline__ float fsigmoid(float x) { return __builtin_amdgcn_rcpf(1.0f + __expf(-x)); }
__device__ __forceinline__ unsigned pk4_fp8(float a, float b, float c, float d) {
    a = fminf(fmaxf(a, -448.f), 448.f); b = fminf(fmaxf(b, -448.f), 448.f); c = fminf(fmaxf(c, -448.f), 448.f); d = fminf(fmaxf(d, -448.f), 448.f);
    unsigned w = 0u; w = __builtin_amdgcn_cvt_pk_fp8_f32(a, b, w, false); w = __builtin_amdgcn_cvt_pk_fp8_f32(c, d, w, true); return w; }
constexpr float FP8_SW = 64.0f;
constexpr float FP8_SA = 4.0f;
constexpr float FP8_SY = 16.0f;
__device__ __forceinline__ float wave_sum(float v) {
#pragma unroll
    for (int o = 1; o < 64; o <<= 1) v += __shfl_xor(v, o);
    return v;
}

namespace pg8 {
constexpr int BM = 256, BK = 64, HALF = 128, HTB = HALF * BK * 2, STAGE_BYTES = 8 * HTB, NXCD = 8, WGM = 8;
__host__ __device__ __forceinline__ int lds_byte(int r, int c) { const int st = (r >> 4) * 2 + (c >> 5), rr = r & 15, cc = c & 31, ob = rr * 64 + cc * 2; return st * 1024 + (ob ^ (((ob >> 9) & 1) << 5)); }
__host__ __device__ __forceinline__ void stage_rc(int b, int& R, int& C) { const int st = b / 1024, sb = b % 1024, swz = sb ^ (((sb >> 9) & 1) << 5); R = (st >> 1) * 16 + swz / 64; C = (st & 1) * 32 + (swz % 64) / 2; }
__host__ __device__ __forceinline__ int perm32(int rho) { const int n = rho >> 4, i = rho & 15; return 8 * (i >> 2) + 4 * n + (i & 3); }

struct Unit { int pm, pn; };
struct Gemm { const bf16_t* A; const bf16_t* Bt; int M, N, K; };

struct StaticOrder {
    int nM, nN, nwg, G, c, K;
    __device__ void init(int M_, int N_, int K_, int G_, int c_) { nM = M_ / BM; nN = N_ / BM; nwg = nM * nN; G = G_; c = c_; K = K_ * 2; }
    __device__ bool next(int i, Unit& u) const {
        const long L = (long)i * G + c; if (L >= nwg) return false;
        int wgid = (int)L; { const int q = nwg / NXCD, r = nwg % NXCD, xcd = wgid % NXCD, off = wgid / NXCD; wgid = (xcd < r ? xcd * (q + 1) : r * (q + 1) + (xcd - r) * q) + off; }
        const int nig = WGM * nN, gid = wgid / nig, fm = gid * WGM, gsz = (nM - fm) < WGM ? (nM - fm) : WGM;
        u.pm = fm + ((wgid % nig) % gsz); u.pn = (wgid % nig) / gsz; return true;
    }
    __device__ __forceinline__ size_t a_off(const Unit& u) const { return (size_t)u.pm * BM * K; }
    __device__ __forceinline__ size_t b_off(const Unit& u) const { return (size_t)u.pn * BM * K; }
    __device__ __forceinline__ const int* rows(const Unit&) const { return nullptr; }
};
struct MoeOrder {
    int ntiles, nN, G, c, K, N; const int* pad_start; const int* rowtok; const LAS unsigned char* texp;
    __device__ __forceinline__ int expert_of(int pm) const { return (int)texp[pm]; }
    __device__ __forceinline__ void build_texp(LAS unsigned char* lds) { LAS unsigned char* t = lds + TEXP_OFF;
        for (int pm = (int)threadIdx.x; pm < MAXROWS / BM; pm += 512) { const int r0 = pm * BM; int e = 0;
            for (int j = 1; j < NEXP; ++j) if (pad_start[j] <= r0) e = j;
            t[pm] = (unsigned char)e; }
        texp = t; WG_BAR(); }
    __device__ bool next(int i, Unit& u) const { const long L = (long)i * G + c; if (L >= (long)ntiles * nN) return false; u.pm = (int)(L / nN); u.pn = (int)(L % nN); return true; }
    __device__ __forceinline__ size_t a_off(const Unit& u) const { return (size_t)u.pm * BM * K; }
    __device__ __forceinline__ size_t b_off(const Unit& u) const { return ((size_t)expert_of(u.pm) * N + (size_t)u.pn * BM) * K; }
    __device__ __forceinline__ const int* rows(const Unit& u) const { return rowtok + u.pm * BM; }
};

__device__ __forceinline__ unsigned cvt_pk_bf16(float lo, float hi) { unsigned r; asm volatile("v_cvt_pk_bf16_f32 %0, %1, %2" : "=v"(r) : "v"(lo), "v"(hi)); return r; }
__device__ __forceinline__ f32x2 gelu_pk(f32x2 v) {
    const f32x2 av = __builtin_elementwise_abs(v), d = av * 0.2316418882f + 1.0f;
    f32x2 t; t.x = __builtin_amdgcn_rcpf(d.x); t.y = __builtin_amdgcn_rcpf(d.y);
    f32x2 q = t * 0.5307027145f + (-0.7265760135f); q = q * t + 0.7107068705f; q = q * t + (-0.142248368f); q = q * t + 0.127414796f; q = q * t;
    const f32x2 s = (v * v) * (-0.72134752044f);
    f32x2 e; e.x = __builtin_amdgcn_exp2f(s.x); e.y = __builtin_amdgcn_exp2f(s.y);
    const f32x2 m = v * (q * e), r = v - m;
    f32x2 o; o.x = v.x < 0.f ? m.x : r.x; o.y = v.y < 0.f ? m.y : r.y; return o;
}
struct EpiProj {
    static constexpr bool PERM = true; static constexpr int NPRE = 0;
    bf16_t* O; int ldc; int ngelu;
    __device__ __forceinline__ const float* pre_src(const Unit&, int) const { return nullptr; }
    __device__ __forceinline__ void operator()(const f32x4 (&acc)[2][2][4][2], const Unit& u, int wr, int wc, int fr, int fq, const LAS float*) const {
        const int row0 = u.pm * BM + wr * 64 + fr, col0 = u.pn * BM + wc * 32 + 8 * fq; const bool act = u.pn < ngelu;
#pragma unroll
        for (int ai = 0; ai < 2; ++ai)
#pragma unroll
            for (int m = 0; m < 4; ++m) { bf16_t* rowp = O + (size_t)(row0 + ai * HALF + m * 16) * ldc + col0;
#pragma unroll
                for (int bj = 0; bj < 2; ++bj) { f32x4 v0 = acc[ai][bj][m][0], v1 = acc[ai][bj][m][1];
                    if (act) { f32x2 a = gelu_pk((f32x2){v0[0], v0[1]}), b = gelu_pk((f32x2){v0[2], v0[3]}), c = gelu_pk((f32x2){v1[0], v1[1]}), d = gelu_pk((f32x2){v1[2], v1[3]});
                        v0 = (f32x4){a.x, a.y, b.x, b.y}; v1 = (f32x4){c.x, c.y, d.x, d.y}; }
                    u32x4 w; w.x = cvt_pk_bf16(v0[0], v0[1]); w.y = cvt_pk_bf16(v0[2], v0[3]); w.z = cvt_pk_bf16(v1[0], v1[1]); w.w = cvt_pk_bf16(v1[2], v1[3]);
                    *(u32x4*)(rowp + bj * HALF) = w; } }
    }
};
struct EpiResF32 {
    static constexpr bool PERM = false; static constexpr int NPRE = 0;
    const float* base; float* out; int ldc;
    __device__ __forceinline__ const float* pre_src(const Unit&, int) const { return nullptr; }
    __device__ __forceinline__ void operator()(const f32x4 (&acc)[2][2][4][2], const Unit& u, int wr, int wc, int fr, int fq, const LAS float*) const {
        const int col0 = u.pn * BM + wc * 32 + 4 * fq;
#pragma unroll
        for (int ai = 0; ai < 2; ++ai)
#pragma unroll
            for (int m = 0; m < 4; ++m) { const size_t off = (size_t)(u.pm * BM + ai * HALF + wr * 64 + m * 16 + fr) * ldc + col0;
#pragma unroll
                for (int bj = 0; bj < 2; ++bj)
#pragma unroll
                    for (int n = 0; n < 2; ++n) { const f32x4 bs = *(const f32x4*)(base + off + bj * HALF + n * 16); *(f32x4*)(out + off + bj * HALF + n * 16) = bs + acc[ai][bj][m][n]; } }
    }
};
struct EpiSwiglu {
    static constexpr bool PERM = true; static constexpr int NPRE = 4;
    unsigned char* O; const float* b1; const MoeOrder* S;
    __device__ __forceinline__ const float* pre_src(const Unit& u, int w) const { return b1 + (size_t)S->expert_of(u.pm) * NHID + u.pn * BM + w * 64; }
    __device__ __forceinline__ void operator()(const f32x4 (&acc)[2][2][4][2], const Unit& u, int wr, int wc, int fr, int fq, const LAS float* pre) const {
        const int row0 = u.pm * BM + wr * 64 + fr, oc0 = u.pn * HALF + wc * 32 + 8 * fq;
        const LAS f32x4* bp = (const LAS f32x4*)(pre + 2 * (wc * 32 + 8 * fq));
        f32x4 bg[2], bl[2];
#pragma unroll
        for (int n = 0; n < 2; ++n) { const f32x4 x0 = bp[2 * n], x1 = bp[2 * n + 1]; bg[n] = (f32x4){x0[0], x0[2], x1[0], x1[2]}; bl[n] = (f32x4){x0[1], x0[3], x1[1], x1[3]}; }
#pragma unroll
        for (int ai = 0; ai < 2; ++ai)
#pragma unroll
            for (int m = 0; m < 4; ++m) { unsigned char* rowp = O + (size_t)(row0 + ai * HALF + m * 16) * DEXP + oc0; float o[8];
#pragma unroll
                for (int n = 0; n < 2; ++n) { const f32x4 g = acc[ai][0][m][n] * (1.0f / FP8_SW) + bg[n], l = acc[ai][1][m][n] * (1.0f / FP8_SW) + bl[n];
#pragma unroll
                    for (int q = 0; q < 4; ++q) { const float gg = fminf(g[q], 7.0f), ll = __builtin_amdgcn_fmed3f(l[q], -7.0f, 7.0f);
                        const float sg = gg * __builtin_amdgcn_rcpf(1.0f + __builtin_amdgcn_exp2f(gg * (-1.702f * 1.4426950408889634f)));
                        o[4 * n + q] = sg * __builtin_fmaf(ll, FP8_SA, FP8_SA); } }
                u32x2 w; { unsigned w0 = 0u; w0 = __builtin_amdgcn_cvt_pk_fp8_f32(o[0], o[1], w0, false); w0 = __builtin_amdgcn_cvt_pk_fp8_f32(o[2], o[3], w0, true); w.x = w0; }
                { unsigned w1 = 0u; w1 = __builtin_amdgcn_cvt_pk_fp8_f32(o[4], o[5], w1, false); w1 = __builtin_amdgcn_cvt_pk_fp8_f32(o[6], o[7], w1, true); w.y = w1; }
                *(u32x2*)rowp = w; }
    }
};
struct EpiGate {
    static constexpr bool PERM = true; static constexpr int NPRE = 8;
    unsigned char* O; const float* b2; const float* rowgate; const MoeOrder* S;
    __device__ __forceinline__ const float* pre_src(const Unit& u, int w) const { return w < 4 ? b2 + (size_t)S->expert_of(u.pm) * D + u.pn * BM + w * 64 : rowgate + (size_t)u.pm * BM + (w - 4) * 64; }
    __device__ __forceinline__ void operator()(const f32x4 (&acc)[2][2][4][2], const Unit& u, int wr, int wc, int fr, int fq, const LAS float* pre) const {
        const int row0 = u.pm * BM + wr * 64 + fr, col0 = u.pn * BM + wc * 32 + 8 * fq;
        f32x4 bv[2][2];
#pragma unroll
        for (int bj = 0; bj < 2; ++bj)
#pragma unroll
            for (int n = 0; n < 2; ++n) bv[bj][n] = *(const LAS f32x4*)(pre + wc * 32 + 8 * fq + bj * HALF + 4 * n);
#pragma unroll
        for (int ai = 0; ai < 2; ++ai)
#pragma unroll
            for (int m = 0; m < 4; ++m) { const int row = row0 + ai * HALF + m * 16; const float gt = pre[BM + wr * 64 + fr + ai * HALF + m * 16] * FP8_SY; unsigned char* rowp = O + (size_t)row * D + col0;
#pragma unroll
                for (int bj = 0; bj < 2; ++bj) { const f32x4 v0 = (acc[ai][bj][m][0] * (1.0f / (FP8_SW * FP8_SA)) + bv[bj][0]) * gt, v1 = (acc[ai][bj][m][1] * (1.0f / (FP8_SW * FP8_SA)) + bv[bj][1]) * gt;
                    u32x2 w; w.x = pk4_fp8(v0[0], v0[1], v0[2], v0[3]); w.y = pk4_fp8(v1[0], v1[1], v1[2], v1[3]);
                    *(u32x2*)(rowp + bj * HALF) = w; } }
    }
};

typedef int v8i32 __attribute__((ext_vector_type(8)));
template <class Epi, class Sched, bool GATHER, bool FP8 = false>
__device__ __forceinline__ void gemm_phase(LAS unsigned char* lds, const Gemm g, const Sched& S, const Epi& E) {
    const int tid = threadIdx.x, wid = __builtin_amdgcn_readfirstlane(tid >> 6), lane = tid & 63, wr = wid >> 2, wc = wid & 3, fr = lane & 15, fq = lane >> 4;
    const int K = FP8 ? g.K : g.K * 2  , nt = K / (BK * 2);
    unsigned voffA[2], voffB[2]; int rA[2];
#pragma unroll
    for (int i = 0; i < 2; ++i) { int R, C; stage_rc(tid * 16 + i * 8192, R, C); const int Rb = Epi::PERM ? ((R & ~31) + perm32(R & 31)) : R;
        voffA[i] = GATHER ? (unsigned)(C * 2) : (unsigned)(R * K + C * 2); voffB[i] = (unsigned)(Rb * K + C * 2); rA[i] = R; }
    const size_t kstep = (size_t)(BK * 2);
    const size_t hstep = (size_t)HALF * K;
    const unsigned ldsw = (unsigned)wid * 1024u;
    const int aoff0 = lds_byte(wr * 64 + fr, fq * 8), aoff1 = aoff0 + 1024;
    const int boff0 = lds_byte(wc * 32 + fr, fq * 8), boff1 = boff0 + 1024;
    LAS unsigned* tab = (LAS unsigned*)(lds + TAB_OFF);
#define PG8_SA(b, h) (((b) * 2 + (h)) * HTB)
#define PG8_SB(b, h) ((4 + (b) * 2 + (h)) * HTB)
#define PG8_STAGE(bufoff, gbase, voff) do { _Pragma("unroll") for (int _i = 0; _i < 2; ++_i) \
        __builtin_amdgcn_global_load_lds((const unsigned*)((const char*)(gbase) + (voff)[_i]), (LAS unsigned*)(lds + (bufoff) + ldsw + _i * 8192), 16, 0, 0); } while (0)
#define PG8_STAGE_A(bufoff, gbase, h, sl) do { if constexpr (GATHER) { _Pragma("unroll") for (int _i = 0; _i < 2; ++_i) { const unsigned _ro = tab[(sl) * 256 + (h) * 128 + rA[_i]]; \
        __builtin_amdgcn_global_load_lds((const unsigned*)((const char*)(gbase) + _ro + voffA[_i]), (LAS unsigned*)(lds + (bufoff) + ldsw + _i * 8192), 16, 0, 0); } } \
        else { PG8_STAGE(bufoff, (const char*)(gbase) + (h) * hstep, voffA); } } while (0)
#define PG8_LDA(dst, b, h) do { _Pragma("unroll") for (int m = 0; m < 4; ++m) { dst[m][0] = *(const LAS bf16x8*)(lds + PG8_SA(b, h) + aoff0 + m * 2048); dst[m][1] = *(const LAS bf16x8*)(lds + PG8_SA(b, h) + aoff1 + m * 2048); } } while (0)
#define PG8_LDB(dst, b, h) do { _Pragma("unroll") for (int n = 0; n < 2; ++n) { dst[n][0] = *(const LAS bf16x8*)(lds + PG8_SB(b, h) + boff0 + n * 2048); dst[n][1] = *(const LAS bf16x8*)(lds + PG8_SB(b, h) + boff1 + n * 2048); } } while (0)
#define PG8_CAT(x) __builtin_bit_cast(v8i32, __builtin_shufflevector((x)[0], (x)[1], 0, 1, 2, 3, 4, 5, 6, 7, 8, 9, 10, 11, 12, 13, 14, 15))
#define PG8_MMA(ai, bj, At, Bt) do { __builtin_amdgcn_s_setprio(1); _Pragma("unroll") for (int m = 0; m < 4; ++m) _Pragma("unroll") for (int n = 0; n < 2; ++n) { \
        if constexpr (FP8) acc[ai][bj][m][n] = __builtin_amdgcn_mfma_scale_f32_16x16x128_f8f6f4(PG8_CAT(Bt[n]), PG8_CAT(At[m]), acc[ai][bj][m][n], 0, 0, 0, 0x7f7f7f7f, 0, 0x7f7f7f7f); \
        else { _Pragma("unroll") for (int k = 0; k < 2; ++k) acc[ai][bj][m][n] = __builtin_amdgcn_mfma_f32_16x16x32_bf16(Bt[n][k], At[m][k], acc[ai][bj][m][n], 0, 0, 0); } } \
        __builtin_amdgcn_s_setprio(0); \
        if constexpr (FP8) { _Pragma("unroll") for (int m = 0; m < 4; ++m) asm volatile("" : "+v"(acc[ai][bj][m][0]), "+v"(acc[ai][bj][m][1])); } } while (0)
#define PG8_WAIT_V(n) asm volatile("s_waitcnt vmcnt(" #n ")" ::: "memory")
#define PG8_WAIT_L(n) asm volatile("s_waitcnt lgkmcnt(" #n ")" ::: "memory")
#define PG8_BAR __builtin_amdgcn_s_barrier()
#define PG8_SCHED __builtin_amdgcn_sched_barrier(0)
#define PG8_SCHF do { if constexpr (FP8) __builtin_amdgcn_sched_barrier(0); } while (0)
    Unit cur, nxt; int ui = 0;
    if (!S.next(0, cur)) return;
    f32x4 acc[2][2][4][2];
#pragma unroll
    for (int a = 0; a < 2; ++a)
#pragma unroll
        for (int b = 0; b < 2; ++b)
#pragma unroll
            for (int m = 0; m < 4; ++m)
#pragma unroll
                for (int n = 0; n < 2; ++n) acc[a][b][m][n] = (f32x4){0.f, 0.f, 0.f, 0.f};
    bf16x8 At[4][2], B0[2][2], B1[2][2];
    const char* cA = (const char*)g.A + (GATHER ? (size_t)0 : S.a_off(cur)); const char* cB = (const char*)g.Bt + S.b_off(cur);
    if constexpr (GATHER) {
        if (tid < 256) tab[tid] = (unsigned)S.rows(cur)[tid] * (unsigned)K;
        WG_BAR();
    }
    PG8_STAGE(PG8_SB(0, 0), cB, voffB); PG8_STAGE(PG8_SB(0, 1), cB + hstep, voffB); PG8_STAGE_A(PG8_SA(0, 0), cA, 0, 0); PG8_STAGE_A(PG8_SA(0, 1), cA, 1, 0);
    if (wr == 1) PG8_BAR;
    PG8_WAIT_V(2); PG8_BAR;
    PG8_STAGE(PG8_SB(1, 0), cB + kstep, voffB); PG8_STAGE_A(PG8_SA(1, 0), cA + kstep, 0, 0); PG8_STAGE(PG8_SB(1, 1), cB + hstep + kstep, voffB);
    PG8_WAIT_V(6); PG8_BAR;
    for (;;) {
        const bool has_next = S.next(ui + 1, nxt);
        const int sc = ui & 1, sn = has_next ? ((ui + 1) & 1) : sc;
        if constexpr (GATHER) { if (has_next && tid < 256) tab[sn * 256 + tid] = (unsigned)S.rows(nxt)[tid] * (unsigned)K; }
        const char* nA = has_next ? (const char*)g.A + (GATHER ? (size_t)0 : S.a_off(nxt)) : cA; const char* nB = has_next ? (const char*)g.Bt + S.b_off(nxt) : cB;
        if constexpr (Epi::NPRE > 0) { if (wid < Epi::NPRE)
            __builtin_amdgcn_global_load_lds((const unsigned*)(E.pre_src(cur, wid) + lane), (LAS unsigned*)(lds + PRE_OFF + sc * 2048 + wid * 256), 4, 0, 0); }
        for (int t = 0; t < nt; t += 2) {
            const bool last = (t == nt - 2);
            const char* a1 = cA + (size_t)(t + 1) * kstep;
            const char* a2 = last ? nA : cA + (size_t)(t + 2) * kstep; const char* b2 = last ? nB : cB + (size_t)(t + 2) * kstep;
            const char* a3 = a2 + kstep; const char* b3 = b2 + kstep;
            const int s2 = last ? sn : sc;
            PG8_LDB(B0, 0, 0); PG8_LDB(B1, 0, 1); PG8_SCHED; PG8_LDA(At, 0, 0); PG8_STAGE_A(PG8_SA(1, 1), a1, 1, sc);
            PG8_WAIT_V(8); PG8_WAIT_L(0); PG8_BAR; PG8_SCHF; PG8_MMA(0, 0, At, B0); PG8_MMA(0, 1, At, B1); PG8_BAR; PG8_SCHED;
            PG8_LDA(At, 0, 1); PG8_STAGE(PG8_SB(0, 0), b2, voffB); PG8_STAGE(PG8_SB(0, 1), b2 + hstep, voffB); PG8_STAGE_A(PG8_SA(0, 0), a2, 0, s2);
            PG8_WAIT_V(8); PG8_WAIT_L(0); PG8_BAR; PG8_SCHF; PG8_MMA(1, 0, At, B0); PG8_MMA(1, 1, At, B1); PG8_BAR; PG8_SCHED;
            PG8_LDB(B0, 1, 0); PG8_LDB(B1, 1, 1); PG8_SCHED; PG8_LDA(At, 1, 0); PG8_STAGE_A(PG8_SA(0, 1), a2, 1, s2);
            PG8_WAIT_V(8); PG8_WAIT_L(0); PG8_BAR; PG8_SCHF; PG8_MMA(0, 0, At, B0); PG8_MMA(0, 1, At, B1); PG8_BAR; PG8_SCHED;
            PG8_LDA(At, 1, 1); PG8_STAGE(PG8_SB(1, 0), b3, voffB); PG8_STAGE(PG8_SB(1, 1), b3 + hstep, voffB); PG8_STAGE_A(PG8_SA(1, 0), a3, 0, s2);
            PG8_WAIT_V(8); PG8_WAIT_L(0); PG8_BAR; PG8_SCHF; PG8_MMA(1, 0, At, B0); PG8_MMA(1, 1, At, B1); PG8_BAR; PG8_SCHED;
        }
        if (wr == 0) PG8_BAR;
        E(acc, cur, wr, wc, fr, fq, (const LAS float*)(lds + PRE_OFF + sc * 2048));
        if (!has_next) break;
#pragma unroll
        for (int a = 0; a < 2; ++a)
#pragma unroll
            for (int b = 0; b < 2; ++b)
#pragma unroll
                for (int m = 0; m < 4; ++m)
#pragma unroll
                    for (int n = 0; n < 2; ++n) acc[a][b][m][n] = (f32x4){0.f, 0.f, 0.f, 0.f};
        cur = nxt; cA = nA; cB = nB; ++ui;
        if (wr == 1) PG8_BAR;
    }
    PG8_WAIT_V(0);
    PG8_BAR;
#undef PG8_SA
#undef PG8_SB
#undef PG8_STAGE
#undef PG8_STAGE_A
#undef PG8_LDA
#undef PG8_LDB
#undef PG8_MMA
#undef PG8_CAT
#undef PG8_WAIT_V
#undef PG8_WAIT_L
#undef PG8_BAR
#undef PG8_SCHED
#undef PG8_SCHF
}
}

#define XB_TMO      128
#define XB_XCNT(j)  (256  + 64 * (j))
#define XB_XSUB(j)  (1280 + 64 * (j))
#define XB_XGEN(j)  (2304 + 64 * (j))
#define XB_TOP      3328
#define XB_TOPGEN   3392
#define XCD_BAR_WORDS 3456
#define XB_SPIN_CAP (1u << 18)
__device__ __forceinline__ unsigned xb_ld(unsigned* p)              { return __hip_atomic_load(p, __ATOMIC_RELAXED, __HIP_MEMORY_SCOPE_AGENT); }
__device__ __forceinline__ unsigned xb_add(unsigned* p, unsigned v) { return __hip_atomic_fetch_add(p, v, __ATOMIC_RELAXED, __HIP_MEMORY_SCOPE_AGENT); }
__device__ __forceinline__ unsigned xb_xcc_id() { return (unsigned)__builtin_amdgcn_s_getreg((3 << 11) | 20) & 0xFu; }
#define XB_SPIN(cond, bar) do { unsigned _sp = 0; while (cond) { __builtin_amdgcn_s_sleep(1); \
    if ((++_sp & 255u) == 0u) { if (xb_ld(&(bar)[XB_TMO])) break; if (_sp > XB_SPIN_CAP) { atomicAdd(&(bar)[XB_TMO], 1u); break; } } } } while (0)
struct XcdBarrier { unsigned* bar; unsigned x; volatile LAS unsigned* st; };
__device__ __forceinline__ XcdBarrier xcd_barrier_post(unsigned* bar, volatile LAS unsigned* st) {
    XcdBarrier b; b.bar = bar; b.x = xb_xcc_id(); b.st = st;
    if (threadIdx.x == 0) (void)xb_add(&bar[XB_XCNT(b.x)], 1u);
    return b;
}
__device__ __forceinline__ void xcd_barrier_complete(unsigned* bar, unsigned x, unsigned& nloc, unsigned& nx) {
    const unsigned G = gridDim.x * gridDim.y * gridDim.z;
    unsigned sum, cnt, mine, sp = 0u;
    for (;;) {
        sum = 0u; cnt = 0u; mine = 0u;
#pragma unroll
        for (unsigned j = 0; j < 16; ++j) { const unsigned c = xb_ld(&bar[XB_XCNT(j)]); sum += c; cnt += (c > 0u) ? 1u : 0u; mine = (j == x) ? c : mine; }
        if (sum == G) break;
        __builtin_amdgcn_s_sleep(1);
        if ((++sp & 255u) == 0u) { if (xb_ld(&bar[XB_TMO])) break; if (sp > XB_SPIN_CAP) { atomicAdd(&bar[XB_TMO], 1u); break; } }
    }
    nloc = mine > 0u ? mine : 1u; nx = cnt > 0u ? cnt : 1u;
}
__device__ __forceinline__ void xcd_barrier(const XcdBarrier& b) {
    asm volatile("s_waitcnt vmcnt(0)" ::: "memory");
    __syncthreads();
    if (threadIdx.x == 0) {
        unsigned* bar = b.bar;
        __builtin_amdgcn_s_waitcnt(0);
        unsigned nloc = b.st[0], nx = b.st[1];
        if (nloc == 0u) { xcd_barrier_complete(bar, b.x, nloc, nx); b.st[0] = nloc; b.st[1] = nx; }
        const unsigned old = xb_add(&bar[XB_XSUB(b.x)], 1u);
        const unsigned gen = old / nloc;
        if (old + 1u == (gen + 1u) * nloc) {
            __builtin_amdgcn_fence(__ATOMIC_RELEASE, "agent");
            asm volatile("s_waitcnt vmcnt(0)" ::: "memory");
            const unsigned og = xb_add(&bar[XB_TOP], 1u);
            const unsigned tg = og / nx;
            if (og + 1u == (tg + 1u) * nx) xb_add(&bar[XB_TOPGEN], 1u);
            else XB_SPIN(xb_ld(&bar[XB_TOPGEN]) == tg, bar);
            __builtin_amdgcn_fence(__ATOMIC_ACQUIRE, "agent");
            xb_add(&bar[XB_XGEN(b.x)], 1u);
            asm volatile("s_waitcnt vmcnt(0)" ::: "memory");
        } else {
            XB_SPIN(xb_ld(&bar[XB_XGEN(b.x)]) == gen, bar);
            __builtin_amdgcn_fence(__ATOMIC_ACQUIRE, "agent");
            asm volatile("s_waitcnt vmcnt(0)" ::: "memory");
        }
    }
    __syncthreads();
}

struct Args {
    const float* in[31]; float* out; unsigned char* ws;
    int ph_lo, ph_hi, li, pad;
};
enum { I_X = 0, I_N1G, I_WIN, I_SLNG, I_SLNB, I_SGUW, I_SGUB, I_MURKV, I_MUWAG, I_W0, I_W1, I_W2, I_A0, I_A1, I_A2, I_G1, I_G2, I_KK, I_KA, I_RK, I_LNXG, I_LNXB, I_WOUT, I_N2G, I_RW, I_RB,
       I_MW1, I_MB1, I_MW2, I_MB2, I_FG };

struct Ctx { LAS unsigned char* lds; int tid, lane, wave, G, vcu; unsigned char* ws; const float* const* in; };

template <int KS> __device__ __forceinline__ void mma_nt(f32x4& acc, const LAS bf16_t* X, int ldx, const LAS bf16_t* Y, int ldy, int lane) {
    const LAS bf16_t* xp = X + (lane & 15) * ldx + 8 * (lane >> 4); const LAS bf16_t* yp = Y + (lane & 15) * ldy + 8 * (lane >> 4);
#pragma unroll
    for (int ks = 0; ks < KS; ++ks) { const bf16x8 a = *(const LAS bf16x8*)(xp + 32 * ks), b = *(const LAS bf16x8*)(yp + 32 * ks); acc = __builtin_amdgcn_mfma_f32_16x16x32_bf16(a, b, acc, 0, 0, 0); }
}
template <int KS> __device__ __forceinline__ void mma_nt_gx(f32x4& acc, const bf16_t* X, int ldx, const LAS bf16_t* Y, int ldy, int lane) {
    const bf16_t* xp = X + (size_t)(lane & 15) * ldx + 8 * (lane >> 4); const LAS bf16_t* yp = Y + (lane & 15) * ldy + 8 * (lane >> 4);
#pragma unroll
    for (int ks = 0; ks < KS; ++ks) { const bf16x8 a = *(const bf16x8*)(xp + 32 * ks), b = *(const LAS bf16x8*)(yp + 32 * ks); acc = __builtin_amdgcn_mfma_f32_16x16x32_bf16(a, b, acc, 0, 0, 0); }
}
__device__ __forceinline__ void st4bf(LAS bf16_t* p, const f32x4 v) { u32x2 w; w.x = pk2(v[0], v[1]); w.y = pk2(v[2], v[3]); *(LAS u32x2*)p = w; }

__device__ __forceinline__ void p0_transpose_item(const float* W, int N, bf16_t* WT, int ldo, int row_off, const float* sc, int mode, bool remap, LAS float* scr, int item, int lane) {
    const int nblk = N / 32, kb = item / nblk, nb = item % nblk, k0 = 64 * kb, n0 = 32 * nb;
#pragma unroll 8
    for (int i = 0; i < 32; ++i) { const int kk = 2 * i + (lane >> 5); float v = __builtin_nontemporal_load(W + (size_t)(k0 + kk) * N + n0 + (lane & 31));
        if (mode) { const float s = sc[k0 + kk]; v *= (mode == 1) ? s : (1.0f - s); }
        scr[kk * 33 + (lane & 31)] = v; }
    LDS_WAIT(); asm volatile("" ::: "memory");
    const int c = lane & 7;
#pragma unroll
    for (int j = 0; j < 4; ++j) { const int n = (lane >> 3) + 8 * j; const LAS float* s = scr + (8 * c) * 33 + n;
        u32x4 o; o.x = pk2(s[0 * 33], s[1 * 33]); o.y = pk2(s[2 * 33], s[3 * 33]); o.z = pk2(s[4 * 33], s[5 * 33]); o.w = pk2(s[6 * 33], s[7 * 33]);
        int orow = n0 + n; if (remap) { const int oc = orow >> 1; orow = 256 * (oc >> 7) + 128 * (orow & 1) + (oc & 127); }
        *(u32x4*)(WT + (size_t)(row_off + orow) * ldo + k0 + 8 * c) = o; }
    LDS_WAIT(); asm volatile("" ::: "memory");
}
__device__ __forceinline__ void p0_transpose_item_fp8(const float* W, int N, unsigned char* WT, int ldo, bool remap, LAS float* scr, int item, int lane) {
    const int nblk = N / 32, kb = item / nblk, nb = item % nblk, k0 = 64 * kb, n0 = 32 * nb;
    float tv[32];
#pragma unroll
    for (int i = 0; i < 32; ++i) tv[i] = __builtin_nontemporal_load(W + (size_t)(k0 + 2 * i + (lane >> 5)) * N + n0 + (lane & 31));
#pragma unroll
    for (int i = 0; i < 32; ++i) scr[(2 * i + (lane >> 5)) * 33 + (lane & 31)] = tv[i] * FP8_SW;
    LDS_WAIT(); asm volatile("" ::: "memory");
    const int c = lane & 3;
#pragma unroll
    for (int j = 0; j < 2; ++j) { const int n = (lane >> 2) + 16 * j; const LAS float* sp = scr + (16 * c) * 33 + n;
        u32x4 o; o.x = pk4_fp8(sp[0 * 33], sp[1 * 33], sp[2 * 33], sp[3 * 33]); o.y = pk4_fp8(sp[4 * 33], sp[5 * 33], sp[6 * 33], sp[7 * 33]);
        o.z = pk4_fp8(sp[8 * 33], sp[9 * 33], sp[10 * 33], sp[11 * 33]); o.w = pk4_fp8(sp[12 * 33], sp[13 * 33], sp[14 * 33], sp[15 * 33]);
        int orow = n0 + n; if (remap) { const int oc = orow >> 1; orow = 256 * (oc >> 7) + 128 * (orow & 1) + (oc & 127); }
        *(u32x4*)(WT + (size_t)orow * ldo + k0 + 16 * c) = o; }
    LDS_WAIT(); asm volatile("" ::: "memory");
}
__device__ __forceinline__ void moe_weight_phase(const Ctx& F) {
    LAS float* scr = (LAS float*)(F.lds + 4096 + F.wave * 16384);
    const int gw = F.vcu * 8 + F.wave, NGW = F.G * 8, lane = F.lane;
    unsigned char* ws = F.ws;
    constexpr int I_M1 = 16 * 64, I_M2 = 16 * 32;
    for (int it = gw; it < NEXP * (I_M1 + I_M2); it += NGW) {
        int r = it; const int e = r / (I_M1 + I_M2); r -= e * (I_M1 + I_M2);
        if (r < I_M1) p0_transpose_item_fp8(F.in[I_MW1] + (size_t)e * D * NHID, NHID, ws + WS_W1T + (size_t)e * NHID * D, D, true, scr, r, lane);
        else p0_transpose_item_fp8(F.in[I_MW2] + (size_t)e * DEXP * D, D, ws + WS_W2T + (size_t)e * D * DEXP, DEXP, false, scr, r - I_M1, lane);
    }
}
__device__ __forceinline__ void p0_prologue(const Ctx& F) {
    LAS float* scr = (LAS float*)(F.lds + F.wave * 16384);
    const int gw = F.vcu * 8 + F.wave, NGW = F.G * 8, lane = F.lane;
    unsigned char* ws = F.ws;
    bf16_t* WCAT = (bf16_t*)(ws + WS_WCAT);
    constexpr int I_WIN_N = 16 * 80, I_L64 = 16 * 2, I_L128 = 16 * 4, I_WO = 16 * 32, I_M1 = 16 * 64, I_M2 = 16 * 32, I_S64 = 1 * 16, I_S128 = 2 * 16;
    constexpr int N_SMALL = I_WIN_N + 4 * I_L64 + 2 * I_L128 + I_WO + 2 * I_S64 + I_S128;
    constexpr int NITEMS = N_SMALL;
    const float* mu_wag = F.in[I_MUWAG];
    for (int it = gw; it < NITEMS; it += NGW) {
        int r = it;
        if (r < I_WIN_N) { p0_transpose_item(F.in[I_WIN], 2560, WCAT, D, 0, nullptr, 0, false, scr, r, lane); continue; } r -= I_WIN_N;
        if (r < I_L64) { p0_transpose_item(F.in[I_W1], 64, WCAT, D, COL_LA + 0, mu_wag + 0 * D, 2, false, scr, r, lane); continue; } r -= I_L64;
        if (r < I_L64) { p0_transpose_item(F.in[I_W1], 64, WCAT, D, COL_LB + 0, mu_wag + 0 * D, 1, false, scr, r, lane); continue; } r -= I_L64;
        if (r < I_L64) { p0_transpose_item(F.in[I_A1], 64, WCAT, D, COL_LA + 64, mu_wag + 1 * D, 2, false, scr, r, lane); continue; } r -= I_L64;
        if (r < I_L64) { p0_transpose_item(F.in[I_A1], 64, WCAT, D, COL_LB + 64, mu_wag + 1 * D, 1, false, scr, r, lane); continue; } r -= I_L64;
        if (r < I_L128) { p0_transpose_item(F.in[I_G1], 128, WCAT, D, COL_LA + 128, mu_wag + 2 * D, 2, false, scr, r, lane); continue; } r -= I_L128;
        if (r < I_L128) { p0_transpose_item(F.in[I_G1], 128, WCAT, D, COL_LB + 128, mu_wag + 2 * D, 1, false, scr, r, lane); continue; } r -= I_L128;
        if (r < I_WO) { p0_transpose_item(F.in[I_WOUT], D, (bf16_t*)(ws + WS_WOUT), D, 0, nullptr, 0, false, scr, r, lane); continue; } r -= I_WO;
        if (r < I_S64) { p0_transpose_item(F.in[I_W2], 512, (bf16_t*)(ws + WS_LW2), 64, 0, nullptr, 0, false, scr, r, lane); continue; } r -= I_S64;
        if (r < I_S64) { p0_transpose_item(F.in[I_A2], 512, (bf16_t*)(ws + WS_LA2), 64, 0, nullptr, 0, false, scr, r, lane); continue; } r -= I_S64;
        p0_transpose_item(F.in[I_G2], 512, (bf16_t*)(ws + WS_LG2), 128, 0, nullptr, 0, false, scr, r, lane);
    }
    const int gt = F.vcu * 512 + F.tid, NGT = F.G * 512;
    { bf16_t* SW = (bf16_t*)(ws + WS_SGUW); const float* w = F.in[I_SGUW];
      for (int i = gt; i < 8 * 128 * 128; i += NGT) { const int qi = (i >> 7) & 127, kj = i & 127; SW[i] = (bf16_t)(((kj >> 6) <= (qi >> 6)) ? f2bf(w[i]) : 0u); } }
    { float* RW = (float*)(ws + WS_RW); const float* w = F.in[I_RW]; const float* g = F.in[I_N2G];
      for (int i = gt; i < D * NEXP; i += NGT) RW[i] = w[i] * g[i >> 5]; }
    { int* rt = (int*)(ws + WS_ROWTOK); float* rg = (float*)(ws + WS_ROWGATE);
      for (int i = gt; i < MAXROWS; i += NGT) { rt[i] = 0; rg[i] = 0.f; } }
    { const float* g1 = F.in[I_N1G]; f32x4 gv[4];
#pragma unroll
      for (int j = 0; j < 4; ++j) gv[j] = *((const f32x4*)g1 + lane + 64 * j);
      for (int m = gw; m < M; m += NGW) {
          const f32x4* xr = (const f32x4*)(F.in[I_X] + (size_t)m * D) + lane; f32x4 v[4]; float s = 0.f;
#pragma unroll
          for (int j = 0; j < 4; ++j) { v[j] = __builtin_nontemporal_load(xr + 64 * j); s += (v[j].x * v[j].x + v[j].y * v[j].y) + (v[j].z * v[j].z + v[j].w * v[j].w); }
          const float rstd = __builtin_amdgcn_rsqf(wave_sum(s) * (1.0f / D) + 1e-5f);
          u32x2* o8 = (u32x2*)((bf16_t*)(ws + WS_XN) + (size_t)m * D) + lane;
#pragma unroll
          for (int j = 0; j < 4; ++j) { u32x2 w; w.x = pk2(v[j].x * rstd * gv[j].x, v[j].y * rstd * gv[j].y); w.y = pk2(v[j].z * rstd * gv[j].z, v[j].w * rstd * gv[j].w); o8[64 * j] = w; }
      } }
}

#define LB() do { asm volatile("s_waitcnt lgkmcnt(0)" ::: "memory"); __builtin_amdgcn_s_barrier(); asm volatile("" ::: "memory"); } while (0)
typedef short v4i16_t __attribute__((ext_vector_type(4)));
__device__ __forceinline__ bf16x8 tr_frag(const LAS bf16_t* base, int ld, int lane) {
    const LAS bf16_t* a = base + (8 * (lane >> 4) + ((lane & 15) >> 2)) * ld + 4 * (lane & 3);
    const v4i16_t lo = __builtin_amdgcn_ds_read_tr16_b64_v4i16((LAS v4i16_t*)a), hi = __builtin_amdgcn_ds_read_tr16_b64_v4i16((LAS v4i16_t*)(a + 4 * ld));
    return __builtin_shufflevector(lo, hi, 0, 1, 2, 3, 4, 5, 6, 7);
}
template <int KS> __device__ __forceinline__ void mma_tx(f32x4& acc, const LAS bf16_t* XR, int ldx, const LAS bf16_t* Y, int ldy, int lane) {
    const LAS bf16_t* yp = Y + (lane & 15) * ldy + 8 * (lane >> 4);
#pragma unroll
    for (int ks = 0; ks < KS; ++ks) { const bf16x8 a = tr_frag(XR + 32 * ks * ldx, ldx, lane), b = *(const LAS bf16x8*)(yp + 32 * ks); acc = __builtin_amdgcn_mfma_f32_16x16x32_bf16(a, b, acc, 0, 0, 0); }
}
template <int KS> __device__ __forceinline__ void mma_ty(f32x4& acc, const LAS bf16_t* X, int ldx, const LAS bf16_t* YR, int ldy, int lane) {
    const LAS bf16_t* xp = X + (lane & 15) * ldx + 8 * (lane >> 4);
#pragma unroll
    for (int ks = 0; ks < KS; ++ks) { const bf16x8 a = *(const LAS bf16x8*)(xp + 32 * ks), b = tr_frag(YR + 32 * ks * ldy, ldy, lane); acc = __builtin_amdgcn_mfma_f32_16x16x32_bf16(a, b, acc, 0, 0, 0); }
}
template <int KS> __device__ __forceinline__ void mma_rx(f32x4& acc, const bf16x8 (&xf)[KS], const LAS bf16_t* Y, int ldy, int lane) {
    const LAS bf16_t* yp = Y + (lane & 15) * ldy + 8 * (lane >> 4);
#pragma unroll
    for (int ks = 0; ks < KS; ++ks) { const bf16x8 b = *(const LAS bf16x8*)(yp + 32 * ks); acc = __builtin_amdgcn_mfma_f32_16x16x32_bf16(xf[ks], b, acc, 0, 0, 0); }
}

__device__ __forceinline__ void sgu_phase(const Ctx& F) {
    const int w = F.wave;
    const bf16_t* PROJ = (const bf16_t*)(F.ws + WS_PROJ); bf16_t* YCAT = (bf16_t*)(F.ws + WS_YCAT); const bf16_t* SW = (const bf16_t*)(F.ws + WS_SGUW);
    LAS bf16_t* vn = (LAS bf16_t*)F.lds;
    constexpr int LDV = 264;
    for (int unit = F.vcu; unit < 256; unit += F.G) {
        int tv_ = F.tid; asm volatile("" : "+v"(tv_)); const int lane = tv_ & 63;
        const int nb = unit >> 1, hh = unit & 1, m0 = nb * 128;
        float lg[8], lb[8];
#pragma unroll
        for (int q = 0; q < 8; ++q) { lg[q] = F.in[I_SLNG][lane * 8 + q]; lb[q] = F.in[I_SLNB][lane * 8 + q]; }
        const int hl = w >> 1, ih = w & 1, h = hh * 4 + hl;
        u32x4 raw[16];
#pragma unroll
        for (int rr = 0; rr < 16; ++rr) raw[rr] = *(const u32x4*)(PROJ + (size_t)(m0 + w * 16 + rr) * NPROJ + COL_V + lane * 8);
        bf16x8 bfr[4][4]; u32x2 ur[4][4]; float bsv[4];
#pragma unroll
        for (int ks = 0; ks < 4; ++ks)
#pragma unroll
            for (int it = 0; it < 4; ++it) bfr[ks][it] = *(const bf16x8*)(SW + (size_t)h * 16384 + (ih * 64 + it * 16 + (lane & 15)) * 128 + ks * 32 + 8 * (lane >> 4));
#pragma unroll
        for (int it = 0; it < 4; ++it) { const int i = ih * 64 + it * 16 + (lane & 15); bsv[it] = F.in[I_SGUB][h * 128 + i];
#pragma unroll
            for (int ct = 0; ct < 4; ++ct) ur[it][ct] = *(const u32x2*)(PROJ + (size_t)(m0 + i) * NPROJ + h * 64 + ct * 16 + 4 * (lane >> 4)); }
#pragma unroll
        for (int rr = 0; rr < 16; ++rr) {
            const int pos = w * 16 + rr; float v[8]; unpack8(raw[rr], v);
            float s = 0.f;
#pragma unroll
            for (int q = 0; q < 8; ++q) s += v[q];
            const float mean = wave_sum(s) * (1.0f / 512.0f); float qq = 0.f;
#pragma unroll
            for (int q = 0; q < 8; ++q) { v[q] -= mean; qq += v[q] * v[q]; }
            const float rstd = __builtin_amdgcn_rsqf(wave_sum(qq) * (1.0f / 512.0f) + 1e-5f);
            if ((lane >> 5) == hh) { float o[8];
#pragma unroll
                for (int q = 0; q < 8; ++q) o[q] = v[q] * rstd * lg[q] + lb[q];
                *(LAS u32x4*)(vn + pos * LDV + (lane & 31) * 8) = pack8(o); }
        }
        LB();
        f32x4 acc[4][4];
#pragma unroll
        for (int a = 0; a < 4; ++a)
#pragma unroll
            for (int b = 0; b < 4; ++b) acc[a][b] = (f32x4){0.f, 0.f, 0.f, 0.f};
#pragma unroll
        for (int ks = 0; ks < 4; ++ks) {
            bf16x8 af[4];
#pragma unroll
            for (int ct = 0; ct < 4; ++ct) af[ct] = tr_frag(vn + (32 * ks) * LDV + hl * 64 + ct * 16, LDV, lane);
#pragma unroll
            for (int ct = 0; ct < 4; ++ct)
#pragma unroll
                for (int it = 0; it < 4; ++it) acc[ct][it] = __builtin_amdgcn_mfma_f32_16x16x32_bf16(af[ct], bfr[ks][it], acc[ct][it], 0, 0, 0);
        }
#pragma unroll
        for (int it = 0; it < 4; ++it) { const int i = ih * 64 + it * 16 + (lane & 15); const float bs = bsv[it]; const size_t row = (size_t)(m0 + i);
#pragma unroll
            for (int ct = 0; ct < 4; ++ct) { const int c = h * 64 + ct * 16 + 4 * (lane >> 4); const u32x2 uu = ur[it][ct];
                const f32x4 a = acc[ct][it]; u32x2 o; o.x = pk2(bflo(uu.x) * (a[0] + bs), bfhi(uu.x) * (a[1] + bs)); o.y = pk2(bflo(uu.y) * (a[2] + bs), bfhi(uu.y) * (a[3] + bs));
                *(u32x2*)(YCAT + row * D + c) = o; } }
        LB();
    }
}

namespace rk {
constexpr int LD = 72, LDF = 68, LDG = 136, MBY = 64 * LD * 2;
constexpr int O_AT = 0, O_RT = MBY, O_BH = 2 * MBY, O_KH = 3 * MBY, O_V = 4 * MBY, O_TB = 5 * MBY, O_LAK = 6 * MBY, O_MRB = 7 * MBY, O_MRK = 8 * MBY,
              O_ST = 9 * MBY, O_XT = 11 * MBY, O_UT = 13 * MBY, O_WC = 15 * MBY, O_WT = O_WC + 512, O_PAR = O_WT + 2048, O_END = O_PAR + 2560;
static_assert(O_END <= MISC_OFF, "RWKV LDS map");
enum { P_MUR = 0, P_MUK, P_MUV, P_W0, P_A0, P_KK, P_KA, P_RK, P_LG, P_LB };
constexpr size_t CHB = 6 * 4096;
template <int KS> __device__ __forceinline__ void mma_txy(f32x4& acc, const LAS bf16_t* XR, int ldx, const LAS bf16_t* YR, int ldy, int lane) {
#pragma unroll
    for (int ks = 0; ks < KS; ++ks) { const bf16x8 a = tr_frag(XR + 32 * ks * ldx, ldx, lane), b = tr_frag(YR + 32 * ks * ldy, ldy, lane); acc = __builtin_amdgcn_mfma_f32_16x16x32_bf16(a, b, acc, 0, 0, 0); }
}
__device__ __forceinline__ void state_yfrags(const f32x4 (&acc)[4], bf16x8 (&yf)[2]) {
#pragma unroll
    for (int ks = 0; ks < 2; ++ks) { u32x4 wv; wv.x = pk2(acc[2 * ks][0], acc[2 * ks][1]); wv.y = pk2(acc[2 * ks][2], acc[2 * ks][3]); wv.z = pk2(acc[2 * ks + 1][0], acc[2 * ks + 1][1]); wv.w = pk2(acc[2 * ks + 1][2], acc[2 * ks + 1][3]);
        yf[ks] = __builtin_bit_cast(bf16x8, wv); }
}
__device__ __forceinline__ void load_xfrags(u32x2 (&xr)[4][2][2], const bf16_t* mt, int ldm, int lane) {
#pragma unroll
    for (int ct = 0; ct < 4; ++ct)
#pragma unroll
        for (int ks = 0; ks < 2; ++ks)
#pragma unroll
            for (int hf = 0; hf < 2; ++hf) xr[ct][ks][hf] = *(const u32x2*)(mt + (size_t)(16 * ct + (lane & 15)) * ldm + 32 * ks + 16 * hf + 4 * (lane >> 4));
}
__device__ __forceinline__ void load_xfrags_lds(u32x2 (&xr)[4][2][2], const LAS bf16_t* mt, int ldm, int lane) {
#pragma unroll
    for (int ct = 0; ct < 4; ++ct)
#pragma unroll
        for (int ks = 0; ks < 2; ++ks)
#pragma unroll
            for (int hf = 0; hf < 2; ++hf) xr[ct][ks][hf] = *(const LAS u32x2*)(mt + (16 * ct + (lane & 15)) * ldm + 32 * ks + 16 * hf + 4 * (lane >> 4));
}
__device__ __forceinline__ void state_step(f32x4 (&acc)[4], const u32x2 (&xr)[4][2][2]) {
    bf16x8 yf[2]; state_yfrags(acc, yf);
#pragma unroll
    for (int ct = 0; ct < 4; ++ct) { f32x4 d = (f32x4){0.f, 0.f, 0.f, 0.f};
#pragma unroll
        for (int ks = 0; ks < 2; ++ks) { u32x4 xw; xw.x = xr[ct][ks][0].x; xw.y = xr[ct][ks][0].y; xw.z = xr[ct][ks][1].x; xw.w = xr[ct][ks][1].y;
            d = __builtin_amdgcn_mfma_f32_16x16x32_bf16(__builtin_bit_cast(bf16x8, xw), yf[ks], d, 0, 0, 0); }
        acc[ct] = d; }
}
__device__ __forceinline__ f32x4 bf4(const u32x2 w) { return (f32x4){bflo(w.x), bfhi(w.x), bflo(w.y), bfhi(w.y)}; }
__device__ __forceinline__ int frag_off(int row, int col) { return (((row >> 4) * 64 + ((col >> 2) & 3) * 16 + (row & 15)) * 4 + (col >> 4)) * 4 + (col & 3); }
}

__device__ __forceinline__ void rwkv_prep_unit(const Ctx& F, int unit) {
    using namespace rk;
    const int w = F.wave;
    const int b = unit >> 7, h = (unit >> 4) & 7, seg = unit & 15;
    constexpr int NL = 4;
    LAS unsigned char* L = F.lds;
    LAS bf16_t *AT = (LAS bf16_t*)(L + O_AT), *RT = (LAS bf16_t*)(L + O_RT), *BH = (LAS bf16_t*)(L + O_BH), *KH = (LAS bf16_t*)(L + O_KH), *V = (LAS bf16_t*)(L + O_V), *TB = (LAS bf16_t*)(L + O_TB),
                *LAK = (LAS bf16_t*)(L + O_LAK), *MRB = (LAS bf16_t*)(L + O_MRB), *MRK = (LAS bf16_t*)(L + O_MRK), *ST = (LAS bf16_t*)(L + O_ST), *XT = (LAS bf16_t*)(L + O_XT), *UT = (LAS bf16_t*)(L + O_UT);
    LAS bf16_t *DECP = ST, *ICLP = ST + 64 * LD, *LW = XT, *LA = XT + 64 * LD, *BT = XT, *KT = XT + 64 * LD, *LG = UT, *AH = ST, *XL = ST + 64 * LD, *UL = XT, *PHL = UT, *PSL = UT + 64 * LD;
    LAS float *LF = (LAS float*)(L + O_ST), *TF = (LAS float*)(L + O_XT), *TMP = (LAS float*)(L + O_UT), *WC = (LAS float*)(L + O_WC), *WT = (LAS float*)(L + O_WT), *PAR = (LAS float*)(L + O_PAR);
    const bf16_t* PROJ = (const bf16_t*)(F.ws + WS_PROJ);
    bf16_t* SEGP = (bf16_t*)(F.ws + WS_SEGP); float* SEGQ = (float*)(F.ws + WS_SEGQ);
    bf16_t *PHIT = (bf16_t*)(F.ws + WS_PHIT), *PSI = (bf16_t*)(F.ws + WS_PSI), *YSG = (bf16_t*)(F.ws + WS_YS), *YLG = (bf16_t*)(F.ws + WS_YL), *GTG = (bf16_t*)(F.ws + WS_GT), *BVG = (bf16_t*)(F.ws + WS_BV);

    { int tid = F.tid; asm volatile("" : "+v"(tid));
      for (int i = tid; i < 640; i += 512) { const int pv = i >> 6, cc = h * 64 + (i & 63); const float* src;
          switch (pv) { case P_MUR: src = F.in[I_MURKV] + 0 * 512; break; case P_MUK: src = F.in[I_MURKV] + 1 * 512; break; case P_MUV: src = F.in[I_MURKV] + 2 * 512; break; case P_W0: src = F.in[I_W0]; break;
                        case P_A0: src = F.in[I_A0]; break; case P_KK: src = F.in[I_KK]; break; case P_KA: src = F.in[I_KA]; break; case P_RK: src = F.in[I_RK]; break; case P_LG: src = F.in[I_LNXG]; break; default: src = F.in[I_LNXB]; break; }
          PAR[i] = src[cc]; }
    }
    const bf16_t* LW2 = (const bf16_t*)(F.ws + WS_LW2); const bf16_t* LA2 = (const bf16_t*)(F.ws + WS_LA2); const bf16_t* LG2 = (const bf16_t*)(F.ws + WS_LG2);

    f32x4 acc[4];
#pragma unroll
    for (int ct = 0; ct < 4; ++ct) acc[ct] = (f32x4){0.f, 0.f, 0.f, 0.f};
    if (w < 4) { int tv0_ = F.tid; asm volatile("" : "+v"(tv0_)); const int lane = tv0_ & 63;
#pragma unroll
        for (int ct = 0; ct < 4; ++ct)
#pragma unroll
            for (int r = 0; r < 4; ++r) acc[ct][r] = (16 * ct + 4 * (lane >> 4) + r == 16 * w + (lane & 15)) ? 1.0f : 0.0f; }
    LB();

    u32x4 rw_c[3 + NL], rw_p[3 + NL];
    auto load_raw = [&](int c, int tv) {
        const int t = tv >> 3, c0 = (tv & 7) * 8, hc = h * 64 + c0; const int tq0 = (seg * SEGC + c) * CH;
        const bf16_t* rowc = PROJ + ((size_t)b * SEQ + tq0 + t) * NPROJ; const bool hasp = (tq0 + t) > 0; const bf16_t* rowp = hasp ? rowc - NPROJ : rowc;
        rw_c[0] = *(const u32x4*)(rowc + COL_R + hc); rw_c[1] = *(const u32x4*)(rowc + COL_K + hc); rw_c[2] = *(const u32x4*)(rowc + COL_VR + hc);
        rw_p[0] = *(const u32x4*)(rowp + COL_R + hc); rw_p[1] = *(const u32x4*)(rowp + COL_K + hc); rw_p[2] = *(const u32x4*)(rowp + COL_VR + hc);
#pragma unroll
        for (int q4 = 0; q4 < NL; ++q4) { rw_c[3 + q4] = *(const u32x4*)(rowc + COL_LA + q4 * 64 + c0); rw_p[3 + q4] = *(const u32x4*)(rowp + COL_LB + q4 * 64 + c0); }
    };
    bf16x8 fW[2], fA[2], fG[4];
    { int tvw_ = F.tid; asm volatile("" : "+v"(tvw_)); const int g_ = (tvw_ & 63) >> 4, ln_ = tvw_ & 15; const size_t row = (size_t)(h * 64 + (w & 3) * 16 + ln_);
#pragma unroll
      for (int ks = 0; ks < 2; ++ks) { fW[ks] = *(const bf16x8*)(LW2 + row * 64 + 32 * ks + 8 * g_); fA[ks] = *(const bf16x8*)(LA2 + row * 64 + 32 * ks + 8 * g_); }
#pragma unroll
      for (int ks = 0; ks < 4; ++ks) fG[ks] = *(const bf16x8*)(LG2 + row * 128 + 32 * ks + 8 * g_); }
    { int tv0_ = F.tid; asm volatile("" : "+v"(tv0_)); load_raw(0, tv0_); }

    for (int c = 0; c < SEGC; ++c) {
        int tv_ = F.tid; asm volatile("" : "+v"(tv_));
        const int lane = tv_ & 63, t = tv_ >> 3, cg = tv_ & 7, c0 = cg * 8, g = lane >> 4, ln = lane & 15;
        const size_t cu = (size_t)((b * 8 + h) * NCHUNK + seg * SEGC + c) * CHB;
        float r_[8], k_[8], v_[8], a_[8], b_[8], ld_[8], pf_[8];
        {
            float cv[8], pv[8];
            { const unsigned km = ((seg * SEGC + c) * CH + t) > 0 ? 0xffffffffu : 0u;
#pragma unroll
              for (int i = 0; i < 3 + NL; ++i) { rw_p[i].x &= km; rw_p[i].y &= km; rw_p[i].z &= km; rw_p[i].w &= km; } }
            unpack8(rw_c[0], cv); unpack8(rw_p[0], pv);
#pragma unroll
            for (int q = 0; q < 8; ++q) r_[q] = cv[q] + (pv[q] - cv[q]) * PAR[P_MUR * 64 + c0 + q];
            unpack8(rw_c[1], cv); unpack8(rw_p[1], pv);
#pragma unroll
            for (int q = 0; q < 8; ++q) k_[q] = cv[q] + (pv[q] - cv[q]) * PAR[P_MUK * 64 + c0 + q];
            unpack8(rw_c[2], cv); unpack8(rw_p[2], pv);
#pragma unroll
            for (int q = 0; q < 8; ++q) v_[q] = cv[q] + (pv[q] - cv[q]) * PAR[P_MUV * 64 + c0 + q];
#pragma unroll
            for (int q4 = 0; q4 < NL; ++q4) { float o[8];
                unpack8(rw_c[3 + q4], cv); unpack8(rw_p[3 + q4], pv);
#pragma unroll
                for (int q = 0; q < 8; ++q) { const float x = cv[q] + pv[q]; o[q] = (q4 == 0) ? (1.0f - 2.0f * __builtin_amdgcn_rcpf(1.0f + __expf(2.0f * x))) : (q4 == 1 ? x : fsigmoid(x)); }
                LAS bf16_t* dst = (q4 == 0) ? (LW + t * LD + c0) : (q4 == 1) ? (LA + t * LD + c0) : (LG + t * LDG + (q4 - 2) * 64 + c0);
                *(LAS u32x4*)dst = pack8(o);
            }
        }
        LB();
        {
            const int ct = w & 3, tp = (w >> 2) * 2;
#pragma unroll
            for (int j = 0; j < 2; ++j) { const int tt = tp + j; const int so = (tt * 16 + ln) * LD + ct * 16 + 4 * g;
                f32x4 d = (f32x4){0.f, 0.f, 0.f, 0.f}; mma_rx<2>(d, fW, LW + tt * 16 * LD, LD, lane); st4bf(DECP + so, d);
                d = (f32x4){0.f, 0.f, 0.f, 0.f}; mma_rx<2>(d, fA, LA + tt * 16 * LD, LD, lane); st4bf(ICLP + so, d);
                d = (f32x4){0.f, 0.f, 0.f, 0.f}; mma_rx<4>(d, fG, LG + tt * 16 * LDG, LDG, lane);
                u32x2 gw; gw.x = pk2(d[0], d[1]); gw.y = pk2(d[2], d[3]); *(u32x2*)(GTG + cu + frag_off(tt * 16 + ln, ct * 16 + 4 * g)) = gw; }
        }
        LB();
        {
            float dp[8], ip[8]; unpack8(*(const LAS u32x4*)(DECP + t * LD + c0), dp); unpack8(*(const LAS u32x4*)(ICLP + t * LD + c0), ip);
            float kk[8], ss = 0.f, bonus = 0.f;
#pragma unroll
            for (int q = 0; q < 8; ++q) {
                const float xw = dp[q] + PAR[P_W0 * 64 + c0 + q]; const float z = -xw;
                const float sp = fmaxf(z, 0.f) + __logf(1.0f + __expf(-fabsf(z)));
                const float wl = -sp - 0.5f; ld_[q] = -__expf(wl);
                ip[q] = fsigmoid(ip[q] + PAR[P_A0 * 64 + c0 + q]);
                kk[q] = k_[q] * PAR[P_KK * 64 + c0 + q]; ss += kk[q] * kk[q];
            }
            ss += __shfl_xor(ss, 1); ss += __shfl_xor(ss, 2); ss += __shfl_xor(ss, 4);
            const float inv = __builtin_amdgcn_rsqf(fmaxf(ss, 1e-24f));
#pragma unroll
            for (int q = 0; q < 8; ++q) { kk[q] *= inv; k_[q] = k_[q] * (1.0f + (ip[q] - 1.0f) * PAR[P_KA * 64 + c0 + q]); a_[q] = -kk[q]; b_[q] = kk[q] * ip[q];
                bonus += r_[q] * k_[q] * PAR[P_RK * 64 + c0 + q]; }
            bonus += __shfl_xor(bonus, 1); bonus += __shfl_xor(bonus, 2); bonus += __shfl_xor(bonus, 4);
            { float o[8];
#pragma unroll
              for (int q = 0; q < 8; ++q) o[q] = bonus * v_[q];
              const u32x4 pw = pack8(o); u32x2 lo_, hi_; lo_.x = pw.x; lo_.y = pw.y; hi_.x = pw.z; hi_.y = pw.w;
              *(u32x2*)(BVG + cu + frag_off(t, c0)) = lo_; *(u32x2*)(BVG + cu + frag_off(t, c0 + 4)) = hi_; }
#pragma unroll
            for (int q = 0; q < 8; ++q) { float x = ld_[q];
#pragma unroll
                for (int dsh = 8; dsh < 64; dsh <<= 1) { const float y = __shfl_up(x, dsh); x += (lane >= dsh) ? y : 0.f; }
                pf_[q] = x; }
            if ((lane >> 3) == 7) { *(LAS f32x4*)(WT + w * 64 + c0) = (f32x4){pf_[0], pf_[1], pf_[2], pf_[3]}; *(LAS f32x4*)(WT + w * 64 + c0 + 4) = (f32x4){pf_[4], pf_[5], pf_[6], pf_[7]}; }
        }
        LB();
        REP(16) {
        {
            float off[8], tot[8];
#pragma unroll
            for (int q = 0; q < 8; ++q) { off[q] = 0.f; tot[q] = 0.f; }
#pragma unroll
            for (int ww = 0; ww < 8; ++ww) { const f32x4 x0 = *(const LAS f32x4*)(WT + ww * 64 + c0), x1 = *(const LAS f32x4*)(WT + ww * 64 + c0 + 4); const float m = (ww < w) ? 1.0f : 0.0f;
#pragma unroll
                for (int q = 0; q < 4; ++q) { tot[q] += x0[q]; tot[q + 4] += x1[q]; off[q] += m * x0[q]; off[q + 4] += m * x1[q]; } }
            float o1[8], o2[8], o3[8], o4[8], o5[8], o6[8];
#pragma unroll
            for (int q = 0; q < 8; ++q) { const float cu_ = pf_[q] + off[q]; const float ec = __expf(cu_), en = __builtin_amdgcn_rcpf(ec), wc = __expf(tot[q]), er = wc * en;
                o1[q] = a_[q] * __expf(cu_ - ld_[q]); o2[q] = r_[q] * ec; o3[q] = b_[q] * en; o4[q] = k_[q] * en; o5[q] = b_[q] * er; o6[q] = k_[q] * er;
                if (t == 63) WC[c0 + q] = wc; }
            *(LAS u32x4*)(AT + t * LD + c0) = pack8(o1); *(LAS u32x4*)(RT + t * LD + c0) = pack8(o2); *(LAS u32x4*)(BT + t * LD + c0) = pack8(o3); *(LAS u32x4*)(KT + t * LD + c0) = pack8(o4);
            *(LAS u32x4*)(BH + t * LD + c0) = pack8(o5); *(LAS u32x4*)(KH + t * LD + c0) = pack8(o6); *(LAS u32x4*)(V + t * LD + c0) = pack8(v_);
        }
        LB();
        {
            const int tt = w & 3, ip0 = (w >> 2) * 2;
#pragma unroll
            for (int j = 0; j < 2; ++j) { const int it = ip0 + j; const int i0 = it * 16 + 4 * g, tq = tt * 16 + ln;
                f32x4 d0 = (f32x4){0.f, 0.f, 0.f, 0.f}, d1 = d0, d2 = d0, d3 = d0;
                if (it <= tt) {
                    mma_nt<2>(d0, BT + it * 16 * LD, LD, AT + tt * 16 * LD, LD, lane); mma_nt<2>(d1, KT + it * 16 * LD, LD, AT + tt * 16 * LD, LD, lane);
                    mma_nt<2>(d2, BT + it * 16 * LD, LD, RT + tt * 16 * LD, LD, lane); mma_nt<2>(d3, KT + it * 16 * LD, LD, RT + tt * 16 * LD, LD, lane);
                    if (it == tt) {
#pragma unroll
                        for (int r = 0; r < 4; ++r) { const int i = i0 + r; if (!(i < tq)) { d0[r] = 0.f; d1[r] = 0.f; } if (!(i <= tq)) { d2[r] = 0.f; d3[r] = 0.f; } } }
                }
                *(LAS f32x4*)(LF + tq * LDF + i0) = d0; st4bf(LAK + tq * LD + i0, d1); st4bf(MRB + tq * LD + i0, d2); st4bf(MRK + tq * LD + i0, d3); }
        }
        LB();
        }
        load_raw(c + 1 < SEGC ? c + 1 : c, tv_);
        REP(14) {
        if (w == 0) { const int bk = lane >> 4, j = lane & 15; float x[16];
            const LAS float* Lb = LF + (16 * bk) * LDF + 16 * bk; LAS float* Tb = TF + (16 * bk) * LDF + 16 * bk + j;
            f32x4 ra[4], rb[4];
#pragma unroll
            for (int q = 0; q < 4; ++q) ra[q] = *(const LAS f32x4*)(Lb + 1 * LDF + 4 * q);
            x[0] = (j == 0) ? 1.0f : 0.0f; Tb[0] = x[0];
#pragma unroll
            for (int tr = 1; tr < 16; ++tr) {
                f32x4 (&cur)[4] = (tr & 1) ? ra : rb; f32x4 (&nxt)[4] = (tr & 1) ? rb : ra;
                if (tr < 15) {
#pragma unroll
                    for (int q = 0; q < 4; ++q) nxt[q] = *(const LAS f32x4*)(Lb + (tr + 1) * LDF + 4 * q); }
                float s0 = (tr == j) ? 1.0f : 0.0f, s1 = 0.f;
#pragma unroll
                for (int i = 0; i < tr; ++i) { if (i & 1) s1 += cur[i >> 2][i & 3] * x[i]; else s0 += cur[i >> 2][i & 3] * x[i]; }
                x[tr] = s0 + s1; Tb[tr * LDF] = x[tr]; } }
        LB();
        if (w < 2) { const int p = w, lr = lane & 15, lk = lane >> 4; f32x4 d = (f32x4){0.f, 0.f, 0.f, 0.f};
#pragma unroll
            for (int ks = 0; ks < 4; ++ks) d = __builtin_amdgcn_mfma_f32_16x16x4f32(LF[(32 * p + 16 + lr) * LDF + 32 * p + 4 * ks + lk], TF[(32 * p + 4 * ks + lk) * LDF + 32 * p + lr], d, 0, 0, 0);
#pragma unroll
            for (int r = 0; r < 4; ++r) TMP[(32 * p + 16 + 4 * lk + r) * LDF + 32 * p + lr] = d[r];
            LDS_WAIT(); f32x4 e = (f32x4){0.f, 0.f, 0.f, 0.f};
#pragma unroll
            for (int ks = 0; ks < 4; ++ks) e = __builtin_amdgcn_mfma_f32_16x16x4f32(TF[(32 * p + 16 + lr) * LDF + 32 * p + 16 + 4 * ks + lk], TMP[(32 * p + 16 + 4 * ks + lk) * LDF + 32 * p + lr], e, 0, 0, 0);
#pragma unroll
            for (int r = 0; r < 4; ++r) TF[(32 * p + 16 + 4 * lk + r) * LDF + 32 * p + lr] = e[r]; }
        LB();
        if (w < 4) { const int ri = w >> 1, cj = w & 1, lr = lane & 15, lk = lane >> 4; f32x4 d = (f32x4){0.f, 0.f, 0.f, 0.f};
#pragma unroll
            for (int ks = 0; ks < 8; ++ks) { const int k = 4 * ks + lk; const float bb = ((k >> 4) >= cj) ? TF[k * LDF + 16 * cj + lr] : 0.0f;
                d = __builtin_amdgcn_mfma_f32_16x16x4f32(LF[(32 + 16 * ri + lr) * LDF + k], bb, d, 0, 0, 0); }
#pragma unroll
            for (int r = 0; r < 4; ++r) TMP[(32 + 16 * ri + 4 * lk + r) * LDF + 16 * cj + lr] = d[r]; }
        LB();
        if (w < 4) { const int ri = w >> 1, cj = w & 1, lr = lane & 15, lk = lane >> 4; f32x4 d = (f32x4){0.f, 0.f, 0.f, 0.f};
#pragma unroll
            for (int ks = 0; ks < 8; ++ks) { const int k = 4 * ks + lk; const float aa = (ri >= (k >> 4)) ? TF[(32 + 16 * ri + lr) * LDF + 32 + k] : 0.0f;
                d = __builtin_amdgcn_mfma_f32_16x16x4f32(aa, TMP[(32 + k) * LDF + 16 * cj + lr], d, 0, 0, 0); }
#pragma unroll
            for (int r = 0; r < 4; ++r) TF[(32 + 16 * ri + 4 * lk + r) * LDF + 16 * cj + lr] = d[r]; }
        LB();
        { float o[8];
#pragma unroll
          for (int q = 0; q < 8; ++q) { const int i = c0 + q; o[q] = ((i >> 4) <= (t >> 4)) ? TF[t * LDF + i] : 0.0f; }
          *(LAS u32x4*)(TB + t * LD + c0) = pack8(o); }
        LB();
        }
        const int tt = w & 3, pr = (w >> 2) * 2;
        REP(15) {
#pragma unroll
        for (int j = 0; j < 2; ++j) { const int mt = pr + j; const int so = (tt * 16 + ln) * LD + mt * 16 + 4 * g;
            f32x4 d = (f32x4){0.f, 0.f, 0.f, 0.f}; mma_tx<2>(d, AT + 16 * mt, LD, TB + tt * 16 * LD, LD, lane); st4bf(AH + so, d);
            d = (f32x4){0.f, 0.f, 0.f, 0.f}; mma_tx<2>(d, V + 16 * mt, LD, LAK + tt * 16 * LD, LD, lane); st4bf(XL + so, d); }
        LB();
#pragma unroll
        for (int j = 0; j < 2; ++j) { const int mt = pr + j; const int so = (tt * 16 + ln) * LD + mt * 16 + 4 * g;
            f32x4 d = (f32x4){0.f, 0.f, 0.f, 0.f}; mma_tx<2>(d, XL + 16 * mt, LD, TB + tt * 16 * LD, LD, lane); st4bf(UL + so, d);
            d = bf4(*(const LAS u32x2*)(RT + so)); mma_tx<2>(d, AH + 16 * mt, LD, MRB + tt * 16 * LD, LD, lane);
            { u32x2 o; o.x = pk2(d[0], d[1]); o.y = pk2(d[2], d[3]); *(u32x2*)(YSG + cu + frag_off(tt * 16 + ln, mt * 16 + 4 * g)) = o; }
            d = (f32x4){0.f, 0.f, 0.f, 0.f}; mma_txy<2>(d, AH + 16 * mt, LD, BH + 16 * tt, LD, lane);
            { const f32x4 wc4 = *(const LAS f32x4*)(WC + mt * 16 + 4 * g);
#pragma unroll
              for (int r = 0; r < 4; ++r) d[r] += (mt * 16 + 4 * g + r == tt * 16 + ln) ? wc4[r] : 0.0f;
              u32x2 o; o.x = pk2(d[0], d[1]); o.y = pk2(d[2], d[3]); *(LAS u32x2*)(PHL + so) = o; } }
        LB();
#pragma unroll
        for (int j = 0; j < 2; ++j) { const int mt = pr + j; const int so = (tt * 16 + ln) * LD + mt * 16 + 4 * g;
            f32x4 d = (f32x4){0.f, 0.f, 0.f, 0.f}; mma_txy<2>(d, BH + 16 * mt, LD, UL + 16 * tt, LD, lane); mma_txy<2>(d, KH + 16 * mt, LD, V + 16 * tt, LD, lane);
            { u32x2 o; o.x = pk2(d[0], d[1]); o.y = pk2(d[2], d[3]); *(LAS u32x2*)(PSL + so) = o; }
            d = (f32x4){0.f, 0.f, 0.f, 0.f}; mma_tx<2>(d, UL + 16 * mt, LD, MRB + tt * 16 * LD, LD, lane); mma_tx<2>(d, V + 16 * mt, LD, MRK + tt * 16 * LD, LD, lane);
            { u32x2 o; o.x = pk2(d[0], d[1]); o.y = pk2(d[2], d[3]); *(u32x2*)(YLG + cu + frag_off(tt * 16 + ln, mt * 16 + 4 * g)) = o; } }
        LB();
        }
        { u32x2 xr[4][2][2]; load_xfrags_lds(xr, PHL, LD, lane); state_step(acc, xr);
          if (w >= 4) {
#pragma unroll
              for (int ct = 0; ct < 4; ++ct) { acc[ct] += bf4(*(const LAS u32x2*)(PSL + (16 * (w - 4) + ln) * LD + 16 * ct + 4 * g));
                  u32x2 o; o.x = pk2(acc[ct][0], acc[ct][1]); o.y = pk2(acc[ct][2], acc[ct][3]); *(u32x2*)(PSI + cu + frag_off(16 * (w - 4) + ln, 16 * ct + 4 * g)) = o; }
          } else {
#pragma unroll
              for (int ct = 0; ct < 4; ++ct) { float v0 = acc[ct][0], v1 = acc[ct][1], v2 = acc[ct][2], v3 = acc[ct][3];
                  { const bool od = lane & 1; float t0 = od ? v0 : v1, t1 = od ? v2 : v3; t0 = __shfl_xor(t0, 1); t1 = __shfl_xor(t1, 1); if (od) { v0 = t0; v2 = t1; } else { v1 = t0; v3 = t1; } }
                  { const bool od = lane & 2; float t0 = od ? v0 : v2, t1 = od ? v1 : v3; t0 = __shfl_xor(t0, 2); t1 = __shfl_xor(t1, 2); if (od) { v0 = t0; v1 = t1; } else { v2 = t0; v3 = t1; } }
                  u32x2 o; o.x = pk2(v0, v1); o.y = pk2(v2, v3); *(u32x2*)(PHIT + cu + frag_off(16 * ct + 4 * g + (ln & 3), 16 * w + (ln & 12))) = o; } } }
        LB();
    }
    LB();
}

namespace rk {
struct FoldRegs { u32x2 x[4][2][2]; f32x4 q[4]; };
__device__ __forceinline__ void fold_load(FoldRegs& R, const bf16_t* RP, const bf16_t* RQ, int up, int rt, int lane) {
    const size_t cu = ((size_t)up * SEGC + (SEGC - 1)) * CHB;
#pragma unroll
    for (int ct = 0; ct < 4; ++ct)
#pragma unroll
        for (int ks = 0; ks < 2; ++ks) { const u32x4 v = *(const u32x4*)(RP + cu + (size_t)(ct * 64 + lane) * 16 + 8 * ks); R.x[ct][ks][0] = (u32x2){v.x, v.y}; R.x[ct][ks][1] = (u32x2){v.z, v.w}; }
#pragma unroll
    for (int ks = 0; ks < 2; ++ks) { const u32x4 v = *(const u32x4*)(RQ + cu + (size_t)(rt * 64 + lane) * 16 + 8 * ks); R.q[2 * ks] = bf4((u32x2){v.x, v.y}); R.q[2 * ks + 1] = bf4((u32x2){v.z, v.w}); }
}
__device__ __forceinline__ void fold_step(const FoldRegs& R, f32x4 (&acc)[4]) { state_step(acc, R.x);
#pragma unroll
    for (int ct = 0; ct < 4; ++ct) acc[ct] += R.q[ct]; }
}
__device__ __forceinline__ void rwkv_scan_unit(const Ctx& F, int unit) {
    using namespace rk;
    const int w = F.wave;
    const int b = unit >> 7, h = (unit >> 4) & 7, seg = unit & 15;
    int tv_ = F.tid; asm volatile("" : "+v"(tv_));
    const int lane = tv_ & 63, g = lane >> 4, ln = lane & 15;
    LAS bf16_t* ST = (LAS bf16_t*)F.lds;
    LAS float* PG = (LAS float*)(F.lds + MBY);
    const bf16_t *RP = (const bf16_t*)(F.ws + WS_PHIT), *RQ = (const bf16_t*)(F.ws + WS_PSI), *YSG = (const bf16_t*)(F.ws + WS_YS), *YLG = (const bf16_t*)(F.ws + WS_YL), *GTG = (const bf16_t*)(F.ws + WS_GT), *BVG = (const bf16_t*)(F.ws + WS_BV);
    bf16_t* YCAT = (bf16_t*)(F.ws + WS_YCAT);
    const bf16_t* SEGP = (const bf16_t*)(F.ws + WS_SEGP); const float* SEGQ = (const float*)(F.ws + WS_SEGQ);
    if (tv_ < 128) PG[tv_] = (tv_ < 64) ? F.in[I_LNXG][h * 64 + tv_] : F.in[I_LNXB][h * 64 + tv_ - 64];
    const int c = w;
    const size_t cu = (size_t)((b * 8 + h) * NCHUNK + seg * SEGC + c) * CHB, cp = c > 0 ? cu - CHB : cu;
    bf16x8 ptx[4][2]; u32x4 qv[4][2]; bf16x8 ysr[4][2];
#define SCAN_LOADS() do { \
_Pragma("unroll") \
    for (int ct = 0; ct < 4; ++ct) \
_Pragma("unroll") \
        for (int ks = 0; ks < 2; ++ks) { ptx[ct][ks] = *(const bf16x8*)(RP + cp + (size_t)(ct * 64 + lane) * 16 + 8 * ks); qv[ct][ks] = *(const u32x4*)(RQ + cp + (size_t)(ct * 64 + lane) * 16 + 8 * ks); \
            ysr[ct][ks] = *(const bf16x8*)(YSG + cu + (size_t)(ct * 64 + lane) * 16 + 8 * ks); } \
    } while (0)
    if (w < 4) SCAN_LOADS();
    if (w >= 4) {
        f32x4 acc[4];
#pragma unroll
        for (int ct = 0; ct < 4; ++ct) acc[ct] = (f32x4){0.f, 0.f, 0.f, 0.f};
        const int rt = w - 4, u0 = unit - seg; FoldRegs F0, F1, F2, F3;
        const int ul = unit > 0 ? unit - 1 : 0;
#define FLD(R, k) do { const int un_ = u0 + (k); fold_load(R, RP, RQ, un_ < ul ? un_ : ul, rt, lane); } while (0)
        FLD(F0, 0); FLD(F1, 1); FLD(F2, 2);
        for (int sp = 0; sp < seg; sp += 4) {
            FLD(F3, sp + 3); fold_step(F0, acc);
            FLD(F0, sp + 4); if (sp + 1 < seg) fold_step(F1, acc);
            FLD(F1, sp + 5); if (sp + 2 < seg) fold_step(F2, acc);
            FLD(F2, sp + 6); if (sp + 3 < seg) fold_step(F3, acc);
        }
#undef FLD
#pragma unroll
        for (int ct = 0; ct < 4; ++ct) st4bf(ST + (16 * rt + ln) * LD + 16 * ct + 4 * g, acc[ct]);
        SCAN_LOADS();
    }
#undef SCAN_LOADS
    LB();
    bf16x8 xs[4][2];
#pragma unroll
    for (int rt = 0; rt < 4; ++rt) {
        f32x4 sc[4];
        if (c > 0) {
            bf16x8 yf[2];
#pragma unroll
            for (int ks = 0; ks < 2; ++ks) { const u32x2 lo_ = *(const LAS u32x2*)(ST + (16 * rt + ln) * LD + 32 * ks + 4 * g), hi_ = *(const LAS u32x2*)(ST + (16 * rt + ln) * LD + 32 * ks + 16 + 4 * g);
                u32x4 wv; wv.x = lo_.x; wv.y = lo_.y; wv.z = hi_.x; wv.w = hi_.y; yf[ks] = __builtin_bit_cast(bf16x8, wv); }
#pragma unroll
            for (int ct = 0; ct < 4; ++ct) { u32x2 q2; if (ct & 1) { q2.x = qv[rt][ct >> 1].z; q2.y = qv[rt][ct >> 1].w; } else { q2.x = qv[rt][ct >> 1].x; q2.y = qv[rt][ct >> 1].y; } f32x4 d = bf4(q2);
#pragma unroll
                for (int ks = 0; ks < 2; ++ks) d = __builtin_amdgcn_mfma_f32_16x16x32_bf16(ptx[ct][ks], yf[ks], d, 0, 0, 0);
                sc[ct] = d; }
        } else {
#pragma unroll
            for (int ct = 0; ct < 4; ++ct) sc[ct] = bf4(*(const LAS u32x2*)(ST + (16 * rt + ln) * LD + 16 * ct + 4 * g));
        }
        state_yfrags(sc, xs[rt]);
    }
    const size_t orow0 = ((size_t)b * SEQ + (size_t)(seg * SEGC + c) * CH) * D + 512 + h * 64;
    u32x4 yl[4][2], gt[4][2], bv[4][2];
#pragma unroll
    for (int tt = 0; tt < 4; ++tt)
#pragma unroll
        for (int ks = 0; ks < 2; ++ks) { const size_t ro = cu + (size_t)(tt * 64 + lane) * 16 + 8 * ks; yl[tt][ks] = *(const u32x4*)(YLG + ro); gt[tt][ks] = *(const u32x4*)(GTG + ro); bv[tt][ks] = *(const u32x4*)(BVG + ro); }
#define H2(a, vt) (((vt) & 1) ? (u32x2){(a)[(vt) >> 1].z, (a)[(vt) >> 1].w} : (u32x2){(a)[(vt) >> 1].x, (a)[(vt) >> 1].y})
#pragma unroll
    for (int tt = 0; tt < 4; ++tt) {
        f32x4 y[4]; float s = 0.f;
#pragma unroll
        for (int vt = 0; vt < 4; ++vt) { f32x4 d = bf4(H2(yl[tt], vt));
#pragma unroll
            for (int ks = 0; ks < 2; ++ks) d = __builtin_amdgcn_mfma_f32_16x16x32_bf16(xs[vt][ks], ysr[tt][ks], d, 0, 0, 0);
            y[vt] = d; s += (d[0] + d[1]) + (d[2] + d[3]); }
        s += __shfl_xor(s, 16); s += __shfl_xor(s, 32);
        const float mean = s * (1.0f / 64.0f); float qq = 0.f;
#pragma unroll
        for (int vt = 0; vt < 4; ++vt) { y[vt] = y[vt] - mean; qq += (y[vt][0] * y[vt][0] + y[vt][1] * y[vt][1]) + (y[vt][2] * y[vt][2] + y[vt][3] * y[vt][3]); }
        qq += __shfl_xor(qq, 16); qq += __shfl_xor(qq, 32);
        const float rstd = __builtin_amdgcn_rsqf(qq * (1.0f / 64.0f) + 64e-5f);
        const size_t orow = orow0 + (size_t)(16 * tt + ln) * D;
#pragma unroll
        for (int vt = 0; vt < 4; ++vt) { const f32x4 lg4 = *(const LAS f32x4*)(PG + 16 * vt + 4 * g), lb4 = *(const LAS f32x4*)(PG + 64 + 16 * vt + 4 * g);
            const f32x4 o = (y[vt] * rstd * lg4 + lb4 + bf4(H2(bv[tt], vt))) * bf4(H2(gt[tt], vt)); u32x2 ow; ow.x = pk2(o[0], o[1]); ow.y = pk2(o[2], o[3]);
            *(u32x2*)(YCAT + orow + 16 * vt + 4 * g) = ow; }
    }
#undef H2
    LB();
}

__device__ __forceinline__ void router_phase(const Ctx& F) {
    const int tid = F.tid, lane = F.lane, w = F.wave;
    constexpr int LDX = 1028;
    LAS float* X = (LAS float*)F.lds;
    LAS float* RS = (LAS float*)(F.lds + 32 * LDX * 4);
    LAS float* LOG = RS + 32;
    LAS int* LCNT = (LAS int*)(LOG + 32 * 33);
    const float* H1 = (const float*)(F.ws + WS_H1); unsigned char* HN2 = F.ws + WS_HN2; const float* RW = (const float*)(F.ws + WS_RW);
    int* CNT = (int*)(F.ws + WS_CNT); int* RIDX = (int*)(F.ws + WS_RIDX); float* RGATE = (float*)(F.ws + WS_RGATE); int* RRANK = (int*)(F.ws + WS_RRANK);
    f32x4 gv[4];
#pragma unroll
    for (int j = 0; j < 4; ++j) gv[j] = *((const f32x4*)F.in[I_N2G] + lane + 64 * j);
    for (int tile = F.vcu; tile < NRT; tile += F.G) {
        f32x4 vr[4][4];
#pragma unroll
        for (int rr = 0; rr < 4; ++rr) { const f32x4* xr = (const f32x4*)(H1 + ((size_t)tile * RT_TOK + w * 4 + rr) * D) + lane;
#pragma unroll
            for (int j = 0; j < 4; ++j) vr[rr][j] = xr[64 * j]; }
#pragma unroll
        for (int rr = 0; rr < 4; ++rr) { const int row = w * 4 + rr; const size_t m = (size_t)tile * RT_TOK + row;
            f32x4 v[4]; float s = 0.f;
#pragma unroll
            for (int j = 0; j < 4; ++j) { v[j] = vr[rr][j]; s += (v[j].x * v[j].x + v[j].y * v[j].y) + (v[j].z * v[j].z + v[j].w * v[j].w); }
            const float rstd = __builtin_amdgcn_rsqf(wave_sum(s) * (1.0f / D) + 1e-5f);
            unsigned* o4 = (unsigned*)(HN2 + m * D) + lane;
#pragma unroll
            for (int j = 0; j < 4; ++j) { o4[64 * j] = pk4_fp8(v[j].x * rstd * gv[j].x, v[j].y * rstd * gv[j].y, v[j].z * rstd * gv[j].z, v[j].w * rstd * gv[j].w);
                *(LAS f32x4*)(X + row * LDX + 4 * (lane + 64 * j)) = v[j]; }
            if (lane == 0) RS[row] = rstd; }
        WG_BAR();
        f32x16 acc;
#pragma unroll
        for (int r = 0; r < 16; ++r) acc[r] = 0.f;
        { const int i = lane & 31, hh = lane >> 5;
#pragma unroll 4
          for (int kg = 0; kg < 16; ++kg) { const int kb = 128 * w + 8 * kg + 4 * hh; const f32x4 xa = *(const LAS f32x4*)(X + i * LDX + kb);
#pragma unroll
              for (int j = 0; j < 4; ++j) acc = __builtin_amdgcn_mfma_f32_32x32x2f32(xa[j], RW[(kb + j) * NEXP + i], acc, 0, 0, 0); } }
        WG_BAR();
#pragma unroll
        for (int r = 0; r < 16; ++r) { const int tok = (r & 3) + 8 * (r >> 2) + 4 * (lane >> 5); X[(w * 32 + tok) * 33 + (lane & 31)] = acc[r]; }
        WG_BAR();
#pragma unroll
        for (int q = 0; q < 2; ++q) { const int idx = tid + 512 * q, tok = idx >> 5, e = idx & 31; float s = 0.f;
#pragma unroll
            for (int ww = 0; ww < 8; ++ww) s += X[(ww * 32 + tok) * 33 + e];
            LOG[tok * 33 + e] = s * RS[tok] + F.in[I_RB][e]; }
        if (tid < 32) LCNT[tid] = 0;
        WG_BAR();
        {
            const int e = lane & 31;
#pragma unroll
            for (int it = 0; it < 2; ++it) { const int tok = w * 4 + 2 * it + (lane >> 5); float val = LOG[tok * 33 + e]; float tv[4]; int ti[4];
#pragma unroll
                for (int p = 0; p < 4; ++p) { float cand = val; int idx = e;
#pragma unroll
                    for (int d = 1; d < 32; d <<= 1) { const float ov = __shfl_xor(cand, d); const int oi = __shfl_xor(idx, d); const bool take = (ov > cand) || (ov == cand && oi < idx); cand = take ? ov : cand; idx = take ? oi : idx; }
                    tv[p] = cand; ti[p] = idx; if (e == idx) val = -3.0e38f; }
                float ex[4], es = 0.f;
#pragma unroll
                for (int p = 0; p < 4; ++p) { ex[p] = __expf(tv[p] - tv[0]); es += ex[p]; }
                const float inv = __builtin_amdgcn_rcpf(es); const size_t m = (size_t)tile * RT_TOK + tok;
#pragma unroll
                for (int p = 0; p < 4; ++p) if (e == ti[p]) { const int rk = atomicAdd((int*)(LCNT + e), 1); RIDX[m * 4 + p] = e; RGATE[m * 4 + p] = ex[p] * inv; RRANK[m * 4 + p] = rk; }
            }
        }
        WG_BAR();
        if (tid < 32) CNT[tile * 32 + tid] = LCNT[tid];
        WG_BAR();
    }
}

__device__ __forceinline__ void scatter_phase(const Ctx& F) {
    const int tid = F.tid;
    LAS int* PS = (LAS int*)F.lds;
    LAS int* PAD = PS + 512;
    LAS int* BASE = PAD + 64;
    const int* CNT = (const int*)(F.ws + WS_CNT); const int* RIDX = (const int*)(F.ws + WS_RIDX); const float* RGATE = (const float*)(F.ws + WS_RGATE); const int* RRANK = (const int*)(F.ws + WS_RRANK);
    int* TDEST = (int*)(F.ws + WS_TDEST); int* ROWTOK = (int*)(F.ws + WS_ROWTOK); float* ROWGATE = (float*)(F.ws + WS_ROWGATE); int* ETAB = (int*)(F.ws + WS_ETAB);
    { const int e = tid & 31, p = tid >> 5; int sm = 0;
#pragma unroll
      for (int j = 0; j < 32; ++j) sm += CNT[(32 * p + j) * 32 + e];
      PS[p * 32 + e] = sm; }
    WG_BAR();
    if (tid < 64) { const int e = tid & 31; int tot = 0;
#pragma unroll
        for (int p = 0; p < 16; ++p) tot += PS[p * 32 + e];
        const int padn = (tot + 255) & ~255; int inc = padn;
#pragma unroll
        for (int d = 1; d < 32; d <<= 1) { const int o = __shfl_up(inc, d, 32); inc += (e >= d) ? o : 0; }
        if (tid < 32) { PAD[e] = inc - padn; if (e == 31) PAD[32] = inc; } }
    WG_BAR();
    if (F.vcu == 0 && tid < 33) ETAB[tid] = PAD[tid];
    for (int tile = F.vcu; tile < NRT; tile += F.G) {
        if (tid < 32) { const int p = tile >> 5; int sm = PAD[tid];
#pragma unroll
            for (int pp = 0; pp < 16; ++pp) sm += (pp < p) ? PS[pp * 32 + tid] : 0;
#pragma unroll
            for (int j = 0; j < 32; ++j) { const int v = CNT[(32 * p + j) * 32 + tid]; sm += (32 * p + j < tile) ? v : 0; }
            BASE[tid] = sm; }
        WG_BAR();
        if (tid < 128) { const size_t ix = (size_t)tile * 128 + tid; const int e = RIDX[ix]; const int dest = BASE[e] + RRANK[ix];
            ROWTOK[dest] = (int)(ix >> 2); ROWGATE[dest] = RGATE[ix]; TDEST[ix] = dest; }
        WG_BAR();
    }
}

struct CombRows { f32x4 v[4]; unsigned y[4][4]; };
__device__ __forceinline__ void comb_load(CombRows& R, const float* H1, const unsigned char* YOUT, const int4 td, int m, int lane) {
    const f32x4* xr = (const f32x4*)(H1 + (size_t)m * D) + lane;
#pragma unroll
    for (int j = 0; j < 4; ++j) R.v[j] = __builtin_nontemporal_load(xr + 64 * j);
    const int dd[4] = {td.x, td.y, td.z, td.w};
#pragma unroll
    for (int p = 0; p < 4; ++p) { const unsigned* yr = (const unsigned*)(YOUT + (size_t)dd[p] * D) + lane;
#pragma unroll
        for (int j = 0; j < 4; ++j) R.y[p][j] = __builtin_nontemporal_load(yr + 64 * j); }
}
__device__ __forceinline__ void comb_store(const CombRows& R, const f32x4 (&gv)[4], float* out, int m, int lane) {
    f32x4 v[4]; float s = 0.f;
#pragma unroll
    for (int j = 0; j < 4; ++j) { v[j] = R.v[j];
#pragma unroll
        for (int p = 0; p < 4; ++p) { const unsigned y = R.y[p][j]; const f32x2 lo = __builtin_amdgcn_cvt_pk_f32_fp8(y, false), hi = __builtin_amdgcn_cvt_pk_f32_fp8(y, true);
            v[j].x += lo.x * (1.0f / FP8_SY); v[j].y += lo.y * (1.0f / FP8_SY); v[j].z += hi.x * (1.0f / FP8_SY); v[j].w += hi.y * (1.0f / FP8_SY); }
        s += (v[j].x * v[j].x + v[j].y * v[j].y) + (v[j].z * v[j].z + v[j].w * v[j].w); }
    const float rstd = __builtin_amdgcn_rsqf(wave_sum(s) * (1.0f / D) + 1e-5f);
    f32x4* o = (f32x4*)(out + (size_t)m * D) + lane;
#pragma unroll
    for (int j = 0; j < 4; ++j) __builtin_nontemporal_store(v[j] * rstd * gv[j], o + 64 * j);
}
__device__ __forceinline__ void combine_phase(const Ctx& F, float* out) {
    const int lane = F.lane; const int gw = F.vcu * 8 + F.wave, NGW = F.G * 8;
    const float* H1 = (const float*)(F.ws + WS_H1); const unsigned char* YOUT = F.ws + WS_YOUT; const int4* TDEST = (const int4*)(F.ws + WS_TDEST);
    f32x4 gv[4];
#pragma unroll
    for (int j = 0; j < 4; ++j) gv[j] = *((const f32x4*)F.in[I_FG] + lane + 64 * j);
    for (int m0 = gw; m0 < M; m0 += 8 * NGW) {
        int4 td[8];
#pragma unroll
        for (int i = 0; i < 8; ++i) { const int m = m0 + i * NGW; td[i] = TDEST[m < M ? m : M - 1]; }
        CombRows A, B;
        comb_load(A, H1, YOUT, td[0], m0, lane);
#pragma unroll
        for (int i = 0; i < 8; i += 2) {
            { const int m = m0 + (i + 1) * NGW; comb_load(B, H1, YOUT, td[i + 1], m < M ? m : M - 1, lane); }
            { const int m = m0 + i * NGW; if (m < M) comb_store(A, gv, out, m, lane); }
            if (i + 2 < 8) { const int m = m0 + (i + 2) * NGW; comb_load(A, H1, YOUT, td[i + 2], m < M ? m : M - 1, lane); }
            { const int m = m0 + (i + 1) * NGW; if (m < M) comb_store(B, gv, out, m, lane); }
        }
    }
}

__global__ void __launch_bounds__(512, 2) mk_fwd(Args args) {
    extern __shared__ __attribute__((aligned(16))) unsigned char lds_raw[];
    Ctx F;
    F.lds = (LAS unsigned char*)lds_raw;
    F.tid = threadIdx.x; F.lane = F.tid & 63; F.wave = __builtin_amdgcn_readfirstlane(F.tid >> 6);
    F.G = gridDim.x; { const int bx = blockIdx.x; F.vcu = (F.G % 8 == 0) ? (bx % 8) * (F.G / 8) + bx / 8 : bx; }
    F.ws = args.ws; F.in = args.in;
    volatile LAS unsigned* MISC = (volatile LAS unsigned*)(F.lds + MISC_OFF);
    if (F.tid < 64) MISC[F.tid] = 0u;
    __syncthreads();
    unsigned* ctl = (unsigned*)(args.ws + WS_CTL);
    XcdBarrier bar; bar.bar = ctl + CW_BAR; bar.x = 0; bar.st = nullptr;
    const int lo = args.ph_lo, hi = args.ph_hi;
    if (hi - lo > 1) bar = xcd_barrier_post(ctl + CW_BAR + args.li * XCD_BAR_WORDS, MISC + 8);
#define IN(k) (lo <= (k) && (k) < hi)
#define SEAM(k) do { if (IN(k) && IN((k) + 1)) xcd_barrier(bar); } while (0)
    unsigned char* ws = args.ws;

    if (IN(0)) REP(0) { p0_prologue(F); } SEAM(0);
    if (IN(1)) REP(1) {
        pg8::Gemm g{(const bf16_t*)(ws + WS_XN), (const bf16_t*)(ws + WS_WCAT), M, NPROJ, D}; pg8::StaticOrder S; S.init(M, NPROJ, D, F.G, (int)blockIdx.x);
        pg8::EpiProj E{(bf16_t*)(ws + WS_PROJ), NPROJ, 4};
        pg8::gemm_phase<pg8::EpiProj, pg8::StaticOrder, false>(F.lds, g, S, E);
    } SEAM(1);
    if (IN(2)) REP(2) { REP(10) sgu_phase(F); for (int u = F.vcu; u < NRU; u += F.G) rwkv_prep_unit(F, u); } SEAM(2);
    if (IN(3)) REP(3) { for (int u = F.vcu; u < NRU; u += F.G) rwkv_scan_unit(F, u); } SEAM(3);
    if (IN(4)) REP(4) {
        pg8::Gemm g{(const bf16_t*)(ws + WS_YCAT), (const bf16_t*)(ws + WS_WOUT), M, D, D}; pg8::StaticOrder S; S.init(M, D, D, F.G, (int)blockIdx.x);
        pg8::EpiResF32 E{F.in[I_X], (float*)(ws + WS_H1), D};
        pg8::gemm_phase<pg8::EpiResF32, pg8::StaticOrder, false>(F.lds, g, S, E);
    } SEAM(4);
    if (IN(5)) REP(5) { router_phase(F); } SEAM(5);
    if (IN(6)) REP(6) { scatter_phase(F); moe_weight_phase(F); } SEAM(6);
    if (IN(7)) REP(7) {
        const int* etab = (const int*)(ws + WS_ETAB);
        pg8::MoeOrder S; S.ntiles = etab[32] >> 8; S.nN = NHID / 256; S.G = F.G; S.c = (int)blockIdx.x; S.K = D; S.N = NHID; S.pad_start = etab; S.rowtok = (const int*)(ws + WS_ROWTOK); S.build_texp(F.lds);
        pg8::Gemm g{(const bf16_t*)(ws + WS_HN2), (const bf16_t*)(ws + WS_W1T), MAXROWS, NHID, D};
        pg8::EpiSwiglu E{ws + WS_ACT, F.in[I_MB1], &S};
        pg8::gemm_phase<pg8::EpiSwiglu, pg8::MoeOrder, true, true>(F.lds, g, S, E);
    } SEAM(7);
    if (IN(8)) REP(8) {
        const int* etab = (const int*)(ws + WS_ETAB);
        pg8::MoeOrder S; S.ntiles = etab[32] >> 8; S.nN = D / 256; S.G = F.G; S.c = (int)blockIdx.x; S.K = DEXP; S.N = D; S.pad_start = etab; S.rowtok = nullptr; S.build_texp(F.lds);
        pg8::Gemm g{(const bf16_t*)(ws + WS_ACT), (const bf16_t*)(ws + WS_W2T), MAXROWS, D, DEXP};
        pg8::EpiGate E{ws + WS_YOUT, F.in[I_MB2], (const float*)(ws + WS_ROWGATE), &S};
        pg8::gemm_phase<pg8::EpiGate, pg8::MoeOrder, false, true>(F.lds, g, S, E);
    } SEAM(8);
    if (IN(9)) REP(9) { combine_phase(F, args.out); }
#undef IN
#undef SEAM
}

extern "C" void kernel_launch(void* const* d_in, const int* in_sizes, int n_in, void* d_out, int out_size, void* d_ws, size_t ws_size, hipStream_t stream) {
    static int grid = 0;
    if (grid == 0) {
        if (n_in != 31 || in_sizes[0] != M * D || out_size != M * D || ws_size < WS_END) { fprintf(stderr, "kernel_launch: unexpected problem (n_in %d, out %d, ws %zu); nothing launched\n", n_in, out_size, ws_size); grid = -1; return; }
        int dev = 0, cus = 0, per_cu = 0;
        if (hipGetDevice(&dev) != hipSuccess || hipDeviceGetAttribute(&cus, hipDeviceAttributeMultiprocessorCount, dev) != hipSuccess) { grid = -1; return; }
        if (hipFuncSetAttribute((const void*)mk_fwd, hipFuncAttributeMaxDynamicSharedMemorySize, LDS_BYTES) != hipSuccess) { fprintf(stderr, "kernel_launch: hipFuncSetAttribute failed\n"); grid = -1; return; }
        if (hipOccupancyMaxActiveBlocksPerMultiprocessor(&per_cu, (const void*)mk_fwd, 512, LDS_BYTES) != hipSuccess || per_cu < 1) fprintf(stderr, "kernel_launch: occupancy query reports %d\n", per_cu);
        (void)hipGetLastError();
        grid = cus;
    }
    if (grid < 0) return;
    if (hipMemsetAsync((char*)d_ws + WS_CTL, 0, CTL_ZERO_BYTES, stream) != hipSuccess) return;
    Args a; memset(&a, 0, sizeof(a));
    for (int i = 0; i < 31; ++i) a.in[i] = (const float*)d_in[i];
    a.out = (float*)d_out; a.ws = (unsigned char*)d_ws;
    constexpr int NL = MK_N_LAUNCHES;
    static_assert(NL == 1 || NL == N_PHASES, "MK_N_LAUNCHES: 1 (one launch) or 10 (one launch per phase)");
    for (int li = 0; li < NL; ++li) {
        a.ph_lo = (NL == 1) ? 0 : li; a.ph_hi = (NL == 1) ? N_PHASES : li + 1; a.li = 0; a.pad = 0;
        hipLaunchKernelGGL(mk_fwd, dim3(grid), dim3(512), LDS_BYTES, stream, a);
    }
}
```

```cpp
#include <hip/hip_runtime.h>
#include <cstdio>
#include <cstdint>
#include <cstring>

#ifndef MK_N_LAUNCHES
#define MK_N_LAUNCHES 1
#endif
constexpr int N_PHASES = 10;
#ifndef PROBE_MASK
#define PROBE_MASK 0
#endif
#define REP(k) for (int rep_ = 0; rep_ < (((PROBE_MASK >> (k)) & 1) ? 2 : 1); ++rep_)

#define LAS __attribute__((address_space(3)))
#define GAS __attribute__((address_space(1)))
typedef unsigned short bf16_t;
typedef short bf16x8 __attribute__((ext_vector_type(8)));
typedef float f32x4 __attribute__((ext_vector_type(4)));
typedef float f32x2 __attribute__((ext_vector_type(2)));
typedef float f32x16 __attribute__((ext_vector_type(16)));
typedef unsigned u32x4 __attribute__((ext_vector_type(4)));
typedef unsigned u32x2 __attribute__((ext_vector_type(2)));
typedef GAS unsigned gu32;
#define RLX_AGENT __ATOMIC_RELAXED, __HIP_MEMORY_SCOPE_AGENT
#define LDS_WAIT() asm volatile("s_waitcnt lgkmcnt(0)" ::: "memory")
#define VM_WAIT() asm volatile("s_waitcnt vmcnt(0)" ::: "memory")
#define WG_BAR() do { asm volatile("s_waitcnt vmcnt(0) lgkmcnt(0)" ::: "memory"); __builtin_amdgcn_s_barrier(); asm volatile("" ::: "memory"); } while (0)

constexpr int BATCH = 2, SEQ = 8192, D = 1024, M = BATCH * SEQ;
constexpr int NPROJ = 3072;
constexpr int COL_V = 512, COL_R = 1024, COL_K = 1536, COL_VR = 2048, COL_LA = 2560, COL_LB = 2816;
constexpr int NEXP = 32, TOPK = 4, DEXP = 1024, NHID = 2048;
constexpr int NASSIGN = M * TOPK;
constexpr int MAXROWS = NASSIGN + NEXP * 256;
constexpr int RT_TOK = 32, NRT = M / RT_TOK;
constexpr int CH = 64, NCHUNK = SEQ / CH, SEGC = 8, NSEG = NCHUNK / SEGC;
constexpr int NRU = BATCH * 8 * NSEG;

constexpr size_t MiB = 1u << 20;
constexpr size_t WS_CTL = 0, CTL_ZERO_BYTES = 14976;
constexpr size_t WS_WCAT = 2 * MiB;
constexpr size_t WS_WOUT = 8 * MiB;
constexpr size_t WS_SMALL = 10 * MiB;
constexpr size_t WS_LW2 = WS_SMALL;
constexpr size_t WS_LA2 = WS_LW2 + 512 * 64 * 2;
constexpr size_t WS_LG2 = WS_LA2 + 512 * 64 * 2;
constexpr size_t WS_SGUW = WS_LG2 + 512 * 128 * 2;
constexpr size_t WS_RW = WS_SGUW + 8 * 128 * 128 * 2;
constexpr size_t WS_ETAB = WS_RW + 1024 * 32 * 4;
constexpr size_t WS_CNT = WS_ETAB + 1024;
constexpr size_t WS_RIDX = WS_CNT + NRT * 32 * 4;
constexpr size_t WS_RGATE = WS_RIDX + (size_t)M * 4 * 4;
constexpr size_t WS_RRANK = WS_RGATE + (size_t)M * 4 * 4;
constexpr size_t WS_TDEST = WS_RRANK + (size_t)M * 4 * 4;
static_assert(WS_TDEST + (size_t)M * 4 * 4 <= 12 * MiB, "small region");
constexpr size_t WS_ROWTOK = 12 * MiB;
constexpr size_t WS_ROWGATE = 13 * MiB;
constexpr size_t WS_SEGP = 14 * MiB;
constexpr size_t WS_SEGQ = 16 * MiB;
constexpr size_t WS_XN = 32 * MiB;
constexpr size_t WS_YCAT = 64 * MiB;
constexpr size_t WS_HN2 = 96 * MiB;
constexpr size_t WS_H1 = 128 * MiB;
constexpr size_t WS_PROJ = 192 * MiB;
constexpr size_t WS_W1T = 288 * MiB;
constexpr size_t WS_W2T = 416 * MiB;
constexpr size_t WS_ACT = 480 * MiB;
constexpr size_t WS_YOUT = 624 * MiB;
constexpr size_t WS_RK = 768 * MiB;
constexpr size_t WS_PHIT = WS_RK, WS_PSI = WS_RK + 8192, WS_YS = WS_RK + 16384, WS_YL = WS_RK + 24576, WS_GT = WS_RK + 32768, WS_BV = WS_RK + 40960;
constexpr size_t WS_END = 864 * MiB;
constexpr int CW_BAR = 0, CW_DEP = 3456;

constexpr int RING_BYTES = 131072;
constexpr int TAB_OFF = 151552;
constexpr int PRE_OFF = RING_BYTES;
constexpr int DEP_OFF = PRE_OFF + 4096;
constexpr int TEXP_OFF = TAB_OFF + 2048;
constexpr int LDS_BYTES = 155648;
constexpr int MISC_OFF = LDS_BYTES - 256;

typedef __bf16 bf16v2_t __attribute__((ext_vector_type(2)));
__device__ __forceinline__ unsigned pk2(float lo, float hi) { const f32x2 v = {lo, hi}; return __builtin_bit_cast(unsigned, __builtin_convertvector(v, bf16v2_t)); }
__device__ __forceinline__ unsigned f2bf(float f) { return pk2(f, 0.f) & 0xffffu; }
__device__ __forceinline__ float bf2f(unsigned short b) { return __builtin_bit_cast(float, (unsigned)b << 16); }
__device__ __forceinline__ float bflo(unsigned w) { return __builtin_bit_cast(float, w << 16); }
__device__ __forceinline__ float bfhi(unsigned w) { return __builtin_bit_cast(float, w & 0xffff0000u); }
__device__ __forceinline__ void unpack8(const u32x4 w, float (&o)[8]) { o[0] = bflo(w.x); o[1] = bfhi(w.x); o[2] = bflo(w.y); o[3] = bfhi(w.y); o[4] = bflo(w.z); o[5] = bfhi(w.z); o[6] = bflo(w.w); o[7] = bfhi(w.w); }
__device__ __forceinline__ u32x4 pack8(const float (&v)[8]) { u32x4 w; w.x = pk2(v[0], v[1]); w.y = pk2(v[2], v[3]); w.z = pk2(v[4], v[5]); w.w = pk2(v[6], v[7]); return w; }
__device__ __forceinline__ float fsigmoid(float x) { return __builtin_amdgcn_rcpf(1.0f + __expf(-x)); }
__device__ __forceinline__ unsigned pk4_fp8(float a, float b, float c, float d) {
    a = fminf(fmaxf(a, -448.f), 448.f); b = fminf(fmaxf(b, -448.f), 448.f); c = fminf(fmaxf(c, -448.f), 448.f); d = fminf(fmaxf(d, -448.f), 448.f);
    unsigned w = 0u; w = __builtin_amdgcn_cvt_pk_fp8_f32(a, b, w, false); w = __builtin_amdgcn_cvt_pk_fp8_f32(c, d, w, true); return w; }
constexpr float FP8_SW = 64.0f;
constexpr float FP8_SA = 4.0f;
constexpr float FP8_SY = 16.0f;
__device__ __forceinline__ float wave_sum(float v) {
#pragma unroll
    for (int o = 1; o < 64; o <<= 1) v += __shfl_xor(v, o);
    return v;
}

namespace pg8 {
constexpr int BM = 256, BK = 64, HALF = 128, HTB = HALF * BK * 2, STAGE_BYTES = 8 * HTB, NXCD = 8, WGM = 8;
__host__ __device__ __forceinline__ int lds_byte(int r, int c) { const int st = (r >> 4) * 2 + (c >> 5), rr = r & 15, cc = c & 31, ob = rr * 64 + cc * 2; return st * 1024 + (ob ^ (((ob >> 9) & 1) << 5)); }
__host__ __device__ __forceinline__ void stage_rc(int b, int& R, int& C) { const int st = b / 1024, sb = b % 1024, swz = sb ^ (((sb >> 9) & 1) << 5); R = (st >> 1) * 16 + swz / 64; C = (st & 1) * 32 + (swz % 64) / 2; }
__host__ __device__ __forceinline__ int perm32(int rho) { const int n = rho >> 4, i = rho & 15; return 8 * (i >> 2) + 4 * n + (i & 3); }

struct Unit { int pm, pn, kind; };
struct Gemm { const bf16_t* A; const bf16_t* Bt; int M, N, K; };

struct StaticOrder {
    static constexpr bool CHAIN = false;
    int nM, nN, nwg, G, c, K;
    __device__ void init(int M_, int N_, int K_, int G_, int c_) { nM = M_ / BM; nN = N_ / BM; nwg = nM * nN; G = G_; c = c_; K = K_ * 2; }
    __device__ bool next(int i, Unit& u) const {
        const long L = (long)i * G + c; if (L >= nwg) return false;
        int wgid = (int)L; { const int q = nwg / NXCD, r = nwg % NXCD, xcd = wgid % NXCD, off = wgid / NXCD; wgid = (xcd < r ? xcd * (q + 1) : r * (q + 1) + (xcd - r) * q) + off; }
        const int nig = WGM * nN, gid = wgid / nig, fm = gid * WGM, gsz = (nM - fm) < WGM ? (nM - fm) : WGM;
        u.pm = fm + ((wgid % nig) % gsz); u.pn = (wgid % nig) / gsz; u.kind = 0; return true;
    }
    __device__ __forceinline__ const char* a_ptr(const Gemm& g, const Unit& u) const { return (const char*)g.A + (size_t)u.pm * BM * K; }
    __device__ __forceinline__ const char* b_ptr(const Gemm& g, const Unit& u) const { return (const char*)g.Bt + (size_t)u.pn * BM * K; }
    __device__ __forceinline__ unsigned row_off(const Unit&, int) const { return 0u; }
};
struct MoeChain {
    static constexpr bool CHAIN = true;
    int n1, ntot, G, c; const int* pad_start; const int* rowtok; const LAS unsigned char* texp;
    const char* A1; const char* B1; const char* A2; const char* B2; unsigned* cnt;
    __device__ __forceinline__ int expert_of(int pm) const { return (int)texp[pm]; }
    __device__ __forceinline__ void build_texp(LAS unsigned char* lds) { LAS unsigned char* t = lds + TEXP_OFF;
        for (int pm = (int)threadIdx.x; pm < MAXROWS / BM; pm += 512) { const int r0 = pm * BM; int e = 0;
            for (int j = 1; j < NEXP; ++j) if (pad_start[j] <= r0) e = j;
            t[pm] = (unsigned char)e; }
        texp = t; WG_BAR(); }
    __device__ bool next(int i, Unit& u) const { const long L = (long)i * G + c; if (L >= ntot) return false;
        if (L < n1) { u.kind = 0; u.pm = (int)L >> 3; u.pn = (int)L & 7; } else { const int j = (int)L - n1; u.kind = 1; u.pm = j >> 2; u.pn = j & 3; } return true; }
    __device__ __forceinline__ const char* a_ptr(const Gemm&, const Unit& u) const { return u.kind ? A2 : A1; }
    __device__ __forceinline__ const char* b_ptr(const Gemm&, const Unit& u) const { const size_t e = (size_t)expert_of(u.pm);
        return u.kind ? B2 + ((e * D + (size_t)u.pn * BM) << 10) : B1 + ((e * NHID + (size_t)u.pn * BM) << 10); }
    __device__ __forceinline__ unsigned row_off(const Unit& u, int r) const { return (u.kind ? (unsigned)(u.pm * BM + r) : (unsigned)rowtok[u.pm * BM + r]) << 10; }
    __device__ __forceinline__ void dep_block(int pm) const {
        for (int it = 0; it < (1 << 22); ++it) { if (__hip_atomic_load(cnt + pm, __ATOMIC_RELAXED, __HIP_MEMORY_SCOPE_AGENT) >= 64u) break; __builtin_amdgcn_s_sleep(8); } }
};

__device__ __forceinline__ unsigned cvt_pk_bf16(float lo, float hi) { unsigned r; asm volatile("v_cvt_pk_bf16_f32 %0, %1, %2" : "=v"(r) : "v"(lo), "v"(hi)); return r; }
__device__ __forceinline__ f32x2 gelu_pk(f32x2 v) {
    const f32x2 av = __builtin_elementwise_abs(v), d = av * 0.2316418882f + 1.0f;
    f32x2 t; t.x = __builtin_amdgcn_rcpf(d.x); t.y = __builtin_amdgcn_rcpf(d.y);
    f32x2 q = t * 0.5307027145f + (-0.7265760135f); q = q * t + 0.7107068705f; q = q * t + (-0.142248368f); q = q * t + 0.127414796f; q = q * t;
    const f32x2 s = (v * v) * (-0.72134752044f);
    f32x2 e; e.x = __builtin_amdgcn_exp2f(s.x); e.y = __builtin_amdgcn_exp2f(s.y);
    const f32x2 m = v * (q * e), r = v - m;
    f32x2 o; o.x = v.x < 0.f ? m.x : r.x; o.y = v.y < 0.f ? m.y : r.y; return o;
}
struct EpiProj {
    static constexpr bool PERM = true; static constexpr int NPRE = 0;
    bf16_t* O; int ldc; int ngelu;
    __device__ __forceinline__ const float* pre_src(const Unit&, int) const { return nullptr; }
    __device__ __forceinline__ void operator()(const f32x4 (&acc)[2][2][4][2], const Unit& u, int wr, int wc, int fr, int fq, const LAS float*) const {
        const int row0 = u.pm * BM + wr * 64 + fr, col0 = u.pn * BM + wc * 32 + 8 * fq; const bool act = u.pn < ngelu;
#pragma unroll
        for (int ai = 0; ai < 2; ++ai)
#pragma unroll
            for (int m = 0; m < 4; ++m) { bf16_t* rowp = O + (size_t)(row0 + ai * HALF + m * 16) * ldc + col0;
#pragma unroll
                for (int bj = 0; bj < 2; ++bj) { f32x4 v0 = acc[ai][bj][m][0], v1 = acc[ai][bj][m][1];
                    if (act) { f32x2 a = gelu_pk((f32x2){v0[0], v0[1]}), b = gelu_pk((f32x2){v0[2], v0[3]}), c = gelu_pk((f32x2){v1[0], v1[1]}), d = gelu_pk((f32x2){v1[2], v1[3]});
                        v0 = (f32x4){a.x, a.y, b.x, b.y}; v1 = (f32x4){c.x, c.y, d.x, d.y}; }
                    u32x4 w; w.x = cvt_pk_bf16(v0[0], v0[1]); w.y = cvt_pk_bf16(v0[2], v0[3]); w.z = cvt_pk_bf16(v1[0], v1[1]); w.w = cvt_pk_bf16(v1[2], v1[3]);
                    *(u32x4*)(rowp + bj * HALF) = w; } }
    }
};
struct EpiResF32 {
    static constexpr bool PERM = false; static constexpr int NPRE = 0;
    const float* base; float* out; int ldc;
    __device__ __forceinline__ const float* pre_src(const Unit&, int) const { return nullptr; }
    __device__ __forceinline__ void operator()(const f32x4 (&acc)[2][2][4][2], const Unit& u, int wr, int wc, int fr, int fq, const LAS float*) const {
        const int col0 = u.pn * BM + wc * 32 + 4 * fq;
#pragma unroll
        for (int ai = 0; ai < 2; ++ai)
#pragma unroll
            for (int m = 0; m < 4; ++m) { const size_t off = (size_t)(u.pm * BM + ai * HALF + wr * 64 + m * 16 + fr) * ldc + col0;
#pragma unroll
                for (int bj = 0; bj < 2; ++bj)
#pragma unroll
                    for (int n = 0; n < 2; ++n) { const f32x4 bs = *(const f32x4*)(base + off + bj * HALF + n * 16); *(f32x4*)(out + off + bj * HALF + n * 16) = bs + acc[ai][bj][m][n]; } }
    }
};
struct EpiSwiglu {
    static constexpr bool PERM = true; static constexpr int NPRE = 4;
    unsigned char* O; const float* b1; const LAS unsigned char* texp;
    __device__ __forceinline__ const float* pre_src(const Unit& u, int w) const { return b1 + (size_t)texp[u.pm] * NHID + u.pn * BM + w * 64; }
    __device__ __forceinline__ void operator()(const f32x4 (&acc)[2][2][4][2], const Unit& u, int wr, int wc, int fr, int fq, const LAS float* pre) const {
        const int row0 = u.pm * BM + wr * 64 + fr, oc0 = u.pn * HALF + wc * 32 + 8 * fq;
        const LAS f32x4* bp = (const LAS f32x4*)(pre + 2 * (wc * 32 + 8 * fq));
        f32x4 bg[2], bl[2];
#pragma unroll
        for (int n = 0; n < 2; ++n) { const f32x4 x0 = bp[2 * n], x1 = bp[2 * n + 1]; bg[n] = (f32x4){x0[0], x0[2], x1[0], x1[2]}; bl[n] = (f32x4){x0[1], x0[3], x1[1], x1[3]}; }
#pragma unroll
        for (int ai = 0; ai < 2; ++ai)
#pragma unroll
            for (int m = 0; m < 4; ++m) { unsigned char* rowp = O + (size_t)(row0 + ai * HALF + m * 16) * DEXP + oc0; float o[8];
#pragma unroll
                for (int n = 0; n < 2; ++n) { const f32x4 g = acc[ai][0][m][n] * (1.0f / FP8_SW) + bg[n], l = acc[ai][1][m][n] * (1.0f / FP8_SW) + bl[n];
#pragma unroll
                    for (int q = 0; q < 4; ++q) { const float gg = fminf(g[q], 7.0f), ll = __builtin_amdgcn_fmed3f(l[q], -7.0f, 7.0f);
                        const float sg = gg * __builtin_amdgcn_rcpf(1.0f + __builtin_amdgcn_exp2f(gg * (-1.702f * 1.4426950408889634f)));
                        o[4 * n + q] = sg * __builtin_fmaf(ll, FP8_SA, FP8_SA); } }
                u32x2 w; { unsigned w0 = 0u; w0 = __builtin_amdgcn_cvt_pk_fp8_f32(o[0], o[1], w0, false); w0 = __builtin_amdgcn_cvt_pk_fp8_f32(o[2], o[3], w0, true); w.x = w0; }
                { unsigned w1 = 0u; w1 = __builtin_amdgcn_cvt_pk_fp8_f32(o[4], o[5], w1, false); w1 = __builtin_amdgcn_cvt_pk_fp8_f32(o[6], o[7], w1, true); w.y = w1; }
                __hip_atomic_store((unsigned long long*)rowp, (unsigned long long)w.x | ((unsigned long long)w.y << 32), __ATOMIC_RELAXED, __HIP_MEMORY_SCOPE_AGENT); }
    }
};
struct EpiGate {
    static constexpr bool PERM = true; static constexpr int NPRE = 8;
    unsigned char* O; const float* b2; const float* rowgate; const LAS unsigned char* texp;
    __device__ __forceinline__ const float* pre_src(const Unit& u, int w) const { return w < 4 ? b2 + (size_t)texp[u.pm] * D + u.pn * BM + w * 64 : rowgate + (size_t)u.pm * BM + (w - 4) * 64; }
    __device__ __forceinline__ void operator()(const f32x4 (&acc)[2][2][4][2], const Unit& u, int wr, int wc, int fr, int fq, const LAS float* pre) const {
        const int row0 = u.pm * BM + wr * 64 + fr, col0 = u.pn * BM + wc * 32 + 8 * fq;
        f32x4 bv[2][2];
#pragma unroll
        for (int bj = 0; bj < 2; ++bj)
#pragma unroll
            for (int n = 0; n < 2; ++n) bv[bj][n] = *(const LAS f32x4*)(pre + wc * 32 + 8 * fq + bj * HALF + 4 * n);
#pragma unroll
        for (int ai = 0; ai < 2; ++ai)
#pragma unroll
            for (int m = 0; m < 4; ++m) { const int row = row0 + ai * HALF + m * 16; const float gt = pre[BM + wr * 64 + fr + ai * HALF + m * 16] * FP8_SY; unsigned char* rowp = O + (size_t)row * D + col0;
#pragma unroll
                for (int bj = 0; bj < 2; ++bj) { const f32x4 v0 = (acc[ai][bj][m][0] * (1.0f / (FP8_SW * FP8_SA)) + bv[bj][0]) * gt, v1 = (acc[ai][bj][m][1] * (1.0f / (FP8_SW * FP8_SA)) + bv[bj][1]) * gt;
                    u32x2 w; w.x = pk4_fp8(v0[0], v0[1], v0[2], v0[3]); w.y = pk4_fp8(v1[0], v1[1], v1[2], v1[3]);
                    *(u32x2*)(rowp + bj * HALF) = w; } }
    }
};

struct EpiChain {
    static constexpr bool PERM = true; static constexpr int NPRE = 8;
    EpiSwiglu e1; EpiGate e2;
    __device__ __forceinline__ const float* pre_src(const Unit& u, int w) const { return u.kind ? e2.pre_src(u, w) : (w < 4 ? e1.pre_src(u, w) : nullptr); }
    __device__ __forceinline__ void operator()(const f32x4 (&acc)[2][2][4][2], const Unit& u, int wr, int wc, int fr, int fq, const LAS float* pre) const {
        if (u.kind) e2(acc, u, wr, wc, fr, fq, pre); else e1(acc, u, wr, wc, fr, fq, pre); }
};

typedef int v8i32 __attribute__((ext_vector_type(8)));
template <class Epi, class Sched, bool GATHER, bool FP8 = false>
__device__ __forceinline__ void gemm_phase(LAS unsigned char* lds, const Gemm g, const Sched& S, const Epi& E) {
    const int tid = threadIdx.x, wid = __builtin_amdgcn_readfirstlane(tid >> 6), lane = tid & 63, wr = wid >> 2, wc = wid & 3, fr = lane & 15, fq = lane >> 4;
    const int K = FP8 ? g.K : g.K * 2  , nt = K / (BK * 2);
    unsigned voffA[2], voffB[2]; int rA[2];
#pragma unroll
    for (int i = 0; i < 2; ++i) { int R, C; stage_rc(tid * 16 + i * 8192, R, C); const int Rb = Epi::PERM ? ((R & ~31) + perm32(R & 31)) : R;
        voffA[i] = GATHER ? (unsigned)(C * 2) : (unsigned)(R * K + C * 2); voffB[i] = (unsigned)(Rb * K + C * 2); rA[i] = R; }
    const size_t kstep = (size_t)(BK * 2);
    const size_t hstep = (size_t)HALF * K;
    const unsigned ldsw = (unsigned)wid * 1024u;
    const int aoff0 = lds_byte(wr * 64 + fr, fq * 8), aoff1 = aoff0 + 1024;
    const int boff0 = lds_byte(wc * 32 + fr, fq * 8), boff1 = boff0 + 1024;
    LAS unsigned* tab = (LAS unsigned*)(lds + TAB_OFF);
#define PG8_SA(b, h) (((b) * 2 + (h)) * HTB)
#define PG8_SB(b, h) ((4 + (b) * 2 + (h)) * HTB)
#define PG8_STAGE(bufoff, gbase, voff) do { _Pragma("unroll") for (int _i = 0; _i < 2; ++_i) \
        __builtin_amdgcn_global_load_lds((const unsigned*)((const char*)(gbase) + (voff)[_i]), (LAS unsigned*)(lds + (bufoff) + ldsw + _i * 8192), 16, 0, 0); } while (0)
#define PG8_STAGE_A(bufoff, gbase, h, sl) do { if constexpr (GATHER) { _Pragma("unroll") for (int _i = 0; _i < 2; ++_i) { const unsigned _ro = tab[(sl) * 256 + (h) * 128 + rA[_i]]; \
        __builtin_amdgcn_global_load_lds((const unsigned*)((const char*)(gbase) + _ro + voffA[_i]), (LAS unsigned*)(lds + (bufoff) + ldsw + _i * 8192), 16, 0, 0); } } \
        else { PG8_STAGE(bufoff, (const char*)(gbase) + (h) * hstep, voffA); } } while (0)
#define PG8_LDA(dst, b, h) do { _Pragma("unroll") for (int m = 0; m < 4; ++m) { dst[m][0] = *(const LAS bf16x8*)(lds + PG8_SA(b, h) + aoff0 + m * 2048); dst[m][1] = *(const LAS bf16x8*)(lds + PG8_SA(b, h) + aoff1 + m * 2048); } } while (0)
#define PG8_LDB(dst, b, h) do { _Pragma("unroll") for (int n = 0; n < 2; ++n) { dst[n][0] = *(const LAS bf16x8*)(lds + PG8_SB(b, h) + boff0 + n * 2048); dst[n][1] = *(const LAS bf16x8*)(lds + PG8_SB(b, h) + boff1 + n * 2048); } } while (0)
#define PG8_CAT(x) __builtin_bit_cast(v8i32, __builtin_shufflevector((x)[0], (x)[1], 0, 1, 2, 3, 4, 5, 6, 7, 8, 9, 10, 11, 12, 13, 14, 15))
#define PG8_MMA(ai, bj, At, Bt) do { __builtin_amdgcn_s_setprio(1); _Pragma("unroll") for (int m = 0; m < 4; ++m) _Pragma("unroll") for (int n = 0; n < 2; ++n) { \
        if constexpr (FP8) acc[ai][bj][m][n] = __builtin_amdgcn_mfma_scale_f32_16x16x128_f8f6f4(PG8_CAT(Bt[n]), PG8_CAT(At[m]), acc[ai][bj][m][n], 0, 0, 0, 0x7f7f7f7f, 0, 0x7f7f7f7f); \
        else { _Pragma("unroll") for (int k = 0; k < 2; ++k) acc[ai][bj][m][n] = __builtin_amdgcn_mfma_f32_16x16x32_bf16(Bt[n][k], At[m][k], acc[ai][bj][m][n], 0, 0, 0); } } \
        __builtin_amdgcn_s_setprio(0); \
        if constexpr (FP8) { _Pragma("unroll") for (int m = 0; m < 4; ++m) asm volatile("" : "+v"(acc[ai][bj][m][0]), "+v"(acc[ai][bj][m][1])); } } while (0)
#define PG8_WAIT_V(n) asm volatile("s_waitcnt vmcnt(" #n ")" ::: "memory")
#define PG8_WAIT_L(n) asm volatile("s_waitcnt lgkmcnt(" #n ")" ::: "memory")
#define PG8_BAR __builtin_amdgcn_s_barrier()
#define PG8_SCHED __builtin_amdgcn_sched_barrier(0)
#define PG8_SCHF do { if constexpr (FP8) __builtin_amdgcn_sched_barrier(0); } while (0)
    Unit cur, nxt; int ui = 0;
    if (!S.next(0, cur)) return;
    f32x4 acc[2][2][4][2];
#pragma unroll
    for (int a = 0; a < 2; ++a)
#pragma unroll
        for (int b = 0; b < 2; ++b)
#pragma unroll
            for (int m = 0; m < 4; ++m)
#pragma unroll
                for (int n = 0; n < 2; ++n) acc[a][b][m][n] = (f32x4){0.f, 0.f, 0.f, 0.f};
    bf16x8 At[4][2], B0[2][2], B1[2][2];
    const char* cA = S.a_ptr(g, cur); const char* cB = S.b_ptr(g, cur);
    if constexpr (Sched::CHAIN) { if (cur.kind) S.dep_block(cur.pm); }
    if constexpr (GATHER) {
        if (tid < 256) tab[tid] = S.row_off(cur, tid);
        WG_BAR();
    }
    PG8_STAGE(PG8_SB(0, 0), cB, voffB); PG8_STAGE(PG8_SB(0, 1), cB + hstep, voffB); PG8_STAGE_A(PG8_SA(0, 0), cA, 0, 0); PG8_STAGE_A(PG8_SA(0, 1), cA, 1, 0);
    if (wr == 1) PG8_BAR;
    PG8_WAIT_V(2); PG8_BAR;
    PG8_STAGE(PG8_SB(1, 0), cB + kstep, voffB); PG8_STAGE_A(PG8_SA(1, 0), cA + kstep, 0, 0); PG8_STAGE(PG8_SB(1, 1), cB + hstep + kstep, voffB);
    PG8_WAIT_V(6); PG8_BAR;
    for (;;) {
        const bool has_next = S.next(ui + 1, nxt);
        const int sc = ui & 1, sn = has_next ? ((ui + 1) & 1) : sc;
        if constexpr (GATHER) { if (has_next && tid < 256) tab[sn * 256 + tid] = S.row_off(nxt, tid); }
        const char* nA = has_next ? S.a_ptr(g, nxt) : cA; const char* nB = has_next ? S.b_ptr(g, nxt) : cB;
        if constexpr (Epi::NPRE > 0) { const float* src = E.pre_src(cur, wid);
            if (src) __builtin_amdgcn_global_load_lds((const unsigned*)(src + lane), (LAS unsigned*)(lds + PRE_OFF + sc * 2048 + wid * 256), 4, 0, 0); }
        bool dep = false;
        if constexpr (Sched::CHAIN) { dep = has_next && nxt.kind;
            if (dep) __builtin_amdgcn_global_load_lds((const unsigned*)(S.cnt + nxt.pm), (LAS unsigned*)(lds + DEP_OFF + wid * 256), 4, 0, 16); }
        for (int t = 0; t < nt; t += 2) {
            const bool last = (t == nt - 2);
            if constexpr (Sched::CHAIN) { if (last && dep) { if (__builtin_amdgcn_readfirstlane(*(const LAS unsigned*)(lds + DEP_OFF + wid * 256 + lane * 4)) < 64u) S.dep_block(nxt.pm); } }
            const char* a1 = cA + (size_t)(t + 1) * kstep;
            const char* a2 = last ? nA : cA + (size_t)(t + 2) * kstep; const char* b2 = last ? nB : cB + (size_t)(t + 2) * kstep;
            const char* a3 = a2 + kstep; const char* b3 = b2 + kstep;
            const int s2 = last ? sn : sc;
            PG8_LDB(B0, 0, 0); PG8_LDB(B1, 0, 1); PG8_SCHED; PG8_LDA(At, 0, 0); PG8_STAGE_A(PG8_SA(1, 1), a1, 1, sc);
            PG8_WAIT_V(8); PG8_WAIT_L(0); PG8_BAR; PG8_SCHF; PG8_MMA(0, 0, At, B0); PG8_MMA(0, 1, At, B1); PG8_BAR; PG8_SCHED;
            PG8_LDA(At, 0, 1); PG8_STAGE(PG8_SB(0, 0), b2, voffB); PG8_STAGE(PG8_SB(0, 1), b2 + hstep, voffB); PG8_STAGE_A(PG8_SA(0, 0), a2, 0, s2);
            PG8_WAIT_V(8); PG8_WAIT_L(0); PG8_BAR; PG8_SCHF; PG8_MMA(1, 0, At, B0); PG8_MMA(1, 1, At, B1); PG8_BAR; PG8_SCHED;
            PG8_LDB(B0, 1, 0); PG8_LDB(B1, 1, 1); PG8_SCHED; PG8_LDA(At, 1, 0); PG8_STAGE_A(PG8_SA(0, 1), a2, 1, s2);
            PG8_WAIT_V(8); PG8_WAIT_L(0); PG8_BAR; PG8_SCHF; PG8_MMA(0, 0, At, B0); PG8_MMA(0, 1, At, B1); PG8_BAR; PG8_SCHED;
            PG8_LDA(At, 1, 1); PG8_STAGE(PG8_SB(1, 0), b3, voffB); PG8_STAGE(PG8_SB(1, 1), b3 + hstep, voffB); PG8_STAGE_A(PG8_SA(1, 0), a3, 0, s2);
            PG8_WAIT_V(8); PG8_WAIT_L(0); PG8_BAR; PG8_SCHF; PG8_MMA(1, 0, At, B0); PG8_MMA(1, 1, At, B1); PG8_BAR; PG8_SCHED;
        }
        if (wr == 0) PG8_BAR;
        E(acc, cur, wr, wc, fr, fq, (const LAS float*)(lds + PRE_OFF + sc * 2048));
        if constexpr (Sched::CHAIN) { if (!cur.kind) { asm volatile("s_waitcnt vmcnt(0)" ::: "memory");
            if (lane == 0) __hip_atomic_fetch_add(S.cnt + cur.pm, 1u, __ATOMIC_RELAXED, __HIP_MEMORY_SCOPE_AGENT); } }
        if (!has_next) break;
#pragma unroll
        for (int a = 0; a < 2; ++a)
#pragma unroll
            for (int b = 0; b < 2; ++b)
#pragma unroll
                for (int m = 0; m < 4; ++m)
#pragma unroll
                    for (int n = 0; n < 2; ++n) acc[a][b][m][n] = (f32x4){0.f, 0.f, 0.f, 0.f};
        cur = nxt; cA = nA; cB = nB; ++ui;
        if (wr == 1) PG8_BAR;
    }
    PG8_WAIT_V(0);
    PG8_BAR;
#undef PG8_SA
#undef PG8_SB
#undef PG8_STAGE
#undef PG8_STAGE_A
#undef PG8_LDA
#undef PG8_LDB
#undef PG8_MMA
#undef PG8_CAT
#undef PG8_WAIT_V
#undef PG8_WAIT_L
#undef PG8_BAR
#undef PG8_SCHED
#undef PG8_SCHF
}
}

#define XB_TMO      128
#define XB_XCNT(j)  (256  + 64 * (j))
#define XB_XSUB(j)  (1280 + 64 * (j))
#define XB_XGEN(j)  (2304 + 64 * (j))
#define XB_TOP      3328
#define XB_TOPGEN   3392
#define XCD_BAR_WORDS 3456
#define XB_SPIN_CAP (1u << 18)
__device__ __forceinline__ unsigned xb_ld(unsigned* p)              { return __hip_atomic_load(p, __ATOMIC_RELAXED, __HIP_MEMORY_SCOPE_AGENT); }
__device__ __forceinline__ unsigned xb_add(unsigned* p, unsigned v) { return __hip_atomic_fetch_add(p, v, __ATOMIC_RELAXED, __HIP_MEMORY_SCOPE_AGENT); }
__device__ __forceinline__ unsigned xb_xcc_id() { return (unsigned)__builtin_amdgcn_s_getreg((3 << 11) | 20) & 0xFu; }
#define XB_SPIN(cond, bar) do { unsigned _sp = 0; while (cond) { __builtin_amdgcn_s_sleep(1); \
    if ((++_sp & 255u) == 0u) { if (xb_ld(&(bar)[XB_TMO])) break; if (_sp > XB_SPIN_CAP) { atomicAdd(&(bar)[XB_TMO], 1u); break; } } } } while (0)
struct XcdBarrier { unsigned* bar; unsigned x; volatile LAS unsigned* st; };
__device__ __forceinline__ XcdBarrier xcd_barrier_post(unsigned* bar, volatile LAS unsigned* st) {
    XcdBarrier b; b.bar = bar; b.x = xb_xcc_id(); b.st = st;
    if (threadIdx.x == 0) (void)xb_add(&bar[XB_XCNT(b.x)], 1u);
    return b;
}
__device__ __forceinline__ void xcd_barrier_complete(unsigned* bar, unsigned x, unsigned& nloc, unsigned& nx) {
    const unsigned G = gridDim.x * gridDim.y * gridDim.z;
    unsigned sum, cnt, mine, sp = 0u;
    for (;;) {
        sum = 0u; cnt = 0u; mine = 0u;
#pragma unroll
        for (unsigned j = 0; j < 16; ++j) { const unsigned c = xb_ld(&bar[XB_XCNT(j)]); sum += c; cnt += (c > 0u) ? 1u : 0u; mine = (j == x) ? c : mine; }
        if (sum == G) break;
        __builtin_amdgcn_s_sleep(1);
        if ((++sp & 255u) == 0u) { if (xb_ld(&bar[XB_TMO])) break; if (sp > XB_SPIN_CAP) { atomicAdd(&bar[XB_TMO], 1u); break; } }
    }
    nloc = mine > 0u ? mine : 1u; nx = cnt > 0u ? cnt : 1u;
}
__device__ __forceinline__ void xcd_barrier(const XcdBarrier& b) {
    asm volatile("s_waitcnt vmcnt(0)" ::: "memory");
    __syncthreads();
    if (threadIdx.x == 0) {
        unsigned* bar = b.bar;
        __builtin_amdgcn_s_waitcnt(0);
        unsigned nloc = b.st[0], nx = b.st[1];
        if (nloc == 0u) { xcd_barrier_complete(bar, b.x, nloc, nx); b.st[0] = nloc; b.st[1] = nx; }
        const unsigned old = xb_add(&bar[XB_XSUB(b.x)], 1u);
        const unsigned gen = old / nloc;
        if (old + 1u == (gen + 1u) * nloc) {
            __builtin_amdgcn_fence(__ATOMIC_RELEASE, "agent");
            asm volatile("s_waitcnt vmcnt(0)" ::: "memory");
            const unsigned og = xb_add(&bar[XB_TOP], 1u);
            const unsigned tg = og / nx;
            if (og + 1u == (tg + 1u) * nx) xb_add(&bar[XB_TOPGEN], 1u);
            else XB_SPIN(xb_ld(&bar[XB_TOPGEN]) == tg, bar);
            __builtin_amdgcn_fence(__ATOMIC_ACQUIRE, "agent");
            xb_add(&bar[XB_XGEN(b.x)], 1u);
            asm volatile("s_waitcnt vmcnt(0)" ::: "memory");
        } else {
            XB_SPIN(xb_ld(&bar[XB_XGEN(b.x)]) == gen, bar);
            __builtin_amdgcn_fence(__ATOMIC_ACQUIRE, "agent");
            asm volatile("s_waitcnt vmcnt(0)" ::: "memory");
        }
    }
    __syncthreads();
}

struct Args {
    const float* in[31]; float* out; unsigned char* ws;
    int ph_lo, ph_hi, li, pad;
};
enum { I_X = 0, I_N1G, I_WIN, I_SLNG, I_SLNB, I_SGUW, I_SGUB, I_MURKV, I_MUWAG, I_W0, I_W1, I_W2, I_A0, I_A1, I_A2, I_G1, I_G2, I_KK, I_KA, I_RK, I_LNXG, I_LNXB, I_WOUT, I_N2G, I_RW, I_RB,
       I_MW1, I_MB1, I_MW2, I_MB2, I_FG };

struct Ctx { LAS unsigned char* lds; int tid, lane, wave, G, vcu; unsigned char* ws; const float* const* in; };

template <int KS> __device__ __forceinline__ void mma_nt(f32x4& acc, const LAS bf16_t* X, int ldx, const LAS bf16_t* Y, int ldy, int lane) {
    const LAS bf16_t* xp = X + (lane & 15) * ldx + 8 * (lane >> 4); const LAS bf16_t* yp = Y + (lane & 15) * ldy + 8 * (lane >> 4);
#pragma unroll
    for (int ks = 0; ks < KS; ++ks) { const bf16x8 a = *(const LAS bf16x8*)(xp + 32 * ks), b = *(const LAS bf16x8*)(yp + 32 * ks); acc = __builtin_amdgcn_mfma_f32_16x16x32_bf16(a, b, acc, 0, 0, 0); }
}
template <int KS> __device__ __forceinline__ void mma_nt_gx(f32x4& acc, const bf16_t* X, int ldx, const LAS bf16_t* Y, int ldy, int lane) {
    const bf16_t* xp = X + (size_t)(lane & 15) * ldx + 8 * (lane >> 4); const LAS bf16_t* yp = Y + (lane & 15) * ldy + 8 * (lane >> 4);
#pragma unroll
    for (int ks = 0; ks < KS; ++ks) { const bf16x8 a = *(const bf16x8*)(xp + 32 * ks), b = *(const LAS bf16x8*)(yp + 32 * ks); acc = __builtin_amdgcn_mfma_f32_16x16x32_bf16(a, b, acc, 0, 0, 0); }
}
__device__ __forceinline__ void st4bf(LAS bf16_t* p, const f32x4 v) { u32x2 w; w.x = pk2(v[0], v[1]); w.y = pk2(v[2], v[3]); *(LAS u32x2*)p = w; }

__device__ __forceinline__ void p0_transpose_item(const float* W, int N, bf16_t* WT, int ldo, int row_off, const float* sc, int mode, bool remap, LAS float* scr, int item, int lane) {
    const int nblk = N / 32, kb = item / nblk, nb = item % nblk, k0 = 64 * kb, n0 = 32 * nb;
#pragma unroll 8
    for (int i = 0; i < 32; ++i) { const int kk = 2 * i + (lane >> 5); float v = __builtin_nontemporal_load(W + (size_t)(k0 + kk) * N + n0 + (lane & 31));
        if (mode) { const float s = sc[k0 + kk]; v *= (mode == 1) ? s : (1.0f - s); }
        scr[kk * 33 + (lane & 31)] = v; }
    LDS_WAIT(); asm volatile("" ::: "memory");
    const int c = lane & 7;
#pragma unroll
    for (int j = 0; j < 4; ++j) { const int n = (lane >> 3) + 8 * j; const LAS float* s = scr + (8 * c) * 33 + n;
        u32x4 o; o.x = pk2(s[0 * 33], s[1 * 33]); o.y = pk2(s[2 * 33], s[3 * 33]); o.z = pk2(s[4 * 33], s[5 * 33]); o.w = pk2(s[6 * 33], s[7 * 33]);
        int orow = n0 + n; if (remap) { const int oc = orow >> 1; orow = 256 * (oc >> 7) + 128 * (orow & 1) + (oc & 127); }
        *(u32x4*)(WT + (size_t)(row_off + orow) * ldo + k0 + 8 * c) = o; }
    LDS_WAIT(); asm volatile("" ::: "memory");
}
__device__ __forceinline__ void p0_transpose_item_fp8(const float* W, int N, unsigned char* WT, int ldo, bool remap, LAS float* scr, int item, int lane) {
    const int nblk = N / 32, kb = item / nblk, nb = item % nblk, k0 = 64 * kb, n0 = 32 * nb;
    float tv[32];
#pragma unroll
    for (int i = 0; i < 32; ++i) tv[i] = __builtin_nontemporal_load(W + (size_t)(k0 + 2 * i + (lane >> 5)) * N + n0 + (lane & 31));
#pragma unroll
    for (int i = 0; i < 32; ++i) scr[(2 * i + (lane >> 5)) * 33 + (lane & 31)] = tv[i] * FP8_SW;
    LDS_WAIT(); asm volatile("" ::: "memory");
    const int c = lane & 3;
#pragma unroll
    for (int j = 0; j < 2; ++j) { const int n = (lane >> 2) + 16 * j; const LAS float* sp = scr + (16 * c) * 33 + n;
        u32x4 o; o.x = pk4_fp8(sp[0 * 33], sp[1 * 33], sp[2 * 33], sp[3 * 33]); o.y = pk4_fp8(sp[4 * 33], sp[5 * 33], sp[6 * 33], sp[7 * 33]);
        o.z = pk4_fp8(sp[8 * 33], sp[9 * 33], sp[10 * 33], sp[11 * 33]); o.w = pk4_fp8(sp[12 * 33], sp[13 * 33], sp[14 * 33], sp[15 * 33]);
        int orow = n0 + n; if (remap) { const int oc = orow >> 1; orow = 256 * (oc >> 7) + 128 * (orow & 1) + (oc & 127); }
        *(u32x4*)(WT + (size_t)orow * ldo + k0 + 16 * c) = o; }
    LDS_WAIT(); asm volatile("" ::: "memory");
}
__device__ __forceinline__ void moe_weight_phase(const Ctx& F) {
    LAS float* scr = (LAS float*)(F.lds + 4096 + F.wave * 16384);
    const int gw = F.vcu * 8 + F.wave, NGW = F.G * 8, lane = F.lane;
    unsigned char* ws = F.ws;
    constexpr int I_M1 = 16 * 64, I_M2 = 16 * 32;
    for (int it = gw; it < NEXP * (I_M1 + I_M2); it += NGW) {
        int r = it; const int e = r / (I_M1 + I_M2); r -= e * (I_M1 + I_M2);
        if (r < I_M1) p0_transpose_item_fp8(F.in[I_MW1] + (size_t)e * D * NHID, NHID, ws + WS_W1T + (size_t)e * NHID * D, D, true, scr, r, lane);
        else p0_transpose_item_fp8(F.in[I_MW2] + (size_t)e * DEXP * D, D, ws + WS_W2T + (size_t)e * D * DEXP, DEXP, false, scr, r - I_M1, lane);
    }
}
__device__ __forceinline__ void p0_prologue(const Ctx& F) {
    LAS float* scr = (LAS float*)(F.lds + F.wave * 16384);
    const int gw = F.vcu * 8 + F.wave, NGW = F.G * 8, lane = F.lane;
    unsigned char* ws = F.ws;
    bf16_t* WCAT = (bf16_t*)(ws + WS_WCAT);
    constexpr int I_WIN_N = 16 * 80, I_L64 = 16 * 2, I_L128 = 16 * 4, I_WO = 16 * 32, I_M1 = 16 * 64, I_M2 = 16 * 32, I_S64 = 1 * 16, I_S128 = 2 * 16;
    constexpr int N_SMALL = I_WIN_N + 4 * I_L64 + 2 * I_L128 + I_WO + 2 * I_S64 + I_S128;
    constexpr int NITEMS = N_SMALL;
    const float* mu_wag = F.in[I_MUWAG];
    for (int it = gw; it < NITEMS; it += NGW) {
        int r = it;
        if (r < I_WIN_N) { p0_transpose_item(F.in[I_WIN], 2560, WCAT, D, 0, nullptr, 0, false, scr, r, lane); continue; } r -= I_WIN_N;
        if (r < I_L64) { p0_transpose_item(F.in[I_W1], 64, WCAT, D, COL_LA + 0, mu_wag + 0 * D, 2, false, scr, r, lane); continue; } r -= I_L64;
        if (r < I_L64) { p0_transpose_item(F.in[I_W1], 64, WCAT, D, COL_LB + 0, mu_wag + 0 * D, 1, false, scr, r, lane); continue; } r -= I_L64;
        if (r < I_L64) { p0_transpose_item(F.in[I_A1], 64, WCAT, D, COL_LA + 64, mu_wag + 1 * D, 2, false, scr, r, lane); continue; } r -= I_L64;
        if (r < I_L64) { p0_transpose_item(F.in[I_A1], 64, WCAT, D, COL_LB + 64, mu_wag + 1 * D, 1, false, scr, r, lane); continue; } r -= I_L64;
        if (r < I_L128) { p0_transpose_item(F.in[I_G1], 128, WCAT, D, COL_LA + 128, mu_wag + 2 * D, 2, false, scr, r, lane); continue; } r -= I_L128;
        if (r < I_L128) { p0_transpose_item(F.in[I_G1], 128, WCAT, D, COL_LB + 128, mu_wag + 2 * D, 1, false, scr, r, lane); continue; } r -= I_L128;
        if (r < I_WO) { p0_transpose_item(F.in[I_WOUT], D, (bf16_t*)(ws + WS_WOUT), D, 0, nullptr, 0, false, scr, r, lane); continue; } r -= I_WO;
        if (r < I_S64) { p0_transpose_item(F.in[I_W2], 512, (bf16_t*)(ws + WS_LW2), 64, 0, nullptr, 0, false, scr, r, lane); continue; } r -= I_S64;
        if (r < I_S64) { p0_transpose_item(F.in[I_A2], 512, (bf16_t*)(ws + WS_LA2), 64, 0, nullptr, 0, false, scr, r, lane); continue; } r -= I_S64;
        p0_transpose_item(F.in[I_G2], 512, (bf16_t*)(ws + WS_LG2), 128, 0, nullptr, 0, false, scr, r, lane);
    }
    const int gt = F.vcu * 512 + F.tid, NGT = F.G * 512;
    { bf16_t* SW = (bf16_t*)(ws + WS_SGUW); const float* w = F.in[I_SGUW];
      for (int i = gt; i < 8 * 128 * 128; i += NGT) { const int qi = (i >> 7) & 127, kj = i & 127; SW[i] = (bf16_t)(((kj >> 6) <= (qi >> 6)) ? f2bf(w[i]) : 0u); } }
    { float* RW = (float*)(ws + WS_RW); const float* w = F.in[I_RW]; const float* g = F.in[I_N2G];
      for (int i = gt; i < D * NEXP; i += NGT) RW[i] = w[i] * g[i >> 5]; }
    { int* rt = (int*)(ws + WS_ROWTOK); float* rg = (float*)(ws + WS_ROWGATE);
      for (int i = gt; i < MAXROWS; i += NGT) { rt[i] = 0; rg[i] = 0.f; } }
    { const float* g1 = F.in[I_N1G]; f32x4 gv[4];
#pragma unroll
      for (int j = 0; j < 4; ++j) gv[j] = *((const f32x4*)g1 + lane + 64 * j);
      for (int m = gw; m < M; m += NGW) {
          const f32x4* xr = (const f32x4*)(F.in[I_X] + (size_t)m * D) + lane; f32x4 v[4]; float s = 0.f;
#pragma unroll
          for (int j = 0; j < 4; ++j) { v[j] = __builtin_nontemporal_load(xr + 64 * j); s += (v[j].x * v[j].x + v[j].y * v[j].y) + (v[j].z * v[j].z + v[j].w * v[j].w); }
          const float rstd = __builtin_amdgcn_rsqf(wave_sum(s) * (1.0f / D) + 1e-5f);
          u32x2* o8 = (u32x2*)((bf16_t*)(ws + WS_XN) + (size_t)m * D) + lane;
#pragma unroll
          for (int j = 0; j < 4; ++j) { u32x2 w; w.x = pk2(v[j].x * rstd * gv[j].x, v[j].y * rstd * gv[j].y); w.y = pk2(v[j].z * rstd * gv[j].z, v[j].w * rstd * gv[j].w); o8[64 * j] = w; }
      } }
}

#define LB() do { asm volatile("s_waitcnt lgkmcnt(0)" ::: "memory"); __builtin_amdgcn_s_barrier(); asm volatile("" ::: "memory"); } while (0)
typedef short v4i16_t __attribute__((ext_vector_type(4)));
__device__ __forceinline__ bf16x8 tr_frag(const LAS bf16_t* base, int ld, int lane) {
    const LAS bf16_t* a = base + (8 * (lane >> 4) + ((lane & 15) >> 2)) * ld + 4 * (lane & 3);
    const v4i16_t lo = __builtin_amdgcn_ds_read_tr16_b64_v4i16((LAS v4i16_t*)a), hi = __builtin_amdgcn_ds_read_tr16_b64_v4i16((LAS v4i16_t*)(a + 4 * ld));
    return __builtin_shufflevector(lo, hi, 0, 1, 2, 3, 4, 5, 6, 7);
}
template <int KS> __device__ __forceinline__ void mma_tx(f32x4& acc, const LAS bf16_t* XR, int ldx, const LAS bf16_t* Y, int ldy, int lane) {
    const LAS bf16_t* yp = Y + (lane & 15) * ldy + 8 * (lane >> 4);
#pragma unroll
    for (int ks = 0; ks < KS; ++ks) { const bf16x8 a = tr_frag(XR + 32 * ks * ldx, ldx, lane), b = *(const LAS bf16x8*)(yp + 32 * ks); acc = __builtin_amdgcn_mfma_f32_16x16x32_bf16(a, b, acc, 0, 0, 0); }
}
template <int KS> __device__ __forceinline__ void mma_ty(f32x4& acc, const LAS bf16_t* X, int ldx, const LAS bf16_t* YR, int ldy, int lane) {
    const LAS bf16_t* xp = X + (lane & 15) * ldx + 8 * (lane >> 4);
#pragma unroll
    for (int ks = 0; ks < KS; ++ks) { const bf16x8 a = *(const LAS bf16x8*)(xp + 32 * ks), b = tr_frag(YR + 32 * ks * ldy, ldy, lane); acc = __builtin_amdgcn_mfma_f32_16x16x32_bf16(a, b, acc, 0, 0, 0); }
}
template <int KS> __device__ __forceinline__ void mma_rx(f32x4& acc, const bf16x8 (&xf)[KS], const LAS bf16_t* Y, int ldy, int lane) {
    const LAS bf16_t* yp = Y + (lane & 15) * ldy + 8 * (lane >> 4);
#pragma unroll
    for (int ks = 0; ks < KS; ++ks) { const bf16x8 b = *(const LAS bf16x8*)(yp + 32 * ks); acc = __builtin_amdgcn_mfma_f32_16x16x32_bf16(xf[ks], b, acc, 0, 0, 0); }
}

__device__ __forceinline__ void sgu_phase(const Ctx& F) {
    const int w = F.wave;
    const bf16_t* PROJ = (const bf16_t*)(F.ws + WS_PROJ); bf16_t* YCAT = (bf16_t*)(F.ws + WS_YCAT); const bf16_t* SW = (const bf16_t*)(F.ws + WS_SGUW);
    LAS bf16_t* vn = (LAS bf16_t*)F.lds;
    constexpr int LDV = 264;
    for (int unit = F.vcu; unit < 256; unit += F.G) {
        int tv_ = F.tid; asm volatile("" : "+v"(tv_)); const int lane = tv_ & 63;
        const int nb = unit >> 1, hh = unit & 1, m0 = nb * 128;
        float lg[8], lb[8];
#pragma unroll
        for (int q = 0; q < 8; ++q) { lg[q] = F.in[I_SLNG][lane * 8 + q]; lb[q] = F.in[I_SLNB][lane * 8 + q]; }
        const int hl = w >> 1, ih = w & 1, h = hh * 4 + hl;
        u32x4 raw[16];
#pragma unroll
        for (int rr = 0; rr < 16; ++rr) raw[rr] = *(const u32x4*)(PROJ + (size_t)(m0 + w * 16 + rr) * NPROJ + COL_V + lane * 8);
        bf16x8 bfr[4][4]; u32x2 ur[4][4]; float bsv[4];
#pragma unroll
        for (int ks = 0; ks < 4; ++ks)
#pragma unroll
            for (int it = 0; it < 4; ++it) bfr[ks][it] = *(const bf16x8*)(SW + (size_t)h * 16384 + (ih * 64 + it * 16 + (lane & 15)) * 128 + ks * 32 + 8 * (lane >> 4));
#pragma unroll
        for (int it = 0; it < 4; ++it) { const int i = ih * 64 + it * 16 + (lane & 15); bsv[it] = F.in[I_SGUB][h * 128 + i];
#pragma unroll
            for (int ct = 0; ct < 4; ++ct) ur[it][ct] = *(const u32x2*)(PROJ + (size_t)(m0 + i) * NPROJ + h * 64 + ct * 16 + 4 * (lane >> 4)); }
#pragma unroll
        for (int rr = 0; rr < 16; ++rr) {
            const int pos = w * 16 + rr; float v[8]; unpack8(raw[rr], v);
            float s = 0.f;
#pragma unroll
            for (int q = 0; q < 8; ++q) s += v[q];
            const float mean = wave_sum(s) * (1.0f / 512.0f); float qq = 0.f;
#pragma unroll
            for (int q = 0; q < 8; ++q) { v[q] -= mean; qq += v[q] * v[q]; }
            const float rstd = __builtin_amdgcn_rsqf(wave_sum(qq) * (1.0f / 512.0f) + 1e-5f);
            if ((lane >> 5) == hh) { float o[8];
#pragma unroll
                for (int q = 0; q < 8; ++q) o[q] = v[q] * rstd * lg[q] + lb[q];
                *(LAS u32x4*)(vn + pos * LDV + (lane & 31) * 8) = pack8(o); }
        }
        LB();
        f32x4 acc[4][4];
#pragma unroll
        for (int a = 0; a < 4; ++a)
#pragma unroll
            for (int b = 0; b < 4; ++b) acc[a][b] = (f32x4){0.f, 0.f, 0.f, 0.f};
#pragma unroll
        for (int ks = 0; ks < 4; ++ks) {
            bf16x8 af[4];
#pragma unroll
            for (int ct = 0; ct < 4; ++ct) af[ct] = tr_frag(vn + (32 * ks) * LDV + hl * 64 + ct * 16, LDV, lane);
#pragma unroll
            for (int ct = 0; ct < 4; ++ct)
#pragma unroll
                for (int it = 0; it < 4; ++it) acc[ct][it] = __builtin_amdgcn_mfma_f32_16x16x32_bf16(af[ct], bfr[ks][it], acc[ct][it], 0, 0, 0);
        }
#pragma unroll
        for (int it = 0; it < 4; ++it) { const int i = ih * 64 + it * 16 + (lane & 15); const float bs = bsv[it]; const size_t row = (size_t)(m0 + i);
#pragma unroll
            for (int ct = 0; ct < 4; ++ct) { const int c = h * 64 + ct * 16 + 4 * (lane >> 4); const u32x2 uu = ur[it][ct];
                const f32x4 a = acc[ct][it]; u32x2 o; o.x = pk2(bflo(uu.x) * (a[0] + bs), bfhi(uu.x) * (a[1] + bs)); o.y = pk2(bflo(uu.y) * (a[2] + bs), bfhi(uu.y) * (a[3] + bs));
                *(u32x2*)(YCAT + row * D + c) = o; } }
        LB();
    }
}

namespace rk {
constexpr int LD = 72, LDF = 68, LDG = 136, MBY = 64 * LD * 2;
constexpr int O_AT = 0, O_RT = MBY, O_BH = 2 * MBY, O_KH = 3 * MBY, O_V = 4 * MBY, O_TB = 5 * MBY, O_LAK = 6 * MBY, O_MRB = 7 * MBY, O_MRK = 8 * MBY,
              O_ST = 9 * MBY, O_XT = 11 * MBY, O_UT = 13 * MBY, O_WC = 15 * MBY, O_WT = O_WC + 512, O_PAR = O_WT + 2048, O_END = O_PAR + 2560;
static_assert(O_END <= MISC_OFF, "RWKV LDS map");
enum { P_MUR = 0, P_MUK, P_MUV, P_W0, P_A0, P_KK, P_KA, P_RK, P_LG, P_LB };
constexpr size_t CHB = 6 * 4096;
template <int KS> __device__ __forceinline__ void mma_txy(f32x4& acc, const LAS bf16_t* XR, int ldx, const LAS bf16_t* YR, int ldy, int lane) {
#pragma unroll
    for (int ks = 0; ks < KS; ++ks) { const bf16x8 a = tr_frag(XR + 32 * ks * ldx, ldx, lane), b = tr_frag(YR + 32 * ks * ldy, ldy, lane); acc = __builtin_amdgcn_mfma_f32_16x16x32_bf16(a, b, acc, 0, 0, 0); }
}
__device__ __forceinline__ void state_yfrags(const f32x4 (&acc)[4], bf16x8 (&yf)[2]) {
#pragma unroll
    for (int ks = 0; ks < 2; ++ks) { u32x4 wv; wv.x = pk2(acc[2 * ks][0], acc[2 * ks][1]); wv.y = pk2(acc[2 * ks][2], acc[2 * ks][3]); wv.z = pk2(acc[2 * ks + 1][0], acc[2 * ks + 1][1]); wv.w = pk2(acc[2 * ks + 1][2], acc[2 * ks + 1][3]);
        yf[ks] = __builtin_bit_cast(bf16x8, wv); }
}
__device__ __forceinline__ void load_xfrags(u32x2 (&xr)[4][2][2], const bf16_t* mt, int ldm, int lane) {
#pragma unroll
    for (int ct = 0; ct < 4; ++ct)
#pragma unroll
        for (int ks = 0; ks < 2; ++ks)
#pragma unroll
            for (int hf = 0; hf < 2; ++hf) xr[ct][ks][hf] = *(const u32x2*)(mt + (size_t)(16 * ct + (lane & 15)) * ldm + 32 * ks + 16 * hf + 4 * (lane >> 4));
}
__device__ __forceinline__ void load_xfrags_lds(u32x2 (&xr)[4][2][2], const LAS bf16_t* mt, int ldm, int lane) {
#pragma unroll
    for (int ct = 0; ct < 4; ++ct)
#pragma unroll
        for (int ks = 0; ks < 2; ++ks)
#pragma unroll
            for (int hf = 0; hf < 2; ++hf) xr[ct][ks][hf] = *(const LAS u32x2*)(mt + (16 * ct + (lane & 15)) * ldm + 32 * ks + 16 * hf + 4 * (lane >> 4));
}
__device__ __forceinline__ void state_step(f32x4 (&acc)[4], const u32x2 (&xr)[4][2][2]) {
    bf16x8 yf[2]; state_yfrags(acc, yf);
#pragma unroll
    for (int ct = 0; ct < 4; ++ct) { f32x4 d = (f32x4){0.f, 0.f, 0.f, 0.f};
#pragma unroll
        for (int ks = 0; ks < 2; ++ks) { u32x4 xw; xw.x = xr[ct][ks][0].x; xw.y = xr[ct][ks][0].y; xw.z = xr[ct][ks][1].x; xw.w = xr[ct][ks][1].y;
            d = __builtin_amdgcn_mfma_f32_16x16x32_bf16(__builtin_bit_cast(bf16x8, xw), yf[ks], d, 0, 0, 0); }
        acc[ct] = d; }
}
__device__ __forceinline__ f32x4 bf4(const u32x2 w) { return (f32x4){bflo(w.x), bfhi(w.x), bflo(w.y), bfhi(w.y)}; }
__device__ __forceinline__ int frag_off(int row, int col) { return (((row >> 4) * 64 + ((col >> 2) & 3) * 16 + (row & 15)) * 4 + (col >> 4)) * 4 + (col & 3); }
}

__device__ __forceinline__ void rwkv_prep_unit(const Ctx& F, int unit) {
    using namespace rk;
    const int w = F.wave;
    const int b = unit >> 7, h = (unit >> 4) & 7, seg = unit & 15;
    constexpr int NL = 4;
    LAS unsigned char* L = F.lds;
    LAS bf16_t *AT = (LAS bf16_t*)(L + O_AT), *RT = (LAS bf16_t*)(L + O_RT), *BH = (LAS bf16_t*)(L + O_BH), *KH = (LAS bf16_t*)(L + O_KH), *V = (LAS bf16_t*)(L + O_V), *TB = (LAS bf16_t*)(L + O_TB),
                *LAK = (LAS bf16_t*)(L + O_LAK), *MRB = (LAS bf16_t*)(L + O_MRB), *MRK = (LAS bf16_t*)(L + O_MRK), *ST = (LAS bf16_t*)(L + O_ST), *XT = (LAS bf16_t*)(L + O_XT), *UT = (LAS bf16_t*)(L + O_UT);
    LAS bf16_t *DECP = ST, *ICLP = ST + 64 * LD, *LW = XT, *LA = XT + 64 * LD, *BT = XT, *KT = XT + 64 * LD, *LG = UT, *AH = ST, *XL = ST + 64 * LD, *UL = XT, *PHL = UT, *PSL = UT + 64 * LD;
    LAS float *LF = (LAS float*)(L + O_ST), *TF = (LAS float*)(L + O_XT), *TMP = (LAS float*)(L + O_UT), *WC = (LAS float*)(L + O_WC), *WT = (LAS float*)(L + O_WT), *PAR = (LAS float*)(L + O_PAR);
    const bf16_t* PROJ = (const bf16_t*)(F.ws + WS_PROJ);
    bf16_t* SEGP = (bf16_t*)(F.ws + WS_SEGP); float* SEGQ = (float*)(F.ws + WS_SEGQ);
    bf16_t *PHIT = (bf16_t*)(F.ws + WS_PHIT), *PSI = (bf16_t*)(F.ws + WS_PSI), *YSG = (bf16_t*)(F.ws + WS_YS), *YLG = (bf16_t*)(F.ws + WS_YL), *GTG = (bf16_t*)(F.ws + WS_GT), *BVG = (bf16_t*)(F.ws + WS_BV);

    { int tid = F.tid; asm volatile("" : "+v"(tid));
      for (int i = tid; i < 640; i += 512) { const int pv = i >> 6, cc = h * 64 + (i & 63); const float* src;
          switch (pv) { case P_MUR: src = F.in[I_MURKV] + 0 * 512; break; case P_MUK: src = F.in[I_MURKV] + 1 * 512; break; case P_MUV: src = F.in[I_MURKV] + 2 * 512; break; case P_W0: src = F.in[I_W0]; break;
                        case P_A0: src = F.in[I_A0]; break; case P_KK: src = F.in[I_KK]; break; case P_KA: src = F.in[I_KA]; break; case P_RK: src = F.in[I_RK]; break; case P_LG: src = F.in[I_LNXG]; break; default: src = F.in[I_LNXB]; break; }
          PAR[i] = src[cc]; }
    }
    const bf16_t* LW2 = (const bf16_t*)(F.ws + WS_LW2); const bf16_t* LA2 = (const bf16_t*)(F.ws + WS_LA2); const bf16_t* LG2 = (const bf16_t*)(F.ws + WS_LG2);

    f32x4 acc[4];
#pragma unroll
    for (int ct = 0; ct < 4; ++ct) acc[ct] = (f32x4){0.f, 0.f, 0.f, 0.f};
    if (w < 4) { int tv0_ = F.tid; asm volatile("" : "+v"(tv0_)); const int lane = tv0_ & 63;
#pragma unroll
        for (int ct = 0; ct < 4; ++ct)
#pragma unroll
            for (int r = 0; r < 4; ++r) acc[ct][r] = (16 * ct + 4 * (lane >> 4) + r == 16 * w + (lane & 15)) ? 1.0f : 0.0f; }
    LB();

    u32x4 rw_c[3 + NL], rw_p[3 + NL];
    auto load_raw = [&](int c, int tv) {
        const int t = tv >> 3, c0 = (tv & 7) * 8, hc = h * 64 + c0; const int tq0 = (seg * SEGC + c) * CH;
        const bf16_t* rowc = PROJ + ((size_t)b * SEQ + tq0 + t) * NPROJ; const bool hasp = (tq0 + t) > 0; const bf16_t* rowp = hasp ? rowc - NPROJ : rowc;
        rw_c[0] = *(const u32x4*)(rowc + COL_R + hc); rw_c[1] = *(const u32x4*)(rowc + COL_K + hc); rw_c[2] = *(const u32x4*)(rowc + COL_VR + hc);
        rw_p[0] = *(const u32x4*)(rowp + COL_R + hc); rw_p[1] = *(const u32x4*)(rowp + COL_K + hc); rw_p[2] = *(const u32x4*)(rowp + COL_VR + hc);
#pragma unroll
        for (int q4 = 0; q4 < NL; ++q4) { rw_c[3 + q4] = *(const u32x4*)(rowc + COL_LA + q4 * 64 + c0); rw_p[3 + q4] = *(const u32x4*)(rowp + COL_LB + q4 * 64 + c0); }
    };
    bf16x8 fW[2], fA[2], fG[4];
    { int tvw_ = F.tid; asm volatile("" : "+v"(tvw_)); const int g_ = (tvw_ & 63) >> 4, ln_ = tvw_ & 15; const size_t row = (size_t)(h * 64 + (w & 3) * 16 + ln_);
#pragma unroll
      for (int ks = 0; ks < 2; ++ks) { fW[ks] = *(const bf16x8*)(LW2 + row * 64 + 32 * ks + 8 * g_); fA[ks] = *(const bf16x8*)(LA2 + row * 64 + 32 * ks + 8 * g_); }
#pragma unroll
      for (int ks = 0; ks < 4; ++ks) fG[ks] = *(const bf16x8*)(LG2 + row * 128 + 32 * ks + 8 * g_); }
    { int tv0_ = F.tid; asm volatile("" : "+v"(tv0_)); load_raw(0, tv0_); }

    for (int c = 0; c < SEGC; ++c) {
        int tv_ = F.tid; asm volatile("" : "+v"(tv_));
        const int lane = tv_ & 63, t = tv_ >> 3, cg = tv_ & 7, c0 = cg * 8, g = lane >> 4, ln = lane & 15;
        const size_t cu = (size_t)((b * 8 + h) * NCHUNK + seg * SEGC + c) * CHB;
        float r_[8], k_[8], v_[8], a_[8], b_[8], ld_[8], pf_[8];
        {
            float cv[8], pv[8];
            { const unsigned km = ((seg * SEGC + c) * CH + t) > 0 ? 0xffffffffu : 0u;
#pragma unroll
              for (int i = 0; i < 3 + NL; ++i) { rw_p[i].x &= km; rw_p[i].y &= km; rw_p[i].z &= km; rw_p[i].w &= km; } }
            unpack8(rw_c[0], cv); unpack8(rw_p[0], pv);
#pragma unroll
            for (int q = 0; q < 8; ++q) r_[q] = cv[q] + (pv[q] - cv[q]) * PAR[P_MUR * 64 + c0 + q];
            unpack8(rw_c[1], cv); unpack8(rw_p[1], pv);
#pragma unroll
            for (int q = 0; q < 8; ++q) k_[q] = cv[q] + (pv[q] - cv[q]) * PAR[P_MUK * 64 + c0 + q];
            unpack8(rw_c[2], cv); unpack8(rw_p[2], pv);
#pragma unroll
            for (int q = 0; q < 8; ++q) v_[q] = cv[q] + (pv[q] - cv[q]) * PAR[P_MUV * 64 + c0 + q];
#pragma unroll
            for (int q4 = 0; q4 < NL; ++q4) { float o[8];
                unpack8(rw_c[3 + q4], cv); unpack8(rw_p[3 + q4], pv);
#pragma unroll
                for (int q = 0; q < 8; ++q) { const float x = cv[q] + pv[q]; o[q] = (q4 == 0) ? (1.0f - 2.0f * __builtin_amdgcn_rcpf(1.0f + __expf(2.0f * x))) : (q4 == 1 ? x : fsigmoid(x)); }
                LAS bf16_t* dst = (q4 == 0) ? (LW + t * LD + c0) : (q4 == 1) ? (LA + t * LD + c0) : (LG + t * LDG + (q4 - 2) * 64 + c0);
                *(LAS u32x4*)dst = pack8(o);
            }
        }
        LB();
        {
            const int ct = w & 3, tp = (w >> 2) * 2;
#pragma unroll
            for (int j = 0; j < 2; ++j) { const int tt = tp + j; const int so = (tt * 16 + ln) * LD + ct * 16 + 4 * g;
                f32x4 d = (f32x4){0.f, 0.f, 0.f, 0.f}; mma_rx<2>(d, fW, LW + tt * 16 * LD, LD, lane); st4bf(DECP + so, d);
                d = (f32x4){0.f, 0.f, 0.f, 0.f}; mma_rx<2>(d, fA, LA + tt * 16 * LD, LD, lane); st4bf(ICLP + so, d);
                d = (f32x4){0.f, 0.f, 0.f, 0.f}; mma_rx<4>(d, fG, LG + tt * 16 * LDG, LDG, lane);
                u32x2 gw; gw.x = pk2(d[0], d[1]); gw.y = pk2(d[2], d[3]); *(u32x2*)(GTG + cu + frag_off(tt * 16 + ln, ct * 16 + 4 * g)) = gw; }
        }
        LB();
        {
            float dp[8], ip[8]; unpack8(*(const LAS u32x4*)(DECP + t * LD + c0), dp); unpack8(*(const LAS u32x4*)(ICLP + t * LD + c0), ip);
            float kk[8], ss = 0.f, bonus = 0.f;
#pragma unroll
            for (int q = 0; q < 8; ++q) {
                const float xw = dp[q] + PAR[P_W0 * 64 + c0 + q]; const float z = -xw;
                const float sp = fmaxf(z, 0.f) + __logf(1.0f + __expf(-fabsf(z)));
                const float wl = -sp - 0.5f; ld_[q] = -__expf(wl);
                ip[q] = fsigmoid(ip[q] + PAR[P_A0 * 64 + c0 + q]);
                kk[q] = k_[q] * PAR[P_KK * 64 + c0 + q]; ss += kk[q] * kk[q];
            }
            ss += __shfl_xor(ss, 1); ss += __shfl_xor(ss, 2); ss += __shfl_xor(ss, 4);
            const float inv = __builtin_amdgcn_rsqf(fmaxf(ss, 1e-24f));
#pragma unroll
            for (int q = 0; q < 8; ++q) { kk[q] *= inv; k_[q] = k_[q] * (1.0f + (ip[q] - 1.0f) * PAR[P_KA * 64 + c0 + q]); a_[q] = -kk[q]; b_[q] = kk[q] * ip[q];
                bonus += r_[q] * k_[q] * PAR[P_RK * 64 + c0 + q]; }
            bonus += __shfl_xor(bonus, 1); bonus += __shfl_xor(bonus, 2); bonus += __shfl_xor(bonus, 4);
            { float o[8];
#pragma unroll
              for (int q = 0; q < 8; ++q) o[q] = bonus * v_[q];
              const u32x4 pw = pack8(o); u32x2 lo_, hi_; lo_.x = pw.x; lo_.y = pw.y; hi_.x = pw.z; hi_.y = pw.w;
              *(u32x2*)(BVG + cu + frag_off(t, c0)) = lo_; *(u32x2*)(BVG + cu + frag_off(t, c0 + 4)) = hi_; }
#pragma unroll
            for (int q = 0; q < 8; ++q) { float x = ld_[q];
#pragma unroll
                for (int dsh = 8; dsh < 64; dsh <<= 1) { const float y = __shfl_up(x, dsh); x += (lane >= dsh) ? y : 0.f; }
                pf_[q] = x; }
            if ((lane >> 3) == 7) { *(LAS f32x4*)(WT + w * 64 + c0) = (f32x4){pf_[0], pf_[1], pf_[2], pf_[3]}; *(LAS f32x4*)(WT + w * 64 + c0 + 4) = (f32x4){pf_[4], pf_[5], pf_[6], pf_[7]}; }
        }
        LB();
        REP(16) {
        {
            float off[8], tot[8];
#pragma unroll
            for (int q = 0; q < 8; ++q) { off[q] = 0.f; tot[q] = 0.f; }
#pragma unroll
            for (int ww = 0; ww < 8; ++ww) { const f32x4 x0 = *(const LAS f32x4*)(WT + ww * 64 + c0), x1 = *(const LAS f32x4*)(WT + ww * 64 + c0 + 4); const float m = (ww < w) ? 1.0f : 0.0f;
#pragma unroll
                for (int q = 0; q < 4; ++q) { tot[q] += x0[q]; tot[q + 4] += x1[q]; off[q] += m * x0[q]; off[q + 4] += m * x1[q]; } }
            float o1[8], o2[8], o3[8], o4[8], o5[8], o6[8];
#pragma unroll
            for (int q = 0; q < 8; ++q) { const float cu_ = pf_[q] + off[q]; const float ec = __expf(cu_), en = __builtin_amdgcn_rcpf(ec), wc = __expf(tot[q]), er = wc * en;
                o1[q] = a_[q] * __expf(cu_ - ld_[q]); o2[q] = r_[q] * ec; o3[q] = b_[q] * en; o4[q] = k_[q] * en; o5[q] = b_[q] * er; o6[q] = k_[q] * er;
                if (t == 63) WC[c0 + q] = wc; }
            *(LAS u32x4*)(AT + t * LD + c0) = pack8(o1); *(LAS u32x4*)(RT + t * LD + c0) = pack8(o2); *(LAS u32x4*)(BT + t * LD + c0) = pack8(o3); *(LAS u32x4*)(KT + t * LD + c0) = pack8(o4);
            *(LAS u32x4*)(BH + t * LD + c0) = pack8(o5); *(LAS u32x4*)(KH + t * LD + c0) = pack8(o6); *(LAS u32x4*)(V + t * LD + c0) = pack8(v_);
        }
        LB();
        {
            const int tt = w & 3, ip0 = (w >> 2) * 2;
#pragma unroll
            for (int j = 0; j < 2; ++j) { const int it = ip0 + j; const int i0 = it * 16 + 4 * g, tq = tt * 16 + ln;
                f32x4 d0 = (f32x4){0.f, 0.f, 0.f, 0.f}, d1 = d0, d2 = d0, d3 = d0;
                if (it <= tt) {
                    mma_nt<2>(d0, BT + it * 16 * LD, LD, AT + tt * 16 * LD, LD, lane); mma_nt<2>(d1, KT + it * 16 * LD, LD, AT + tt * 16 * LD, LD, lane);
                    mma_nt<2>(d2, BT + it * 16 * LD, LD, RT + tt * 16 * LD, LD, lane); mma_nt<2>(d3, KT + it * 16 * LD, LD, RT + tt * 16 * LD, LD, lane);
                    if (it == tt) {
#pragma unroll
                        for (int r = 0; r < 4; ++r) { const int i = i0 + r; if (!(i < tq)) { d0[r] = 0.f; d1[r] = 0.f; } if (!(i <= tq)) { d2[r] = 0.f; d3[r] = 0.f; } } }
                }
                *(LAS f32x4*)(LF + tq * LDF + i0) = d0; st4bf(LAK + tq * LD + i0, d1); st4bf(MRB + tq * LD + i0, d2); st4bf(MRK + tq * LD + i0, d3); }
        }
        LB();
        }
        load_raw(c + 1 < SEGC ? c + 1 : c, tv_);
        REP(14) {
        if (w == 0) { const int bk = lane >> 4, j = lane & 15; float x[16];
            const LAS float* Lb = LF + (16 * bk) * LDF + 16 * bk; LAS float* Tb = TF + (16 * bk) * LDF + 16 * bk + j;
            f32x4 ra[4], rb[4];
#pragma unroll
            for (int q = 0; q < 4; ++q) ra[q] = *(const LAS f32x4*)(Lb + 1 * LDF + 4 * q);
            x[0] = (j == 0) ? 1.0f : 0.0f; Tb[0] = x[0];
#pragma unroll
            for (int tr = 1; tr < 16; ++tr) {
                f32x4 (&cur)[4] = (tr & 1) ? ra : rb; f32x4 (&nxt)[4] = (tr & 1) ? rb : ra;
                if (tr < 15) {
#pragma unroll
                    for (int q = 0; q < 4; ++q) nxt[q] = *(const LAS f32x4*)(Lb + (tr + 1) * LDF + 4 * q); }
                float s0 = (tr == j) ? 1.0f : 0.0f, s1 = 0.f;
#pragma unroll
                for (int i = 0; i < tr; ++i) { if (i & 1) s1 += cur[i >> 2][i & 3] * x[i]; else s0 += cur[i >> 2][i & 3] * x[i]; }
                x[tr] = s0 + s1; Tb[tr * LDF] = x[tr]; } }
        LB();
        if (w < 2) { const int p = w, lr = lane & 15, lk = lane >> 4; f32x4 d = (f32x4){0.f, 0.f, 0.f, 0.f};
#pragma unroll
            for (int ks = 0; ks < 4; ++ks) d = __builtin_amdgcn_mfma_f32_16x16x4f32(LF[(32 * p + 16 + lr) * LDF + 32 * p + 4 * ks + lk], TF[(32 * p + 4 * ks + lk) * LDF + 32 * p + lr], d, 0, 0, 0);
#pragma unroll
            for (int r = 0; r < 4; ++r) TMP[(32 * p + 16 + 4 * lk + r) * LDF + 32 * p + lr] = d[r];
            LDS_WAIT(); f32x4 e = (f32x4){0.f, 0.f, 0.f, 0.f};
#pragma unroll
            for (int ks = 0; ks < 4; ++ks) e = __builtin_amdgcn_mfma_f32_16x16x4f32(TF[(32 * p + 16 + lr) * LDF + 32 * p + 16 + 4 * ks + lk], TMP[(32 * p + 16 + 4 * ks + lk) * LDF + 32 * p + lr], e, 0, 0, 0);
#pragma unroll
            for (int r = 0; r < 4; ++r) TF[(32 * p + 16 + 4 * lk + r) * LDF + 32 * p + lr] = e[r]; }
        LB();
        if (w < 4) { const int ri = w >> 1, cj = w & 1, lr = lane & 15, lk = lane >> 4; f32x4 d = (f32x4){0.f, 0.f, 0.f, 0.f};
#pragma unroll
            for (int ks = 0; ks < 8; ++ks) { const int k = 4 * ks + lk; const float bb = ((k >> 4) >= cj) ? TF[k * LDF + 16 * cj + lr] : 0.0f;
                d = __builtin_amdgcn_mfma_f32_16x16x4f32(LF[(32 + 16 * ri + lr) * LDF + k], bb, d, 0, 0, 0); }
#pragma unroll
            for (int r = 0; r < 4; ++r) TMP[(32 + 16 * ri + 4 * lk + r) * LDF + 16 * cj + lr] = d[r]; }
        LB();
        if (w < 4) { const int ri = w >> 1, cj = w & 1, lr = lane & 15, lk = lane >> 4; f32x4 d = (f32x4){0.f, 0.f, 0.f, 0.f};
#pragma unroll
            for (int ks = 0; ks < 8; ++ks) { const int k = 4 * ks + lk; const float aa = (ri >= (k >> 4)) ? TF[(32 + 16 * ri + lr) * LDF + 32 + k] : 0.0f;
                d = __builtin_amdgcn_mfma_f32_16x16x4f32(aa, TMP[(32 + k) * LDF + 16 * cj + lr], d, 0, 0, 0); }
#pragma unroll
            for (int r = 0; r < 4; ++r) TF[(32 + 16 * ri + 4 * lk + r) * LDF + 16 * cj + lr] = d[r]; }
        LB();
        { float o[8];
#pragma unroll
          for (int q = 0; q < 8; ++q) { const int i = c0 + q; o[q] = ((i >> 4) <= (t >> 4)) ? TF[t * LDF + i] : 0.0f; }
          *(LAS u32x4*)(TB + t * LD + c0) = pack8(o); }
        LB();
        }
        const int tt = w & 3, pr = (w >> 2) * 2;
        REP(15) {
#pragma unroll
        for (int j = 0; j < 2; ++j) { const int mt = pr + j; const int so = (tt * 16 + ln) * LD + mt * 16 + 4 * g;
            f32x4 d = (f32x4){0.f, 0.f, 0.f, 0.f}; mma_tx<2>(d, AT + 16 * mt, LD, TB + tt * 16 * LD, LD, lane); st4bf(AH + so, d);
            d = (f32x4){0.f, 0.f, 0.f, 0.f}; mma_tx<2>(d, V + 16 * mt, LD, LAK + tt * 16 * LD, LD, lane); st4bf(XL + so, d); }
        LB();
#pragma unroll
        for (int j = 0; j < 2; ++j) { const int mt = pr + j; const int so = (tt * 16 + ln) * LD + mt * 16 + 4 * g;
            f32x4 d = (f32x4){0.f, 0.f, 0.f, 0.f}; mma_tx<2>(d, XL + 16 * mt, LD, TB + tt * 16 * LD, LD, lane); st4bf(UL + so, d);
            d = bf4(*(const LAS u32x2*)(RT + so)); mma_tx<2>(d, AH + 16 * mt, LD, MRB + tt * 16 * LD, LD, lane);
            { u32x2 o; o.x = pk2(d[0], d[1]); o.y = pk2(d[2], d[3]); *(u32x2*)(YSG + cu + frag_off(tt * 16 + ln, mt * 16 + 4 * g)) = o; }
            d = (f32x4){0.f, 0.f, 0.f, 0.f}; mma_txy<2>(d, AH + 16 * mt, LD, BH + 16 * tt, LD, lane);
            { const f32x4 wc4 = *(const LAS f32x4*)(WC + mt * 16 + 4 * g);
#pragma unroll
              for (int r = 0; r < 4; ++r) d[r] += (mt * 16 + 4 * g + r == tt * 16 + ln) ? wc4[r] : 0.0f;
              u32x2 o; o.x = pk2(d[0], d[1]); o.y = pk2(d[2], d[3]); *(LAS u32x2*)(PHL + so) = o; } }
        LB();
#pragma unroll
        for (int j = 0; j < 2; ++j) { const int mt = pr + j; const int so = (tt * 16 + ln) * LD + mt * 16 + 4 * g;
            f32x4 d = (f32x4){0.f, 0.f, 0.f, 0.f}; mma_txy<2>(d, BH + 16 * mt, LD, UL + 16 * tt, LD, lane); mma_txy<2>(d, KH + 16 * mt, LD, V + 16 * tt, LD, lane);
            { u32x2 o; o.x = pk2(d[0], d[1]); o.y = pk2(d[2], d[3]); *(LAS u32x2*)(PSL + so) = o; }
            d = (f32x4){0.f, 0.f, 0.f, 0.f}; mma_tx<2>(d, UL + 16 * mt, LD, MRB + tt * 16 * LD, LD, lane); mma_tx<2>(d, V + 16 * mt, LD, MRK + tt * 16 * LD, LD, lane);
            { u32x2 o; o.x = pk2(d[0], d[1]); o.y = pk2(d[2], d[3]); *(u32x2*)(YLG + cu + frag_off(tt * 16 + ln, mt * 16 + 4 * g)) = o; } }
        LB();
        }
        { u32x2 xr[4][2][2]; load_xfrags_lds(xr, PHL, LD, lane); state_step(acc, xr);
          if (w >= 4) {
#pragma unroll
              for (int ct = 0; ct < 4; ++ct) { acc[ct] += bf4(*(const LAS u32x2*)(PSL + (16 * (w - 4) + ln) * LD + 16 * ct + 4 * g));
                  u32x2 o; o.x = pk2(acc[ct][0], acc[ct][1]); o.y = pk2(acc[ct][2], acc[ct][3]); *(u32x2*)(PSI + cu + frag_off(16 * (w - 4) + ln, 16 * ct + 4 * g)) = o; }
          } else {
#pragma unroll
              for (int ct = 0; ct < 4; ++ct) { float v0 = acc[ct][0], v1 = acc[ct][1], v2 = acc[ct][2], v3 = acc[ct][3];
                  { const bool od = lane & 1; float t0 = od ? v0 : v1, t1 = od ? v2 : v3; t0 = __shfl_xor(t0, 1); t1 = __shfl_xor(t1, 1); if (od) { v0 = t0; v2 = t1; } else { v1 = t0; v3 = t1; } }
                  { const bool od = lane & 2; float t0 = od ? v0 : v2, t1 = od ? v1 : v3; t0 = __shfl_xor(t0, 2); t1 = __shfl_xor(t1, 2); if (od) { v0 = t0; v1 = t1; } else { v2 = t0; v3 = t1; } }
                  u32x2 o; o.x = pk2(v0, v1); o.y = pk2(v2, v3); *(u32x2*)(PHIT + cu + frag_off(16 * ct + 4 * g + (ln & 3), 16 * w + (ln & 12))) = o; } } }
        LB();
    }
    LB();
}

namespace rk {
struct FoldRegs { u32x2 x[4][2][2]; f32x4 q[4]; };
__device__ __forceinline__ void fold_load(FoldRegs& R, const bf16_t* RP, const bf16_t* RQ, int up, int rt, int lane) {
    const size_t cu = ((size_t)up * SEGC + (SEGC - 1)) * CHB;
#pragma unroll
    for (int ct = 0; ct < 4; ++ct)
#pragma unroll
        for (int ks = 0; ks < 2; ++ks) { const u32x4 v = *(const u32x4*)(RP + cu + (size_t)(ct * 64 + lane) * 16 + 8 * ks); R.x[ct][ks][0] = (u32x2){v.x, v.y}; R.x[ct][ks][1] = (u32x2){v.z, v.w}; }
#pragma unroll
    for (int ks = 0; ks < 2; ++ks) { const u32x4 v = *(const u32x4*)(RQ + cu + (size_t)(rt * 64 + lane) * 16 + 8 * ks); R.q[2 * ks] = bf4((u32x2){v.x, v.y}); R.q[2 * ks + 1] = bf4((u32x2){v.z, v.w}); }
}
__device__ __forceinline__ void fold_step(const FoldRegs& R, f32x4 (&acc)[4]) { state_step(acc, R.x);
#pragma unroll
    for (int ct = 0; ct < 4; ++ct) acc[ct] += R.q[ct]; }
}
__device__ __forceinline__ void rwkv_scan_unit(const Ctx& F, int unit) {
    using namespace rk;
    const int w = F.wave;
    const int b = unit >> 7, h = (unit >> 4) & 7, seg = unit & 15;
    int tv_ = F.tid; asm volatile("" : "+v"(tv_));
    const int lane = tv_ & 63, g = lane >> 4, ln = lane & 15;
    LAS bf16_t* ST = (LAS bf16_t*)F.lds;
    LAS float* PG = (LAS float*)(F.lds + MBY);
    const bf16_t *RP = (const bf16_t*)(F.ws + WS_PHIT), *RQ = (const bf16_t*)(F.ws + WS_PSI), *YSG = (const bf16_t*)(F.ws + WS_YS), *YLG = (const bf16_t*)(F.ws + WS_YL), *GTG = (const bf16_t*)(F.ws + WS_GT), *BVG = (const bf16_t*)(F.ws + WS_BV);
    bf16_t* YCAT = (bf16_t*)(F.ws + WS_YCAT);
    const bf16_t* SEGP = (const bf16_t*)(F.ws + WS_SEGP); const float* SEGQ = (const float*)(F.ws + WS_SEGQ);
    if (tv_ < 128) PG[tv_] = (tv_ < 64) ? F.in[I_LNXG][h * 64 + tv_] : F.in[I_LNXB][h * 64 + tv_ - 64];
    const int c = w;
    const size_t cu = (size_t)((b * 8 + h) * NCHUNK + seg * SEGC + c) * CHB, cp = c > 0 ? cu - CHB : cu;
    bf16x8 ptx[4][2]; u32x4 qv[4][2]; bf16x8 ysr[4][2];
#define SCAN_LOADS() do { \
_Pragma("unroll") \
    for (int ct = 0; ct < 4; ++ct) \
_Pragma("unroll") \
        for (int ks = 0; ks < 2; ++ks) { ptx[ct][ks] = *(const bf16x8*)(RP + cp + (size_t)(ct * 64 + lane) * 16 + 8 * ks); qv[ct][ks] = *(const u32x4*)(RQ + cp + (size_t)(ct * 64 + lane) * 16 + 8 * ks); \
            ysr[ct][ks] = *(const bf16x8*)(YSG + cu + (size_t)(ct * 64 + lane) * 16 + 8 * ks); } \
    } while (0)
    if (w < 4) SCAN_LOADS();
    if (w >= 4) {
        f32x4 acc[4];
#pragma unroll
        for (int ct = 0; ct < 4; ++ct) acc[ct] = (f32x4){0.f, 0.f, 0.f, 0.f};
        const int rt = w - 4, u0 = unit - seg; FoldRegs F0, F1, F2, F3;
        const int ul = unit > 0 ? unit - 1 : 0;
#define FLD(R, k) do { const int un_ = u0 + (k); fold_load(R, RP, RQ, un_ < ul ? un_ : ul, rt, lane); } while (0)
        FLD(F0, 0); FLD(F1, 1); FLD(F2, 2);
        for (int sp = 0; sp < seg; sp += 4) {
            FLD(F3, sp + 3); fold_step(F0, acc);
            FLD(F0, sp + 4); if (sp + 1 < seg) fold_step(F1, acc);
            FLD(F1, sp + 5); if (sp + 2 < seg) fold_step(F2, acc);
            FLD(F2, sp + 6); if (sp + 3 < seg) fold_step(F3, acc);
        }
#undef FLD
#pragma unroll
        for (int ct = 0; ct < 4; ++ct) st4bf(ST + (16 * rt + ln) * LD + 16 * ct + 4 * g, acc[ct]);
        SCAN_LOADS();
    }
#undef SCAN_LOADS
    LB();
    bf16x8 xs[4][2];
#pragma unroll
    for (int rt = 0; rt < 4; ++rt) {
        f32x4 sc[4];
        if (c > 0) {
            bf16x8 yf[2];
#pragma unroll
            for (int ks = 0; ks < 2; ++ks) { const u32x2 lo_ = *(const LAS u32x2*)(ST + (16 * rt + ln) * LD + 32 * ks + 4 * g), hi_ = *(const LAS u32x2*)(ST + (16 * rt + ln) * LD + 32 * ks + 16 + 4 * g);
                u32x4 wv; wv.x = lo_.x; wv.y = lo_.y; wv.z = hi_.x; wv.w = hi_.y; yf[ks] = __builtin_bit_cast(bf16x8, wv); }
#pragma unroll
            for (int ct = 0; ct < 4; ++ct) { u32x2 q2; if (ct & 1) { q2.x = qv[rt][ct >> 1].z; q2.y = qv[rt][ct >> 1].w; } else { q2.x = qv[rt][ct >> 1].x; q2.y = qv[rt][ct >> 1].y; } f32x4 d = bf4(q2);
#pragma unroll
                for (int ks = 0; ks < 2; ++ks) d = __builtin_amdgcn_mfma_f32_16x16x32_bf16(ptx[ct][ks], yf[ks], d, 0, 0, 0);
                sc[ct] = d; }
        } else {
#pragma unroll
            for (int ct = 0; ct < 4; ++ct) sc[ct] = bf4(*(const LAS u32x2*)(ST + (16 * rt + ln) * LD + 16 * ct + 4 * g));
        }
        state_yfrags(sc, xs[rt]);
    }
    const size_t orow0 = ((size_t)b * SEQ + (size_t)(seg * SEGC + c) * CH) * D + 512 + h * 64;
    u32x4 yl[4][2], gt[4][2], bv[4][2];
#pragma unroll
    for (int tt = 0; tt < 4; ++tt)
#pragma unroll
        for (int ks = 0; ks < 2; ++ks) { const size_t ro = cu + (size_t)(tt * 64 + lane) * 16 + 8 * ks; yl[tt][ks] = *(const u32x4*)(YLG + ro); gt[tt][ks] = *(const u32x4*)(GTG + ro); bv[tt][ks] = *(const u32x4*)(BVG + ro); }
#define H2(a, vt) (((vt) & 1) ? (u32x2){(a)[(vt) >> 1].z, (a)[(vt) >> 1].w} : (u32x2){(a)[(vt) >> 1].x, (a)[(vt) >> 1].y})
#pragma unroll
    for (int tt = 0; tt < 4; ++tt) {
        f32x4 y[4]; float s = 0.f;
#pragma unroll
        for (int vt = 0; vt < 4; ++vt) { f32x4 d = bf4(H2(yl[tt], vt));
#pragma unroll
            for (int ks = 0; ks < 2; ++ks) d = __builtin_amdgcn_mfma_f32_16x16x32_bf16(xs[vt][ks], ysr[tt][ks], d, 0, 0, 0);
            y[vt] = d; s += (d[0] + d[1]) + (d[2] + d[3]); }
        s += __shfl_xor(s, 16); s += __shfl_xor(s, 32);
        const float mean = s * (1.0f / 64.0f); float qq = 0.f;
#pragma unroll
        for (int vt = 0; vt < 4; ++vt) { y[vt] = y[vt] - mean; qq += (y[vt][0] * y[vt][0] + y[vt][1] * y[vt][1]) + (y[vt][2] * y[vt][2] + y[vt][3] * y[vt][3]); }
        qq += __shfl_xor(qq, 16); qq += __shfl_xor(qq, 32);
        const float rstd = __builtin_amdgcn_rsqf(qq * (1.0f / 64.0f) + 64e-5f);
        const size_t orow = orow0 + (size_t)(16 * tt + ln) * D;
#pragma unroll
        for (int vt = 0; vt < 4; ++vt) { const f32x4 lg4 = *(const LAS f32x4*)(PG + 16 * vt + 4 * g), lb4 = *(const LAS f32x4*)(PG + 64 + 16 * vt + 4 * g);
            const f32x4 o = (y[vt] * rstd * lg4 + lb4 + bf4(H2(bv[tt], vt))) * bf4(H2(gt[tt], vt)); u32x2 ow; ow.x = pk2(o[0], o[1]); ow.y = pk2(o[2], o[3]);
            *(u32x2*)(YCAT + orow + 16 * vt + 4 * g) = ow; }
    }
#undef H2
    LB();
}

__device__ __forceinline__ void router_phase(const Ctx& F) {
    const int tid = F.tid, lane = F.lane, w = F.wave;
    constexpr int LDX = 1028;
    LAS float* X = (LAS float*)F.lds;
    LAS float* RS = (LAS float*)(F.lds + 32 * LDX * 4);
    LAS float* LOG = RS + 32;
    LAS int* LCNT = (LAS int*)(LOG + 32 * 33);
    const float* H1 = (const float*)(F.ws + WS_H1); unsigned char* HN2 = F.ws + WS_HN2; const float* RW = (const float*)(F.ws + WS_RW);
    int* CNT = (int*)(F.ws + WS_CNT); int* RIDX = (int*)(F.ws + WS_RIDX); float* RGATE = (float*)(F.ws + WS_RGATE); int* RRANK = (int*)(F.ws + WS_RRANK);
    f32x4 gv[4];
#pragma unroll
    for (int j = 0; j < 4; ++j) gv[j] = *((const f32x4*)F.in[I_N2G] + lane + 64 * j);
    for (int tile = F.vcu; tile < NRT; tile += F.G) {
        f32x4 vr[4][4];
#pragma unroll
        for (int rr = 0; rr < 4; ++rr) { const f32x4* xr = (const f32x4*)(H1 + ((size_t)tile * RT_TOK + w * 4 + rr) * D) + lane;
#pragma unroll
            for (int j = 0; j < 4; ++j) vr[rr][j] = xr[64 * j]; }
#pragma unroll
        for (int rr = 0; rr < 4; ++rr) { const int row = w * 4 + rr; const size_t m = (size_t)tile * RT_TOK + row;
            f32x4 v[4]; float s = 0.f;
#pragma unroll
            for (int j = 0; j < 4; ++j) { v[j] = vr[rr][j]; s += (v[j].x * v[j].x + v[j].y * v[j].y) + (v[j].z * v[j].z + v[j].w * v[j].w); }
            const float rstd = __builtin_amdgcn_rsqf(wave_sum(s) * (1.0f / D) + 1e-5f);
            unsigned* o4 = (unsigned*)(HN2 + m * D) + lane;
#pragma unroll
            for (int j = 0; j < 4; ++j) { o4[64 * j] = pk4_fp8(v[j].x * rstd * gv[j].x, v[j].y * rstd * gv[j].y, v[j].z * rstd * gv[j].z, v[j].w * rstd * gv[j].w);
                *(LAS f32x4*)(X + row * LDX + 4 * (lane + 64 * j)) = v[j]; }
            if (lane == 0) RS[row] = rstd; }
        WG_BAR();
        f32x16 acc;
#pragma unroll
        for (int r = 0; r < 16; ++r) acc[r] = 0.f;
        { const int i = lane & 31, hh = lane >> 5;
#pragma unroll 4
          for (int kg = 0; kg < 16; ++kg) { const int kb = 128 * w + 8 * kg + 4 * hh; const f32x4 xa = *(const LAS f32x4*)(X + i * LDX + kb);
#pragma unroll
              for (int j = 0; j < 4; ++j) acc = __builtin_amdgcn_mfma_f32_32x32x2f32(xa[j], RW[(kb + j) * NEXP + i], acc, 0, 0, 0); } }
        WG_BAR();
#pragma unroll
        for (int r = 0; r < 16; ++r) { const int tok = (r & 3) + 8 * (r >> 2) + 4 * (lane >> 5); X[(w * 32 + tok) * 33 + (lane & 31)] = acc[r]; }
        WG_BAR();
#pragma unroll
        for (int q = 0; q < 2; ++q) { const int idx = tid + 512 * q, tok = idx >> 5, e = idx & 31; float s = 0.f;
#pragma unroll
            for (int ww = 0; ww < 8; ++ww) s += X[(ww * 32 + tok) * 33 + e];
            LOG[tok * 33 + e] = s * RS[tok] + F.in[I_RB][e]; }
        if (tid < 32) LCNT[tid] = 0;
        WG_BAR();
        {
            const int e = lane & 31;
#pragma unroll
            for (int it = 0; it < 2; ++it) { const int tok = w * 4 + 2 * it + (lane >> 5); float val = LOG[tok * 33 + e]; float tv[4]; int ti[4];
#pragma unroll
                for (int p = 0; p < 4; ++p) { float cand = val; int idx = e;
#pragma unroll
                    for (int d = 1; d < 32; d <<= 1) { const float ov = __shfl_xor(cand, d); const int oi = __shfl_xor(idx, d); const bool take = (ov > cand) || (ov == cand && oi < idx); cand = take ? ov : cand; idx = take ? oi : idx; }
                    tv[p] = cand; ti[p] = idx; if (e == idx) val = -3.0e38f; }
                float ex[4], es = 0.f;
#pragma unroll
                for (int p = 0; p < 4; ++p) { ex[p] = __expf(tv[p] - tv[0]); es += ex[p]; }
                const float inv = __builtin_amdgcn_rcpf(es); const size_t m = (size_t)tile * RT_TOK + tok;
#pragma unroll
                for (int p = 0; p < 4; ++p) if (e == ti[p]) { const int rk = atomicAdd((int*)(LCNT + e), 1); RIDX[m * 4 + p] = e; RGATE[m * 4 + p] = ex[p] * inv; RRANK[m * 4 + p] = rk; }
            }
        }
        WG_BAR();
        if (tid < 32) CNT[tile * 32 + tid] = LCNT[tid];
        WG_BAR();
    }
}

__device__ __forceinline__ void scatter_phase(const Ctx& F) {
    const int tid = F.tid;
    LAS int* PS = (LAS int*)F.lds;
    LAS int* PAD = PS + 512;
    LAS int* BASE = PAD + 64;
    const int* CNT = (const int*)(F.ws + WS_CNT); const int* RIDX = (const int*)(F.ws + WS_RIDX); const float* RGATE = (const float*)(F.ws + WS_RGATE); const int* RRANK = (const int*)(F.ws + WS_RRANK);
    int* TDEST = (int*)(F.ws + WS_TDEST); int* ROWTOK = (int*)(F.ws + WS_ROWTOK); float* ROWGATE = (float*)(F.ws + WS_ROWGATE); int* ETAB = (int*)(F.ws + WS_ETAB);
    { const int e = tid & 31, p = tid >> 5; int sm = 0;
#pragma unroll
      for (int j = 0; j < 32; ++j) sm += CNT[(32 * p + j) * 32 + e];
      PS[p * 32 + e] = sm; }
    WG_BAR();
    if (tid < 64) { const int e = tid & 31; int tot = 0;
#pragma unroll
        for (int p = 0; p < 16; ++p) tot += PS[p * 32 + e];
        const int padn = (tot + 255) & ~255; int inc = padn;
#pragma unroll
        for (int d = 1; d < 32; d <<= 1) { const int o = __shfl_up(inc, d, 32); inc += (e >= d) ? o : 0; }
        if (tid < 32) { PAD[e] = inc - padn; if (e == 31) PAD[32] = inc; } }
    WG_BAR();
    if (F.vcu == 0 && tid < 33) ETAB[tid] = PAD[tid];
    for (int tile = F.vcu; tile < NRT; tile += F.G) {
        if (tid < 32) { const int p = tile >> 5; int sm = PAD[tid];
#pragma unroll
            for (int pp = 0; pp < 16; ++pp) sm += (pp < p) ? PS[pp * 32 + tid] : 0;
#pragma unroll
            for (int j = 0; j < 32; ++j) { const int v = CNT[(32 * p + j) * 32 + tid]; sm += (32 * p + j < tile) ? v : 0; }
            BASE[tid] = sm; }
        WG_BAR();
        if (tid < 128) { const size_t ix = (size_t)tile * 128 + tid; const int e = RIDX[ix]; const int dest = BASE[e] + RRANK[ix];
            ROWTOK[dest] = (int)(ix >> 2); ROWGATE[dest] = RGATE[ix]; TDEST[ix] = dest; }
        WG_BAR();
    }
}

struct CombRows { f32x4 v[4]; unsigned y[4][4]; };
__device__ __forceinline__ void comb_load(CombRows& R, const float* H1, const unsigned char* YOUT, const int4 td, int m, int lane) {
    const f32x4* xr = (const f32x4*)(H1 + (size_t)m * D) + lane;
#pragma unroll
    for (int j = 0; j < 4; ++j) R.v[j] = __builtin_nontemporal_load(xr + 64 * j);
    const int dd[4] = {td.x, td.y, td.z, td.w};
#pragma unroll
    for (int p = 0; p < 4; ++p) { const unsigned* yr = (const unsigned*)(YOUT + (size_t)dd[p] * D) + lane;
#pragma unroll
        for (int j = 0; j < 4; ++j) R.y[p][j] = __builtin_nontemporal_load(yr + 64 * j); }
}
__device__ __forceinline__ void comb_store(const CombRows& R, const f32x4 (&gv)[4], float* out, int m, int lane) {
    f32x4 v[4]; float s = 0.f;
#pragma unroll
    for (int j = 0; j < 4; ++j) { v[j] = R.v[j];
#pragma unroll
        for (int p = 0; p < 4; ++p) { const unsigned y = R.y[p][j]; const f32x2 lo = __builtin_amdgcn_cvt_pk_f32_fp8(y, false), hi = __builtin_amdgcn_cvt_pk_f32_fp8(y, true);
            v[j].x += lo.x * (1.0f / FP8_SY); v[j].y += lo.y * (1.0f / FP8_SY); v[j].z += hi.x * (1.0f / FP8_SY); v[j].w += hi.y * (1.0f / FP8_SY); }
        s += (v[j].x * v[j].x + v[j].y * v[j].y) + (v[j].z * v[j].z + v[j].w * v[j].w); }
    const float rstd = __builtin_amdgcn_rsqf(wave_sum(s) * (1.0f / D) + 1e-5f);
    f32x4* o = (f32x4*)(out + (size_t)m * D) + lane;
#pragma unroll
    for (int j = 0; j < 4; ++j) __builtin_nontemporal_store(v[j] * rstd * gv[j], o + 64 * j);
}
__device__ __forceinline__ void combine_phase(const Ctx& F, float* out) {
    const int lane = F.lane; const int gw = F.vcu * 8 + F.wave, NGW = F.G * 8;
    const float* H1 = (const float*)(F.ws + WS_H1); const unsigned char* YOUT = F.ws + WS_YOUT; const int4* TDEST = (const int4*)(F.ws + WS_TDEST);
    f32x4 gv[4];
#pragma unroll
    for (int j = 0; j < 4; ++j) gv[j] = *((const f32x4*)F.in[I_FG] + lane + 64 * j);
    for (int m0 = gw; m0 < M; m0 += 8 * NGW) {
        int4 td[8];
#pragma unroll
        for (int i = 0; i < 8; ++i) { const int m = m0 + i * NGW; td[i] = TDEST[m < M ? m : M - 1]; }
        CombRows A, B;
        comb_load(A, H1, YOUT, td[0], m0, lane);
#pragma unroll
        for (int i = 0; i < 8; i += 2) {
            { const int m = m0 + (i + 1) * NGW; comb_load(B, H1, YOUT, td[i + 1], m < M ? m : M - 1, lane); }
            { const int m = m0 + i * NGW; if (m < M) comb_store(A, gv, out, m, lane); }
            if (i + 2 < 8) { const int m = m0 + (i + 2) * NGW; comb_load(A, H1, YOUT, td[i + 2], m < M ? m : M - 1, lane); }
            { const int m = m0 + (i + 1) * NGW; if (m < M) comb_store(B, gv, out, m, lane); }
        }
    }
}

__global__ void __launch_bounds__(512, 2) mk_fwd(Args args) {
    extern __shared__ __attribute__((aligned(16))) unsigned char lds_raw[];
    Ctx F;
    F.lds = (LAS unsigned char*)lds_raw;
    F.tid = threadIdx.x; F.lane = F.tid & 63; F.wave = __builtin_amdgcn_readfirstlane(F.tid >> 6);
    F.G = gridDim.x; { const int bx = blockIdx.x; F.vcu = (F.G % 8 == 0) ? (bx % 8) * (F.G / 8) + bx / 8 : bx; }
    F.ws = args.ws; F.in = args.in;
    volatile LAS unsigned* MISC = (volatile LAS unsigned*)(F.lds + MISC_OFF);
    if (F.tid < 64) MISC[F.tid] = 0u;
    __syncthreads();
    unsigned* ctl = (unsigned*)(args.ws + WS_CTL);
    XcdBarrier bar; bar.bar = ctl + CW_BAR; bar.x = 0; bar.st = nullptr;
    const int lo = args.ph_lo, hi = args.ph_hi;
    if (hi - lo > 1) bar = xcd_barrier_post(ctl + CW_BAR + args.li * XCD_BAR_WORDS, MISC + 8);
#define IN(k) (lo <= (k) && (k) < hi)
#define SEAM(k) do { if (IN(k) && IN((k) + 1)) xcd_barrier(bar); } while (0)
    unsigned char* ws = args.ws;

    if (IN(0)) REP(0) { p0_prologue(F); } SEAM(0);
    if (IN(1)) REP(1) {
        pg8::Gemm g{(const bf16_t*)(ws + WS_XN), (const bf16_t*)(ws + WS_WCAT), M, NPROJ, D}; pg8::StaticOrder S; S.init(M, NPROJ, D, F.G, (int)blockIdx.x);
        pg8::EpiProj E{(bf16_t*)(ws + WS_PROJ), NPROJ, 4};
        pg8::gemm_phase<pg8::EpiProj, pg8::StaticOrder, false>(F.lds, g, S, E);
    } SEAM(1);
    if (IN(2)) REP(2) { REP(10) sgu_phase(F); for (int u = F.vcu; u < NRU; u += F.G) rwkv_prep_unit(F, u); } SEAM(2);
    if (IN(3)) REP(3) { for (int u = F.vcu; u < NRU; u += F.G) rwkv_scan_unit(F, u); } SEAM(3);
    if (IN(4)) REP(4) {
        pg8::Gemm g{(const bf16_t*)(ws + WS_YCAT), (const bf16_t*)(ws + WS_WOUT), M, D, D}; pg8::StaticOrder S; S.init(M, D, D, F.G, (int)blockIdx.x);
        pg8::EpiResF32 E{F.in[I_X], (float*)(ws + WS_H1), D};
        pg8::gemm_phase<pg8::EpiResF32, pg8::StaticOrder, false>(F.lds, g, S, E);
    } SEAM(4);
    if (IN(5)) REP(5) { router_phase(F); } SEAM(5);
    if (IN(6)) REP(6) { scatter_phase(F); moe_weight_phase(F); } SEAM(6);
    if (IN(7)) REP(7) {
        const int* etab = (const int*)(ws + WS_ETAB); const int ntiles = etab[32] >> 8;
        pg8::MoeChain S; S.n1 = ntiles * (NHID / 256); S.ntot = ntiles * (NHID / 256 + D / 256); S.G = F.G; S.c = (int)blockIdx.x; S.pad_start = etab; S.rowtok = (const int*)(ws + WS_ROWTOK);
        S.A1 = (const char*)(ws + WS_HN2); S.B1 = (const char*)(ws + WS_W1T); S.A2 = (const char*)(ws + WS_ACT); S.B2 = (const char*)(ws + WS_W2T); S.cnt = ctl + CW_DEP; S.build_texp(F.lds);
        pg8::Gemm g{nullptr, nullptr, MAXROWS, NHID, D};
        pg8::EpiChain E{{ws + WS_ACT, F.in[I_MB1], S.texp}, {ws + WS_YOUT, F.in[I_MB2], (const float*)(ws + WS_ROWGATE), S.texp}};
        pg8::gemm_phase<pg8::EpiChain, pg8::MoeChain, true, true>(F.lds, g, S, E);
    } SEAM(7);
    if (IN(9)) REP(9) { combine_phase(F, args.out); }
#undef IN
#undef SEAM
}

extern "C" void kernel_launch(void* const* d_in, const int* in_sizes, int n_in, void* d_out, int out_size, void* d_ws, size_t ws_size, hipStream_t stream) {
    static int grid = 0;
    if (grid == 0) {
        if (n_in != 31 || in_sizes[0] != M * D || out_size != M * D || ws_size < WS_END) { fprintf(stderr, "kernel_launch: unexpected problem (n_in %d, out %d, ws %zu); nothing launched\n", n_in, out_size, ws_size); grid = -1; return; }
        int dev = 0, cus = 0, per_cu = 0;
        if (hipGetDevice(&dev) != hipSuccess || hipDeviceGetAttribute(&cus, hipDeviceAttributeMultiprocessorCount, dev) != hipSuccess) { grid = -1; return; }
        if (hipFuncSetAttribute((const void*)mk_fwd, hipFuncAttributeMaxDynamicSharedMemorySize, LDS_BYTES) != hipSuccess) { fprintf(stderr, "kernel_launch: hipFuncSetAttribute failed\n"); grid = -1; return; }
        if (hipOccupancyMaxActiveBlocksPerMultiprocessor(&per_cu, (const void*)mk_fwd, 512, LDS_BYTES) != hipSuccess || per_cu < 1) fprintf(stderr, "kernel_launch: occupancy query reports %d\n", per_cu);
        (void)hipGetLastError();
        grid = cus;
    }
    if (grid < 0) return;
    if (hipMemsetAsync((char*)d_ws + WS_CTL, 0, CTL_ZERO_BYTES, stream) != hipSuccess) return;
    Args a; memset(&a, 0, sizeof(a));
    for (int i = 0; i < 31; ++i) a.in[i] = (const float*)d_in[i];
    a.out = (float*)d_out; a.ws = (unsigned char*)d_ws;
    constexpr int NL = MK_N_LAUNCHES;
    static_assert(NL == 1 || NL == N_PHASES, "MK_N_LAUNCHES: 1 (one launch) or 10 (one launch per phase)");
    for (int li = 0; li < NL; ++li) {
        a.ph_lo = (NL == 1) ? 0 : li; a.ph_hi = (NL == 1) ? N_PHASES : li + 1; a.li = 0; a.pad = 0;
        hipLaunchKernelGGL(mk_fwd, dim3(grid), dim3(512), LDS_BYTES, stream, a);
    }
}
```

```cpp
#include <hip/hip_runtime.h>
#include <cstdio>
#include <cstdint>
#include <cstring>

#ifndef MK_N_LAUNCHES
#define MK_N_LAUNCHES 1
#endif
constexpr int N_PHASES = 10;
#ifndef PROBE_MASK
#define PROBE_MASK 0
#endif
#define REP(k) for (int rep_ = 0; rep_ < (((PROBE_MASK >> (k)) & 1) ? 2 : 1); ++rep_)

#define LAS __attribute__((address_space(3)))
#define GAS __attribute__((address_space(1)))
typedef unsigned short bf16_t;
typedef short bf16x8 __attribute__((ext_vector_type(8)));
typedef float f32x4 __attribute__((ext_vector_type(4)));
typedef float f32x2 __attribute__((ext_vector_type(2)));
typedef float f32x16 __attribute__((ext_vector_type(16)));
typedef unsigned u32x4 __attribute__((ext_vector_type(4)));
typedef unsigned u32x2 __attribute__((ext_vector_type(2)));
typedef GAS unsigned gu32;
#define RLX_AGENT __ATOMIC_RELAXED, __HIP_MEMORY_SCOPE_AGENT
#define LDS_WAIT() asm volatile("s_waitcnt lgkmcnt(0)" ::: "memory")
#define VM_WAIT() asm volatile("s_waitcnt vmcnt(0)" ::: "memory")
#define WG_BAR() do { asm volatile("s_waitcnt vmcnt(0) lgkmcnt(0)" ::: "memory"); __builtin_amdgcn_s_barrier(); asm volatile("" ::: "memory"); } while (0)

constexpr int BATCH = 2, SEQ = 8192, D = 1024, M = BATCH * SEQ;
constexpr int NPROJ = 3072;
constexpr int COL_V = 512, COL_R = 1024, COL_K = 1536, COL_VR = 2048, COL_LA = 2560, COL_LB = 2816;
constexpr int NEXP = 32, TOPK = 4, DEXP = 1024, NHID = 2048;
constexpr int NASSIGN = M * TOPK;
constexpr int MAXROWS = NASSIGN + NEXP * 256;
constexpr int RT_TOK = 32, NRT = M / RT_TOK;
constexpr int CH = 64, NCHUNK = SEQ / CH, SEGC = 8, NSEG = NCHUNK / SEGC;
constexpr int NRU = BATCH * 8 * NSEG;

constexpr size_t MiB = 1u << 20;
constexpr size_t WS_CTL = 0, CTL_ZERO_BYTES = 15040;
constexpr size_t WS_WCAT = 2 * MiB;
constexpr size_t WS_WOUT = 8 * MiB;
constexpr size_t WS_SMALL = 10 * MiB;
constexpr size_t WS_LW2 = WS_SMALL;
constexpr size_t WS_LA2 = WS_LW2 + 512 * 64 * 2;
constexpr size_t WS_LG2 = WS_LA2 + 512 * 64 * 2;
constexpr size_t WS_SGUW = WS_LG2 + 512 * 128 * 2;
constexpr size_t WS_RW = WS_SGUW + 8 * 128 * 128 * 2;
constexpr size_t WS_ETAB = WS_RW + 1024 * 32 * 4;
constexpr size_t WS_CNT = WS_ETAB + 1024;
constexpr size_t WS_RIDX = WS_CNT + NRT * 32 * 4;
constexpr size_t WS_RGATE = WS_RIDX + (size_t)M * 4 * 4;
constexpr size_t WS_RRANK = WS_RGATE + (size_t)M * 4 * 4;
constexpr size_t WS_TDEST = WS_RRANK + (size_t)M * 4 * 4;
static_assert(WS_TDEST + (size_t)M * 4 * 4 <= 12 * MiB, "small region");
constexpr size_t WS_ROWTOK = 12 * MiB;
constexpr size_t WS_SEGP = 14 * MiB;
constexpr size_t WS_SEGQ = 16 * MiB;
constexpr size_t WS_XN = 32 * MiB;
constexpr size_t WS_YCAT = 64 * MiB;
constexpr size_t WS_HN2 = 96 * MiB;
constexpr size_t WS_H1 = 128 * MiB;
constexpr size_t WS_PROJ = 192 * MiB;
constexpr size_t WS_W1T = 288 * MiB;
constexpr size_t WS_W2T = 416 * MiB;
constexpr size_t WS_ACT = 480 * MiB;
constexpr size_t WS_YOUT = 624 * MiB;
constexpr size_t WS_RK = 768 * MiB;
constexpr size_t WS_PHIT = WS_RK, WS_PSI = WS_RK + 8192, WS_YS = WS_RK + 16384, WS_YL = WS_RK + 24576, WS_GT = WS_RK + 32768, WS_BV = WS_RK + 40960;
constexpr size_t WS_END = 864 * MiB;
constexpr int CW_BAR = 0, CW_DEP = 3456, CW_XMAP = CW_DEP + 288, CW_XBAD = CW_XMAP + 8;

constexpr int RING_BYTES = 131072;
constexpr int TAB_OFF = 151552;
constexpr int PRE_OFF = RING_BYTES;
constexpr int DEP_OFF = PRE_OFF + 4096;
constexpr int TEXP_OFF = TAB_OFF + 2048;
constexpr int LDS_BYTES = 155648;
constexpr int MISC_OFF = LDS_BYTES - 256;

typedef __bf16 bf16v2_t __attribute__((ext_vector_type(2)));
__device__ __forceinline__ unsigned pk2(float lo, float hi) { const f32x2 v = {lo, hi}; return __builtin_bit_cast(unsigned, __builtin_convertvector(v, bf16v2_t)); }
__device__ __forceinline__ unsigned f2bf(float f) { return pk2(f, 0.f) & 0xffffu; }
__device__ __forceinline__ float bf2f(unsigned short b) { return __builtin_bit_cast(float, (unsigned)b << 16); }
__device__ __forceinline__ float bflo(unsigned w) { return __builtin_bit_cast(float, w << 16); }
__device__ __forceinline__ float bfhi(unsigned w) { return __builtin_bit_cast(float, w & 0xffff0000u); }
__device__ __forceinline__ void unpack8(const u32x4 w, float (&o)[8]) { o[0] = bflo(w.x); o[1] = bfhi(w.x); o[2] = bflo(w.y); o[3] = bfhi(w.y); o[4] = bflo(w.z); o[5] = bfhi(w.z); o[6] = bflo(w.w); o[7] = bfhi(w.w); }
__device__ __forceinline__ u32x4 pack8(const float (&v)[8]) { u32x4 w; w.x = pk2(v[0], v[1]); w.y = pk2(v[2], v[3]); w.z = pk2(v[4], v[5]); w.w = pk2(v[6], v[7]); return w; }
__device__ __forceinline__ float fsigmoid(float x) { return __builtin_amdgcn_rcpf(1.0f + __expf(-x)); }
__device__ __forceinline__ unsigned pk4_fp8(float a, float b, float c, float d) {
    a = fminf(fmaxf(a, -448.f), 448.f); b = fminf(fmaxf(b, -448.f), 448.f); c = fminf(fmaxf(c, -448.f), 448.f); d = fminf(fmaxf(d, -448.f), 448.f);
    unsigned w = 0u; w = __builtin_amdgcn_cvt_pk_fp8_f32(a, b, w, false); w = __builtin_amdgcn_cvt_pk_fp8_f32(c, d, w, true); return w; }
constexpr float FP8_SW = 64.0f;
constexpr float FP8_SA = 4.0f;
constexpr float FP8_SY = 4.0f;
template <int CTRL> __device__ __forceinline__ float dpp_f(float v) { return __builtin_bit_cast(float, __builtin_amdgcn_update_dpp(0, __builtin_bit_cast(int, v), CTRL, 0xF, 0xF, false)); }
constexpr int DPP_XOR1 = 0xB1, DPP_XOR2 = 0x4E, DPP_HMIRROR = 0x141, DPP_MIRROR = 0x140;
__device__ __forceinline__ float sum8(float v) { v += dpp_f<DPP_XOR1>(v); v += dpp_f<DPP_XOR2>(v); v += dpp_f<DPP_HMIRROR>(v); return v; }
__device__ __forceinline__ float sum16(float v) { v = sum8(v); v += dpp_f<DPP_MIRROR>(v); return v; }
__device__ __forceinline__ float wave_sum(float v) {
    v = sum16(v);
    const float r0 = __builtin_amdgcn_readlane(v, 0), r1 = __builtin_amdgcn_readlane(v, 16), r2 = __builtin_amdgcn_readlane(v, 32), r3 = __builtin_amdgcn_readlane(v, 48);
    return (r0 + r1) + (r2 + r3);
}

__device__ __forceinline__ u32x4 widen16(u32x2 a, u32x2 b) {
    const auto x = __builtin_amdgcn_permlane16_swap(a.x, b.x, false, false); const auto y = __builtin_amdgcn_permlane16_swap(a.y, b.y, false, false);
    return (u32x4){x[0], y[0], x[1], y[1]};
}
__device__ __forceinline__ float xor16_sum(float v) { const unsigned u = __builtin_bit_cast(unsigned, v); const auto r = __builtin_amdgcn_permlane16_swap(u, u, false, false);
    unsigned a0 = r[0], a1 = r[1]; asm volatile("" : "+v"(a0), "+v"(a1)); return __builtin_bit_cast(float, a0) + __builtin_bit_cast(float, a1); }
__device__ __forceinline__ float xor32_sum(float v) { const unsigned u = __builtin_bit_cast(unsigned, v); const auto r = __builtin_amdgcn_permlane32_swap(u, u, false, false);
    unsigned a0 = r[0], a1 = r[1]; asm volatile("" : "+v"(a0), "+v"(a1)); return __builtin_bit_cast(float, a0) + __builtin_bit_cast(float, a1); }
namespace pg8 {
constexpr int BM = 256, BK = 64, HALF = 128, HTB = HALF * BK * 2, STAGE_BYTES = 8 * HTB, NXCD = 8, WGM = 8;
__host__ __device__ __forceinline__ int lds_byte(int r, int c) { const int st = (r >> 4) * 2 + (c >> 5), rr = r & 15, cc = c & 31, ob = rr * 64 + cc * 2; return st * 1024 + (ob ^ (((ob >> 9) & 1) << 5)); }
__host__ __device__ __forceinline__ void stage_rc(int b, int& R, int& C) { const int st = b / 1024, sb = b % 1024, swz = sb ^ (((sb >> 9) & 1) << 5); R = (st >> 1) * 16 + swz / 64; C = (st & 1) * 32 + (swz % 64) / 2; }
__host__ __device__ __forceinline__ int perm32(int rho) { const int n = rho >> 4, i = rho & 15; return 8 * (i >> 2) + 4 * n + (i & 3); }

struct Unit { int pm, pn, kind; };
struct Gemm { const bf16_t* A; const bf16_t* Bt; int M, N, K; };

struct StaticOrder {
    static constexpr bool CHAIN = false;
    int nM, nN, nwg, G, c, K;
    __device__ void init(int M_, int N_, int K_, int G_, int c_) { nM = M_ / BM; nN = N_ / BM; nwg = nM * nN; G = G_; c = c_; K = K_ * 2; }
    __device__ bool next(int i, Unit& u) const {
        const long L = (long)i * G + c; if (L >= nwg) return false;
        int wgid = (int)L; { const int q = nwg / NXCD, r = nwg % NXCD, xcd = wgid % NXCD, off = wgid / NXCD; wgid = (xcd < r ? xcd * (q + 1) : r * (q + 1) + (xcd - r) * q) + off; }
        const int nig = WGM * nN, gid = wgid / nig, fm = gid * WGM, gsz = (nM - fm) < WGM ? (nM - fm) : WGM;
        u.pm = fm + ((wgid % nig) % gsz); u.pn = (wgid % nig) / gsz; u.kind = 0; return true;
    }
    __device__ __forceinline__ const char* a_ptr(const Gemm& g, const Unit& u) const { return (const char*)g.A + (size_t)u.pm * BM * K; }
    __device__ __forceinline__ const char* b_ptr(const Gemm& g, const Unit& u) const { return (const char*)g.Bt + (size_t)u.pn * BM * K; }
    __device__ __forceinline__ unsigned row_off(const Unit&, int) const { return 0u; }
};
struct MoeChain {
    static constexpr bool CHAIN = true;
    int lo, nt, W, r; const int* pad_start; const int* rowtok; const LAS unsigned char* texp;
    const char* A1; const char* B1; const char* A2; const char* B2; unsigned* cnt;
    __device__ __forceinline__ int expert_of(int pm) const { return (int)texp[pm]; }
    __device__ __forceinline__ void build_texp(LAS unsigned char* lds) { LAS unsigned char* t = lds + TEXP_OFF;
        for (int pm = (int)threadIdx.x; pm < MAXROWS / BM; pm += 512) { const int r0 = pm * BM; int e = 0;
            for (int j = 1; j < NEXP; ++j) if (pad_start[j] <= r0) e = j;
            t[pm] = (unsigned char)e; }
        texp = t; WG_BAR(); }
    __device__ __forceinline__ void deal(int ntiles, int G, int c) { const int NX = (G % 8 == 0) ? 8 : 1, x = c % NX; r = c / NX; W = G / NX; lo = (int)(((long)x * ntiles) / NX); nt = (int)(((long)(x + 1) * ntiles) / NX) - lo; }
    __device__ bool next(int i, Unit& u) const { const long idx = (long)i * W + r;
        if (idx < 8L * nt) { u.kind = 0; u.pm = lo + (int)(idx >> 3); u.pn = (int)idx & 7; return true; }
        const long j = idx - 8L * nt; if (j >= 4L * nt) return false;
        u.kind = 1; u.pm = lo + (int)(j >> 2); u.pn = (int)j & 3; return true; }
    __device__ __forceinline__ const char* a_ptr(const Gemm&, const Unit& u) const { return u.kind ? A2 : A1; }
    __device__ __forceinline__ const char* b_ptr(const Gemm&, const Unit& u) const { const size_t e = (size_t)expert_of(u.pm);
        return u.kind ? B2 + ((e * D + (size_t)u.pn * BM) << 10) : B1 + ((e * NHID + (size_t)u.pn * BM) << 10); }
    __device__ __forceinline__ unsigned row_off(const Unit& u, int r) const { return u.kind ? (unsigned)(u.pm * BM + r) << 10 : (unsigned)rowtok[u.pm * BM + r]; }
    __device__ __forceinline__ void dep_block(int pm) const {
        for (int it = 0; it < (1 << 22); ++it) { if (__hip_atomic_load(cnt + pm, __ATOMIC_RELAXED, __HIP_MEMORY_SCOPE_AGENT) >= 64u) break; __builtin_amdgcn_s_sleep(8); } }
};

__device__ __forceinline__ unsigned cvt_pk_bf16(float lo, float hi) { unsigned r; asm volatile("v_cvt_pk_bf16_f32 %0, %1, %2" : "=v"(r) : "v"(lo), "v"(hi)); return r; }
__device__ __forceinline__ f32x2 gelu_pk(f32x2 v) {
    const f32x2 av = __builtin_elementwise_abs(v), d = av * 0.2316418882f + 1.0f;
    f32x2 t; t.x = __builtin_amdgcn_rcpf(d.x); t.y = __builtin_amdgcn_rcpf(d.y);
    f32x2 q = t * 0.5307027145f + (-0.7265760135f); q = q * t + 0.7107068705f; q = q * t + (-0.142248368f); q = q * t + 0.127414796f; q = q * t;
    const f32x2 s = (v * v) * (-0.72134752044f);
    f32x2 e; e.x = __builtin_amdgcn_exp2f(s.x); e.y = __builtin_amdgcn_exp2f(s.y);
    return v * 0.5f + av * (0.5f - q * e);
}
struct EpiProj {
    static constexpr bool PERM = true; static constexpr int NPRE = 0;
    bf16_t* O; int ldc; int ngelu;
    __device__ __forceinline__ const float* pre_src(const Unit&, int) const { return nullptr; }
    __device__ __forceinline__ void operator()(const f32x4 (&acc)[2][2][4][2], const Unit& u, int wr, int wc, int fr, int fq, const LAS float*) const {
        const int row0 = u.pm * BM + wr * 64 + fr, col0 = u.pn * BM + wc * 32 + 8 * fq; const bool act = u.pn < ngelu;
#pragma unroll
        for (int ai = 0; ai < 2; ++ai)
#pragma unroll
            for (int m = 0; m < 4; ++m) { bf16_t* rowp = O + (size_t)(row0 + ai * HALF + m * 16) * ldc + col0;
#pragma unroll
                for (int bj = 0; bj < 2; ++bj) { f32x4 v0 = acc[ai][bj][m][0], v1 = acc[ai][bj][m][1];
                    if (act) { f32x2 a = gelu_pk((f32x2){v0[0], v0[1]}), b = gelu_pk((f32x2){v0[2], v0[3]}), c = gelu_pk((f32x2){v1[0], v1[1]}), d = gelu_pk((f32x2){v1[2], v1[3]});
                        v0 = (f32x4){a.x, a.y, b.x, b.y}; v1 = (f32x4){c.x, c.y, d.x, d.y}; }
                    u32x4 w; w.x = cvt_pk_bf16(v0[0], v0[1]); w.y = cvt_pk_bf16(v0[2], v0[3]); w.z = cvt_pk_bf16(v1[0], v1[1]); w.w = cvt_pk_bf16(v1[2], v1[3]);
                    *(u32x4*)(rowp + bj * HALF) = w; } }
    }
};
struct EpiResF32 {
    static constexpr bool PERM = false; static constexpr int NPRE = 0;
    const float* base; float* out; int ldc;
    __device__ __forceinline__ const float* pre_src(const Unit&, int) const { return nullptr; }
    __device__ __forceinline__ void operator()(const f32x4 (&acc)[2][2][4][2], const Unit& u, int wr, int wc, int fr, int fq, const LAS float*) const {
        const int col0 = u.pn * BM + wc * 32 + 4 * fq;
#pragma unroll
        for (int ai = 0; ai < 2; ++ai) { f32x4 bs[4][2][2];
#pragma unroll
            for (int m = 0; m < 4; ++m) { const size_t off = (size_t)(u.pm * BM + ai * HALF + wr * 64 + m * 16 + fr) * ldc + col0;
#pragma unroll
                for (int bj = 0; bj < 2; ++bj)
#pragma unroll
                    for (int n = 0; n < 2; ++n) bs[m][bj][n] = __builtin_nontemporal_load((const f32x4*)(base + off + bj * HALF + n * 16)); }
#pragma unroll
            for (int m = 0; m < 4; ++m) { const size_t off = (size_t)(u.pm * BM + ai * HALF + wr * 64 + m * 16 + fr) * ldc + col0;
#pragma unroll
                for (int bj = 0; bj < 2; ++bj)
#pragma unroll
                    for (int n = 0; n < 2; ++n) *(f32x4*)(out + off + bj * HALF + n * 16) = bs[m][bj][n] + acc[ai][bj][m][n]; } }
    }
};
struct EpiSwiglu {
    static constexpr bool PERM = true; static constexpr int NPRE = 4;
    unsigned char* O; const float* b1; const LAS unsigned char* texp; bool plain;
    __device__ __forceinline__ const float* pre_src(const Unit& u, int w) const { return b1 + (size_t)texp[u.pm] * NHID + u.pn * BM + w * 64; }
    __device__ __forceinline__ void operator()(const f32x4 (&acc)[2][2][4][2], const Unit& u, int wr, int wc, int fr, int fq, const LAS float* pre) const {
        const int row0 = u.pm * BM + wr * 64 + fr, oc0 = u.pn * HALF + wc * 32 + 8 * fq;
        const LAS f32x4* bp = (const LAS f32x4*)(pre + 2 * (wc * 32 + 8 * fq));
        constexpr float CG = -1.702f * 1.4426950408889634f;
        f32x4 bg[2], bl[2];
#pragma unroll
        for (int n = 0; n < 2; ++n) { const f32x4 x0 = bp[2 * n], x1 = bp[2 * n + 1]; bg[n] = (f32x4){x0[0], x0[2], x1[0], x1[2]} * CG; bl[n] = ((f32x4){x0[1], x0[3], x1[1], x1[3]} + 1.0f) * (FP8_SA / CG); }
#pragma unroll
        for (int ai = 0; ai < 2; ++ai)
#pragma unroll
            for (int mp = 0; mp < 4; mp += 2) { u32x2 wq[2];
#pragma unroll
              for (int mq = 0; mq < 2; ++mq) { const int m = mp + mq; float o[8];
#pragma unroll
                for (int n = 0; n < 2; ++n) { const f32x4 g = acc[ai][0][m][n] * (CG / FP8_SW) + bg[n], l = acc[ai][1][m][n] * (FP8_SA / (CG * FP8_SW)) + bl[n];
#pragma unroll
                    for (int q = 0; q < 4; ++q) { const float t = fmaxf(g[q], 7.0f * CG), u = __builtin_amdgcn_fmed3f(l[q], 8.0f * FP8_SA / CG, -6.0f * FP8_SA / CG);
                        o[4 * n + q] = (t * __builtin_amdgcn_rcpf(1.0f + __builtin_amdgcn_exp2f(t))) * u; } }
                { unsigned w0 = 0u; w0 = __builtin_amdgcn_cvt_pk_fp8_f32(o[0], o[1], w0, false); w0 = __builtin_amdgcn_cvt_pk_fp8_f32(o[2], o[3], w0, true); wq[mq].x = w0; }
                { unsigned w1 = 0u; w1 = __builtin_amdgcn_cvt_pk_fp8_f32(o[4], o[5], w1, false); w1 = __builtin_amdgcn_cvt_pk_fp8_f32(o[6], o[7], w1, true); wq[mq].y = w1; } }
              const u32x4 w16 = widen16(wq[0], wq[1]);
              unsigned char* rowp = O + (size_t)(row0 + ai * HALF + (mp + (fq & 1)) * 16) * DEXP + (oc0 - 8 * (fq & 1));
              if (plain) *(u32x4*)rowp = w16; else asm volatile("global_store_dwordx4 %0, %1, off sc1\n\ts_nop 4" :: "v"(rowp), "v"(w16) : "memory"); }
    }
};
struct EpiGate {
    static constexpr bool PERM = true; static constexpr int NPRE = 4;
    unsigned char* O; const float* b2; const LAS unsigned char* texp;
    __device__ __forceinline__ const float* pre_src(const Unit& u, int w) const { return w < 4 ? b2 + (size_t)texp[u.pm] * D + u.pn * BM + w * 64 : nullptr; }
    __device__ __forceinline__ void operator()(const f32x4 (&acc)[2][2][4][2], const Unit& u, int wr, int wc, int fr, int fq, const LAS float* pre) const {
        const int row0 = u.pm * BM + wr * 64 + fr, col0 = u.pn * BM + wc * 32 + 8 * fq;
        f32x4 bv[2][2];
#pragma unroll
        for (int bj = 0; bj < 2; ++bj)
#pragma unroll
            for (int n = 0; n < 2; ++n) bv[bj][n] = *(const LAS f32x4*)(pre + wc * 32 + 8 * fq + bj * HALF + 4 * n) * FP8_SY;
#pragma unroll
        for (int ai = 0; ai < 2; ++ai)
#pragma unroll
            for (int mp = 0; mp < 4; mp += 2) {
                unsigned char* rowp = O + (size_t)(row0 + ai * HALF + (mp + (fq & 1)) * 16) * D + (col0 - 8 * (fq & 1));
#pragma unroll
                for (int bj = 0; bj < 2; ++bj) { u32x2 w[2];
#pragma unroll
                    for (int q = 0; q < 2; ++q) { const f32x4 v0 = acc[ai][bj][mp + q][0] * (FP8_SY / (FP8_SW * FP8_SA)) + bv[bj][0], v1 = acc[ai][bj][mp + q][1] * (FP8_SY / (FP8_SW * FP8_SA)) + bv[bj][1];
                        w[q].x = pk4_fp8(v0[0], v0[1], v0[2], v0[3]); w[q].y = pk4_fp8(v1[0], v1[1], v1[2], v1[3]); }
                    *(u32x4*)(rowp + bj * HALF) = widen16(w[0], w[1]); } }
    }
};
struct EpiChain {
    static constexpr bool PERM = true; static constexpr int NPRE = 8;
    EpiSwiglu e1; EpiGate e2;
    __device__ __forceinline__ const float* pre_src(const Unit& u, int w) const { return w < 4 ? (u.kind ? e2.pre_src(u, w) : e1.pre_src(u, w)) : nullptr; }
    __device__ __forceinline__ void operator()(const f32x4 (&acc)[2][2][4][2], const Unit& u, int wr, int wc, int fr, int fq, const LAS float* pre) const {
        if (u.kind) e2(acc, u, wr, wc, fr, fq, pre); else e1(acc, u, wr, wc, fr, fq, pre); }
};

typedef int v8i32 __attribute__((ext_vector_type(8)));
template <class Epi, class Sched, bool GATHER, bool FP8 = false>
__device__ __forceinline__ void gemm_phase(LAS unsigned char* lds, const Gemm g, const Sched& S, const Epi& E) {
    const int tid = threadIdx.x, wid = __builtin_amdgcn_readfirstlane(tid >> 6), lane = tid & 63, wr = wid >> 2, wc = wid & 3, fr = lane & 15, fq = lane >> 4;
    const int K = FP8 ? g.K : g.K * 2  , nt = K / (BK * 2);
    unsigned voffA[2], voffB[2]; int rA[2];
#pragma unroll
    for (int i = 0; i < 2; ++i) { int R, C; stage_rc(tid * 16 + i * 8192, R, C); const int Rb = Epi::PERM ? ((R & ~31) + perm32(R & 31)) : R;
        voffA[i] = GATHER ? (unsigned)(C * 2) : (unsigned)(R * K + C * 2); voffB[i] = (unsigned)(Rb * K + C * 2); rA[i] = R; }
    const size_t kstep = (size_t)(BK * 2);
    const size_t hstep = (size_t)HALF * K;
    const unsigned ldsw = (unsigned)wid * 1024u;
    const int aoff0 = lds_byte(wr * 64 + fr, fq * 8), aoff1 = aoff0 + 1024;
    const int boff0 = lds_byte(wc * 32 + fr, fq * 8), boff1 = boff0 + 1024;
    LAS unsigned* tab = (LAS unsigned*)(lds + TAB_OFF);
#define PG8_SA(b, h) (((b) * 2 + (h)) * HTB)
#define PG8_SB(b, h) ((4 + (b) * 2 + (h)) * HTB)
#define PG8_STAGE(bufoff, gbase, voff) do { _Pragma("unroll") for (int _i = 0; _i < 2; ++_i) \
        __builtin_amdgcn_global_load_lds((const unsigned*)((const char*)(gbase) + (voff)[_i]), (LAS unsigned*)(lds + (bufoff) + ldsw + _i * 8192), 16, 0, 0); } while (0)
#define PG8_STAGE_A(bufoff, gbase, h, sl) do { if constexpr (GATHER) { _Pragma("unroll") for (int _i = 0; _i < 2; ++_i) { const unsigned _ro = tab[(sl) * 256 + (h) * 128 + rA[_i]]; \
        __builtin_amdgcn_global_load_lds((const unsigned*)((const char*)(gbase) + _ro + voffA[_i]), (LAS unsigned*)(lds + (bufoff) + ldsw + _i * 8192), 16, 0, 0); } } \
        else { PG8_STAGE(bufoff, (const char*)(gbase) + (h) * hstep, voffA); } } while (0)
#define PG8_LDA(dst, b, h) do { _Pragma("unroll") for (int m = 0; m < 4; ++m) { dst[m][0] = *(const LAS bf16x8*)(lds + PG8_SA(b, h) + aoff0 + m * 2048); dst[m][1] = *(const LAS bf16x8*)(lds + PG8_SA(b, h) + aoff1 + m * 2048); } } while (0)
#define PG8_LDB(dst, b, h) do { _Pragma("unroll") for (int n = 0; n < 2; ++n) { dst[n][0] = *(const LAS bf16x8*)(lds + PG8_SB(b, h) + boff0 + n * 2048); dst[n][1] = *(const LAS bf16x8*)(lds + PG8_SB(b, h) + boff1 + n * 2048); } } while (0)
#define PG8_CAT(x) __builtin_bit_cast(v8i32, __builtin_shufflevector((x)[0], (x)[1], 0, 1, 2, 3, 4, 5, 6, 7, 8, 9, 10, 11, 12, 13, 14, 15))
#define PG8_MMA(ai, bj, At, Bt) do { __builtin_amdgcn_s_setprio(1); _Pragma("unroll") for (int m = 0; m < 4; ++m) _Pragma("unroll") for (int n = 0; n < 2; ++n) { \
        if constexpr (FP8) acc[ai][bj][m][n] = __builtin_amdgcn_mfma_scale_f32_16x16x128_f8f6f4(PG8_CAT(Bt[n]), PG8_CAT(At[m]), acc[ai][bj][m][n], 0, 0, 0, 0x7f7f7f7f, 0, 0x7f7f7f7f); \
        else { _Pragma("unroll") for (int k = 0; k < 2; ++k) acc[ai][bj][m][n] = __builtin_amdgcn_mfma_f32_16x16x32_bf16(Bt[n][k], At[m][k], acc[ai][bj][m][n], 0, 0, 0); } } \
        __builtin_amdgcn_s_setprio(0); \
        if constexpr (FP8) { _Pragma("unroll") for (int m = 0; m < 4; ++m) asm volatile("" : "+v"(acc[ai][bj][m][0]), "+v"(acc[ai][bj][m][1])); } } while (0)
#define PG8_WAIT_V(n) asm volatile("s_waitcnt vmcnt(" #n ")" ::: "memory")
#define PG8_WAIT_L(n) asm volatile("s_waitcnt lgkmcnt(" #n ")" ::: "memory")
#define PG8_BAR __builtin_amdgcn_s_barrier()
#define PG8_SCHED __builtin_amdgcn_sched_barrier(0)
#define PG8_SCHF do { if constexpr (FP8) __builtin_amdgcn_sched_barrier(0); } while (0)
    Unit cur, nxt; int ui = 0;
    if (!S.next(0, cur)) return;
    f32x4 acc[2][2][4][2];
#pragma unroll
    for (int a = 0; a < 2; ++a)
#pragma unroll
        for (int b = 0; b < 2; ++b)
#pragma unroll
            for (int m = 0; m < 4; ++m)
#pragma unroll
                for (int n = 0; n < 2; ++n) acc[a][b][m][n] = (f32x4){0.f, 0.f, 0.f, 0.f};
    bf16x8 At[4][2], B0[2][2], B1[2][2];
    const char* cA = S.a_ptr(g, cur); const char* cB = S.b_ptr(g, cur);
    if constexpr (Sched::CHAIN) { if (cur.kind) S.dep_block(cur.pm); }
    if constexpr (GATHER) {
        if (tid < 256) tab[tid] = S.row_off(cur, tid);
        WG_BAR();
    }
    PG8_STAGE(PG8_SB(0, 0), cB, voffB); PG8_STAGE(PG8_SB(0, 1), cB + hstep, voffB); PG8_STAGE_A(PG8_SA(0, 0), cA, 0, 0); PG8_STAGE_A(PG8_SA(0, 1), cA, 1, 0);
    if (wr == 1) PG8_BAR;
    PG8_WAIT_V(2); PG8_BAR;
    PG8_STAGE(PG8_SB(1, 0), cB + kstep, voffB); PG8_STAGE_A(PG8_SA(1, 0), cA + kstep, 0, 0); PG8_STAGE(PG8_SB(1, 1), cB + hstep + kstep, voffB);
    PG8_WAIT_V(6); PG8_BAR;
#define PG8_PRE_BIAS(u, slot) do { if constexpr (Epi::NPRE > 0) { const float* _src = E.pre_src(u, wid); \
        if (_src) __builtin_amdgcn_global_load_lds((const unsigned*)(_src + lane), (LAS unsigned*)(lds + PRE_OFF + (slot) * 2048 + wid * 256), 4, 0, 0); } } while (0)
#define PG8_PRE_TAB(u, slot) do { if constexpr (GATHER) { if constexpr (Sched::CHAIN) { \
            if ((u).kind) { if (tid < 256) tab[(slot) * 256 + tid] = (unsigned)((u).pm * BM + tid) << 10; \
                __builtin_amdgcn_global_load_lds((const unsigned*)(S.cnt + (u).pm), (LAS unsigned*)(lds + DEP_OFF + wid * 256), 4, 0, 16); } \
            else if (wid < 4) __builtin_amdgcn_global_load_lds((const unsigned*)(S.rowtok + (u).pm * BM + wid * 64 + lane), (LAS unsigned*)(lds + TAB_OFF + ((slot) * 256 + wid * 64) * 4), 4, 0, 0); } \
        else { if (tid < 256) tab[(slot) * 256 + tid] = S.row_off(u, tid); } } } while (0)
    bool has_next = S.next(1, nxt);
    PG8_PRE_BIAS(cur, 0);
    if (has_next) PG8_PRE_TAB(nxt, 1);
    for (;;) {
        const int sc = ui & 1, sn = has_next ? ((ui + 1) & 1) : sc;
        const char* nA = has_next ? S.a_ptr(g, nxt) : cA; const char* nB = has_next ? S.b_ptr(g, nxt) : cB;
        bool dep = false;
        if constexpr (Sched::CHAIN) dep = has_next && nxt.kind;
        for (int t = 0; t < nt; t += 2) {
            const bool last = (t == nt - 2);
            if constexpr (Sched::CHAIN) { if (last && dep) { if (__builtin_amdgcn_readfirstlane(*(const LAS unsigned*)(lds + DEP_OFF + wid * 256 + lane * 4)) < 64u) S.dep_block(nxt.pm); } }
            const char* a1 = cA + (size_t)(t + 1) * kstep;
            const char* a2 = last ? nA : cA + (size_t)(t + 2) * kstep; const char* b2 = last ? nB : cB + (size_t)(t + 2) * kstep;
            const char* a3 = a2 + kstep; const char* b3 = b2 + kstep;
            const int s2 = last ? sn : sc;
            PG8_LDB(B0, 0, 0); PG8_LDB(B1, 0, 1); PG8_SCHED; PG8_LDA(At, 0, 0); PG8_STAGE_A(PG8_SA(1, 1), a1, 1, sc);
            PG8_WAIT_V(8); PG8_WAIT_L(0); PG8_BAR; PG8_SCHF; PG8_MMA(0, 0, At, B0); PG8_MMA(0, 1, At, B1); PG8_BAR; PG8_SCHED;
            PG8_LDA(At, 0, 1); PG8_STAGE(PG8_SB(0, 0), b2, voffB); PG8_STAGE(PG8_SB(0, 1), b2 + hstep, voffB); PG8_STAGE_A(PG8_SA(0, 0), a2, 0, s2);
            PG8_WAIT_V(8); PG8_WAIT_L(0); PG8_BAR; PG8_SCHF; PG8_MMA(1, 0, At, B0); PG8_MMA(1, 1, At, B1); PG8_BAR; PG8_SCHED;
            PG8_LDB(B0, 1, 0); PG8_LDB(B1, 1, 1); PG8_SCHED; PG8_LDA(At, 1, 0); PG8_STAGE_A(PG8_SA(0, 1), a2, 1, s2);
            PG8_WAIT_V(8); PG8_WAIT_L(0); PG8_BAR; PG8_SCHF; PG8_MMA(0, 0, At, B0); PG8_MMA(0, 1, At, B1); PG8_BAR; PG8_SCHED;
            PG8_LDA(At, 1, 1); PG8_STAGE(PG8_SB(1, 0), b3, voffB); PG8_STAGE(PG8_SB(1, 1), b3 + hstep, voffB); PG8_STAGE_A(PG8_SA(1, 0), a3, 0, s2);
            PG8_WAIT_V(8); PG8_WAIT_L(0); PG8_BAR; PG8_SCHF; PG8_MMA(1, 0, At, B0); PG8_MMA(1, 1, At, B1); PG8_BAR; PG8_SCHED;
        }
        if (wr == 0) PG8_BAR;
        Unit nn; const bool has_nn = has_next && S.next(ui + 2, nn);
        if (has_next) PG8_PRE_BIAS(nxt, sn);
        if (has_nn) PG8_PRE_TAB(nn, sc);
        E(acc, cur, wr, wc, fr, fq, (const LAS float*)(lds + PRE_OFF + sc * 2048));
        if constexpr (Sched::CHAIN) { if (!cur.kind) { asm volatile("s_waitcnt vmcnt(0)" ::: "memory");
            if (lane == 0) __hip_atomic_fetch_add(S.cnt + cur.pm, 1u, __ATOMIC_RELAXED, __HIP_MEMORY_SCOPE_AGENT); } }
        if (!has_next) break;
#pragma unroll
        for (int a = 0; a < 2; ++a)
#pragma unroll
            for (int b = 0; b < 2; ++b)
#pragma unroll
                for (int m = 0; m < 4; ++m)
#pragma unroll
                    for (int n = 0; n < 2; ++n) acc[a][b][m][n] = (f32x4){0.f, 0.f, 0.f, 0.f};
        cur = nxt; nxt = nn; has_next = has_nn; cA = nA; cB = nB; ++ui;
        if (wr == 1) PG8_BAR;
    }
    PG8_WAIT_V(0);
    PG8_BAR;
#undef PG8_PRE_BIAS
#undef PG8_PRE_TAB
#undef PG8_SA
#undef PG8_SB
#undef PG8_STAGE
#undef PG8_STAGE_A
#undef PG8_LDA
#undef PG8_LDB
#undef PG8_MMA
#undef PG8_CAT
#undef PG8_WAIT_V
#undef PG8_WAIT_L
#undef PG8_BAR
#undef PG8_SCHED
#undef PG8_SCHF
}
}

#define XB_TMO      128
#define XB_XCNT(j)  (256  + 64 * (j))
#define XB_XSUB(j)  (1280 + 64 * (j))
#define XB_XGEN(j)  (2304 + 64 * (j))
#define XB_TOP      3328
#define XB_TOPGEN   3392
#define XCD_BAR_WORDS 3456
#define XB_SPIN_CAP (1u << 18)
__device__ __forceinline__ unsigned xb_ld(unsigned* p)              { return __hip_atomic_load(p, __ATOMIC_RELAXED, __HIP_MEMORY_SCOPE_AGENT); }
__device__ __forceinline__ unsigned xb_add(unsigned* p, unsigned v) { return __hip_atomic_fetch_add(p, v, __ATOMIC_RELAXED, __HIP_MEMORY_SCOPE_AGENT); }
__device__ __forceinline__ unsigned xb_xcc_id() { return (unsigned)__builtin_amdgcn_s_getreg((3 << 11) | 20) & 0xFu; }
#define XB_SPIN(cond, bar) do { unsigned _sp = 0; while (cond) { __builtin_amdgcn_s_sleep(8);     \
    if ((++_sp & 255u) == 0u) { if (xb_ld(&(bar)[XB_TMO])) break; if (_sp > XB_SPIN_CAP) { atomicAdd(&(bar)[XB_TMO], 1u); break; } } } } while (0)
struct XcdBarrier { unsigned* bar; unsigned x; volatile LAS unsigned* st; };
__device__ __forceinline__ XcdBarrier xcd_barrier_post(unsigned* bar, volatile LAS unsigned* st) {
    XcdBarrier b; b.bar = bar; b.x = xb_xcc_id(); b.st = st;
    if (threadIdx.x == 0) (void)xb_add(&bar[XB_XCNT(b.x)], 1u);
    return b;
}
__device__ __forceinline__ void xcd_barrier_complete(unsigned* bar, unsigned x, unsigned& nloc, unsigned& nx) {
    const unsigned G = gridDim.x * gridDim.y * gridDim.z;
    unsigned sum, cnt, mine, sp = 0u;
    for (;;) {
        sum = 0u; cnt = 0u; mine = 0u;
#pragma unroll
        for (unsigned j = 0; j < 16; ++j) { const unsigned c = xb_ld(&bar[XB_XCNT(j)]); sum += c; cnt += (c > 0u) ? 1u : 0u; mine = (j == x) ? c : mine; }
        if (sum == G) break;
        __builtin_amdgcn_s_sleep(1);
        if ((++sp & 255u) == 0u) { if (xb_ld(&bar[XB_TMO])) break; if (sp > XB_SPIN_CAP) { atomicAdd(&bar[XB_TMO], 1u); break; } }
    }
    nloc = mine > 0u ? mine : 1u; nx = cnt > 0u ? cnt : 1u;
}
__device__ __forceinline__ void xcd_barrier(const XcdBarrier& b) {
    asm volatile("s_waitcnt vmcnt(0)" ::: "memory");
    __syncthreads();
    if (threadIdx.x == 0) {
        unsigned* bar = b.bar;
        __builtin_amdgcn_s_waitcnt(0);
        unsigned nloc = b.st[0], nx = b.st[1];
        if (nloc == 0u) { xcd_barrier_complete(bar, b.x, nloc, nx); b.st[0] = nloc; b.st[1] = nx; }
        const unsigned old = xb_add(&bar[XB_XSUB(b.x)], 1u);
        const unsigned gen = old / nloc;
        if (old + 1u == (gen + 1u) * nloc) {
            __builtin_amdgcn_fence(__ATOMIC_RELEASE, "agent");
            asm volatile("s_waitcnt vmcnt(0)" ::: "memory");
            const unsigned og = xb_add(&bar[XB_TOP], 1u);
            const unsigned tg = og / nx;
            if (og + 1u == (tg + 1u) * nx) xb_add(&bar[XB_TOPGEN], 1u);
            else XB_SPIN(xb_ld(&bar[XB_TOPGEN]) == tg, bar);
            __builtin_amdgcn_fence(__ATOMIC_ACQUIRE, "agent");
            xb_add(&bar[XB_XGEN(b.x)], 1u);
            asm volatile("s_waitcnt vmcnt(0)" ::: "memory");
        } else {
            XB_SPIN(xb_ld(&bar[XB_XGEN(b.x)]) == gen, bar);
            __builtin_amdgcn_fence(__ATOMIC_ACQUIRE, "agent");
            asm volatile("s_waitcnt vmcnt(0)" ::: "memory");
        }
    }
    __syncthreads();
}

__device__ __forceinline__ void xcd_barrier_arrive(const XcdBarrier& b) {
    asm volatile("s_waitcnt vmcnt(0)" ::: "memory");
    __syncthreads();
    if (threadIdx.x == 0) {
        unsigned* bar = b.bar;
        __builtin_amdgcn_s_waitcnt(0);
        unsigned nloc = b.st[0], nx = b.st[1];
        if (nloc == 0u) { xcd_barrier_complete(bar, b.x, nloc, nx); b.st[0] = nloc; b.st[1] = nx; }
        const unsigned old = xb_add(&bar[XB_XSUB(b.x)], 1u);
        const unsigned gen = old / nloc; unsigned last = 0u, tg = 0u, glast = 0u;
        if (old + 1u == (gen + 1u) * nloc) {
            last = 1u;
            __builtin_amdgcn_fence(__ATOMIC_RELEASE, "agent");
            asm volatile("s_waitcnt vmcnt(0)" ::: "memory");
            const unsigned og = xb_add(&bar[XB_TOP], 1u);
            tg = og / nx;
            if (og + 1u == (tg + 1u) * nx) { glast = 1u; xb_add(&bar[XB_TOPGEN], 1u); }
        }
        b.st[2] = gen; b.st[3] = last; b.st[4] = tg; b.st[5] = glast;
    }
}
__device__ __forceinline__ void xcd_barrier_wait(const XcdBarrier& b) {
    if (threadIdx.x == 0) {
        unsigned* bar = b.bar;
        const unsigned gen = b.st[2], last = b.st[3], tg = b.st[4], glast = b.st[5];
        if (last) {
            if (!glast) XB_SPIN(xb_ld(&bar[XB_TOPGEN]) == tg, bar);
            __builtin_amdgcn_fence(__ATOMIC_ACQUIRE, "agent");
            xb_add(&bar[XB_XGEN(b.x)], 1u);
            asm volatile("s_waitcnt vmcnt(0)" ::: "memory");
        } else {
            XB_SPIN(xb_ld(&bar[XB_XGEN(b.x)]) == gen, bar);
            __builtin_amdgcn_fence(__ATOMIC_ACQUIRE, "agent");
            asm volatile("s_waitcnt vmcnt(0)" ::: "memory");
        }
    }
    __syncthreads();
}

struct Args {
    const float* in[31]; float* out; unsigned char* ws;
    int ph_lo, ph_hi, li, pad;
};
enum { I_X = 0, I_N1G, I_WIN, I_SLNG, I_SLNB, I_SGUW, I_SGUB, I_MURKV, I_MUWAG, I_W0, I_W1, I_W2, I_A0, I_A1, I_A2, I_G1, I_G2, I_KK, I_KA, I_RK, I_LNXG, I_LNXB, I_WOUT, I_N2G, I_RW, I_RB,
       I_MW1, I_MB1, I_MW2, I_MB2, I_FG };

struct Ctx { LAS unsigned char* lds; int tid, lane, wave, G, vcu; unsigned char* ws; const float* const* in; };

template <int KS> __device__ __forceinline__ void mma_nt(f32x4& acc, const LAS bf16_t* X, int ldx, const LAS bf16_t* Y, int ldy, int lane) {
    const LAS bf16_t* xp = X + (lane & 15) * ldx + 8 * (lane >> 4); const LAS bf16_t* yp = Y + (lane & 15) * ldy + 8 * (lane >> 4);
#pragma unroll
    for (int ks = 0; ks < KS; ++ks) { const bf16x8 a = *(const LAS bf16x8*)(xp + 32 * ks), b = *(const LAS bf16x8*)(yp + 32 * ks); acc = __builtin_amdgcn_mfma_f32_16x16x32_bf16(a, b, acc, 0, 0, 0); }
}
template <int KS> __device__ __forceinline__ void mma_nt_gx(f32x4& acc, const bf16_t* X, int ldx, const LAS bf16_t* Y, int ldy, int lane) {
    const bf16_t* xp = X + (size_t)(lane & 15) * ldx + 8 * (lane >> 4); const LAS bf16_t* yp = Y + (lane & 15) * ldy + 8 * (lane >> 4);
#pragma unroll
    for (int ks = 0; ks < KS; ++ks) { const bf16x8 a = *(const bf16x8*)(xp + 32 * ks), b = *(const LAS bf16x8*)(yp + 32 * ks); acc = __builtin_amdgcn_mfma_f32_16x16x32_bf16(a, b, acc, 0, 0, 0); }
}
__device__ __forceinline__ void st4bf(LAS bf16_t* p, const f32x4 v) { u32x2 w; w.x = pk2(v[0], v[1]); w.y = pk2(v[2], v[3]); *(LAS u32x2*)p = w; }

__device__ __forceinline__ void p0_transpose_item(const float* W, int N, bf16_t* WT, int ldo, int row_off, const float* sc, int mode, bool remap, LAS float* scr, int item, int lane) {
    const int nblk = N / 32, kb = item / nblk, nb = item % nblk, k0 = 64 * kb, n0 = 32 * nb;
#pragma unroll 8
    for (int i = 0; i < 32; ++i) { const int kk = 2 * i + (lane >> 5); float v = __builtin_nontemporal_load(W + (size_t)(k0 + kk) * N + n0 + (lane & 31));
        if (mode) { const float s = sc[k0 + kk]; v *= (mode == 1) ? s : (1.0f - s); }
        scr[kk * 33 + (lane & 31)] = v; }
    LDS_WAIT(); asm volatile("" ::: "memory");
    const int c = lane & 7;
#pragma unroll
    for (int j = 0; j < 4; ++j) { const int n = (lane >> 3) + 8 * j; const LAS float* s = scr + (8 * c) * 33 + n;
        u32x4 o; o.x = pk2(s[0 * 33], s[1 * 33]); o.y = pk2(s[2 * 33], s[3 * 33]); o.z = pk2(s[4 * 33], s[5 * 33]); o.w = pk2(s[6 * 33], s[7 * 33]);
        int orow = n0 + n; if (remap) { const int oc = orow >> 1; orow = 256 * (oc >> 7) + 128 * (orow & 1) + (oc & 127); }
        *(u32x4*)(WT + (size_t)(row_off + orow) * ldo + k0 + 8 * c) = o; }
    LDS_WAIT(); asm volatile("" ::: "memory");
}
__device__ __forceinline__ void p0_transpose_item_fp8(const float* W, int N, unsigned char* WT, int ldo, bool remap, LAS float* scr, int item, int lane) {
    const int nblk = N / 32, kb = item / nblk, nb = item % nblk, k0 = 64 * kb, n0 = 32 * nb;
    float tv[32];
#pragma unroll
    for (int i = 0; i < 32; ++i) tv[i] = __builtin_nontemporal_load(W + (size_t)(k0 + 2 * i + (lane >> 5)) * N + n0 + (lane & 31));
#pragma unroll
    for (int i = 0; i < 32; ++i) scr[(2 * i + (lane >> 5)) * 33 + (lane & 31)] = tv[i] * FP8_SW;
    LDS_WAIT(); asm volatile("" ::: "memory");
    const int c = lane & 3;
#pragma unroll
    for (int j = 0; j < 2; ++j) { const int n = (lane >> 2) + 16 * j; const LAS float* sp = scr + (16 * c) * 33 + n;
        u32x4 o; o.x = pk4_fp8(sp[0 * 33], sp[1 * 33], sp[2 * 33], sp[3 * 33]); o.y = pk4_fp8(sp[4 * 33], sp[5 * 33], sp[6 * 33], sp[7 * 33]);
        o.z = pk4_fp8(sp[8 * 33], sp[9 * 33], sp[10 * 33], sp[11 * 33]); o.w = pk4_fp8(sp[12 * 33], sp[13 * 33], sp[14 * 33], sp[15 * 33]);
        int orow = n0 + n; if (remap) { const int oc = orow >> 1; orow = 256 * (oc >> 7) + 128 * (orow & 1) + (oc & 127); }
        *(u32x4*)(WT + (size_t)orow * ldo + k0 + 16 * c) = o; }
    LDS_WAIT(); asm volatile("" ::: "memory");
}
__device__ __forceinline__ void cvt_half_load(float (&tv)[32], const float* W, int N, int k0, int n0, int lane) {
#pragma unroll
    for (int i = 0; i < 32; ++i) tv[i] = __builtin_nontemporal_load(W + (size_t)(k0 + 2 * i + (lane >> 5)) * N + n0 + (lane & 31));
}
__device__ __forceinline__ void cvt_block_store(const float (&ta)[32], const float (&tb)[32], unsigned char* WT, bool remap, int k0, int n0, LAS unsigned* scr, int lane) {
    LAS unsigned* wp = scr + (lane >> 5) * 34 + (lane & 31);
#pragma unroll
    for (int j = 0; j < 8; ++j) wp[(2 * j) * 34] = pk4_fp8(ta[4 * j] * FP8_SW, ta[4 * j + 1] * FP8_SW, ta[4 * j + 2] * FP8_SW, ta[4 * j + 3] * FP8_SW);
#pragma unroll
    for (int j = 0; j < 8; ++j) wp[(2 * j + 16) * 34] = pk4_fp8(tb[4 * j] * FP8_SW, tb[4 * j + 1] * FP8_SW, tb[4 * j + 2] * FP8_SW, tb[4 * j + 3] * FP8_SW);
    LDS_WAIT(); asm volatile("" ::: "memory");
    const int c = lane & 7;
#pragma unroll
    for (int ps = 0; ps < 4; ++ps) { const int n = (lane >> 3) + 8 * ps; const LAS unsigned* rp = scr + (4 * c) * 34 + n;
        const unsigned p00 = rp[0], p01 = rp[34], p10 = rp[68], p11 = rp[102];
        u32x4 o; o.x = __builtin_amdgcn_perm(p01, p00, 0x05010400u); o.y = __builtin_amdgcn_perm(p01, p00, 0x07030602u); o.z = __builtin_amdgcn_perm(p11, p10, 0x05010400u); o.w = __builtin_amdgcn_perm(p11, p10, 0x07030602u);
        int orow = n0 + n; if (remap) { const int oc = orow >> 1; orow = 256 * (oc >> 7) + 128 * (orow & 1) + (oc & 127); }
        __builtin_nontemporal_store(o, (u32x4*)(WT + (size_t)orow * 1024 + k0 + 16 * c)); }
    LDS_WAIT(); asm volatile("" ::: "memory");
}
__device__ __forceinline__ void moe_convert_block(const Ctx& F, int b, LAS unsigned* scr) {
    constexpr int S1 = 8 * 64, S2 = 8 * 32;
    const int e = b / (S1 + S2); int j = b - e * (S1 + S2); const bool k2 = j >= S1; if (k2) j -= S1;
    const float* Wp = k2 ? F.in[I_MW2] + (size_t)e * DEXP * D : F.in[I_MW1] + (size_t)e * D * NHID;
    unsigned char* WT = k2 ? F.ws + WS_W2T + (size_t)e * D * DEXP : F.ws + WS_W1T + (size_t)e * NHID * D;
    const int N = k2 ? D : NHID, nblk = N / 32, k0 = 128 * (j / nblk), n0 = 32 * (j % nblk);
    float ta[32], tb[32];
    cvt_half_load(ta, Wp, N, k0, n0, F.lane); cvt_half_load(tb, Wp, N, k0 + 64, n0, F.lane);
    cvt_block_store(ta, tb, WT, !k2, k0, n0, scr, F.lane);
}
constexpr int MOE_ITEMS = NEXP * (8 * 64 + 8 * 32), MOE_SLICE = 4096, MOE_SKEW = 4096, MOE_EARLY = 4 * MOE_SLICE + MOE_SKEW;
__host__ __device__ constexpr int moe_slice_hi(int j) { return MOE_ITEMS - (j < 3 ? j * MOE_SLICE : j == 3 ? 3 * MOE_SLICE : 3 * MOE_SLICE + MOE_SKEW); }
__host__ __device__ constexpr int moe_slice_lo(int j) { return moe_slice_hi(j) - (j == 3 ? MOE_SKEW : MOE_SLICE); }
__device__ __forceinline__ void moe_weight_phase(const Ctx& F, int lo, int hi) {
    LAS unsigned* scr = (LAS unsigned*)(F.lds + 4096 + F.wave * 16384);
    const int gw = F.vcu * 8 + F.wave, NGW = F.G * 8;
    for (int it = lo + gw; it < hi; it += NGW) { int b_ = it; asm volatile("" : "+s"(b_)); moe_convert_block(F, b_, scr); }
}
__device__ __forceinline__ void moe_weight_half(const Ctx& F, int lo, int hi, int par) {
    if ((F.vcu & 1) != par) return;
    LAS unsigned* scr = (LAS unsigned*)(F.lds + 4096 + F.wave * 16384);
    const int gw = (F.vcu >> 1) * 8 + F.wave, NGW = (F.G >> 1) * 8;
    int it = lo + gw;
    for (; it < hi; it += NGW) { int b_ = it; asm volatile("" : "+s"(b_)); moe_convert_block(F, b_, scr); }
}
__device__ __forceinline__ void moe_weight_skew(const Ctx& F, int lo) {
    LAS unsigned* scr = (LAS unsigned*)(F.lds + 4096 + F.wave * 16384);
    const int seg = F.vcu & 15, n = seg < 5 ? 3 : seg < 11 ? 2 : 1, pre = seg < 5 ? 24 * seg : seg < 11 ? 120 + 16 * (seg - 5) : 216 + 8 * (seg - 11);
    const int base = lo + (F.vcu >> 4) * 256 + pre + F.wave * n;
    for (int j = 0; j < n; ++j) { int b_ = base + j; asm volatile("" : "+s"(b_)); moe_convert_block(F, b_, scr); }
}
__device__ __forceinline__ void p0_prologue(const Ctx& F) {
    LAS float* scr = (LAS float*)(F.lds + F.wave * 16384);
    const int gw = F.vcu * 8 + F.wave, NGW = F.G * 8, lane = F.lane;
    unsigned char* ws = F.ws;
    bf16_t* WCAT = (bf16_t*)(ws + WS_WCAT);
    constexpr int I_WIN_N = 16 * 80, I_L64 = 16 * 2, I_L128 = 16 * 4, I_WO = 16 * 32, I_M1 = 16 * 64, I_M2 = 16 * 32, I_S64 = 1 * 16, I_S128 = 2 * 16;
    constexpr int N_SMALL = I_WIN_N + 4 * I_L64 + 2 * I_L128 + I_WO + 2 * I_S64 + I_S128;
    constexpr int NITEMS = N_SMALL;
    const float* mu_wag = F.in[I_MUWAG];
    for (int it = gw; it < NITEMS; it += NGW) {
        int r = it;
        if (r < I_WIN_N) { p0_transpose_item(F.in[I_WIN], 2560, WCAT, D, 0, nullptr, 0, false, scr, r, lane); continue; } r -= I_WIN_N;
        if (r < I_L64) { p0_transpose_item(F.in[I_W1], 64, WCAT, D, COL_LA + 0, mu_wag + 0 * D, 2, false, scr, r, lane); continue; } r -= I_L64;
        if (r < I_L64) { p0_transpose_item(F.in[I_W1], 64, WCAT, D, COL_LB + 0, mu_wag + 0 * D, 1, false, scr, r, lane); continue; } r -= I_L64;
        if (r < I_L64) { p0_transpose_item(F.in[I_A1], 64, WCAT, D, COL_LA + 64, mu_wag + 1 * D, 2, false, scr, r, lane); continue; } r -= I_L64;
        if (r < I_L64) { p0_transpose_item(F.in[I_A1], 64, WCAT, D, COL_LB + 64, mu_wag + 1 * D, 1, false, scr, r, lane); continue; } r -= I_L64;
        if (r < I_L128) { p0_transpose_item(F.in[I_G1], 128, WCAT, D, COL_LA + 128, mu_wag + 2 * D, 2, false, scr, r, lane); continue; } r -= I_L128;
        if (r < I_L128) { p0_transpose_item(F.in[I_G1], 128, WCAT, D, COL_LB + 128, mu_wag + 2 * D, 1, false, scr, r, lane); continue; } r -= I_L128;
        if (r < I_WO) { p0_transpose_item(F.in[I_WOUT], D, (bf16_t*)(ws + WS_WOUT), D, 0, nullptr, 0, false, scr, r, lane); continue; } r -= I_WO;
        if (r < I_S64) { p0_transpose_item(F.in[I_W2], 512, (bf16_t*)(ws + WS_LW2), 64, 0, nullptr, 0, false, scr, r, lane); continue; } r -= I_S64;
        if (r < I_S64) { p0_transpose_item(F.in[I_A2], 512, (bf16_t*)(ws + WS_LA2), 64, 0, nullptr, 0, false, scr, r, lane); continue; } r -= I_S64;
        p0_transpose_item(F.in[I_G2], 512, (bf16_t*)(ws + WS_LG2), 128, 0, nullptr, 0, false, scr, r, lane);
    }
    const int gt = F.vcu * 512 + F.tid, NGT = F.G * 512;
    { bf16_t* SW = (bf16_t*)(ws + WS_SGUW); const float* w = F.in[I_SGUW];
      for (int i = gt; i < 8 * 128 * 128; i += NGT) { const int qi = (i >> 7) & 127, kj = i & 127; SW[i] = (bf16_t)(((kj >> 6) <= (qi >> 6)) ? f2bf(w[i]) : 0u); } }
    { float* RW = (float*)(ws + WS_RW); const float* w = F.in[I_RW]; const float* g = F.in[I_N2G];
      for (int i = gt; i < D * NEXP; i += NGT) RW[i] = w[i] * g[i >> 5]; }
    { int* rt = (int*)(ws + WS_ROWTOK);
      for (int i = gt; i < MAXROWS; i += NGT) rt[i] = 0; }
    { const float* g1 = F.in[I_N1G]; f32x4 gv[4];
#pragma unroll
      for (int j = 0; j < 4; ++j) gv[j] = *((const f32x4*)g1 + lane + 64 * j);
      for (int m = gw; m < M; m += NGW) {
          const f32x4* xr = (const f32x4*)(F.in[I_X] + (size_t)m * D) + lane; f32x4 v[4]; float s = 0.f;
#pragma unroll
          for (int j = 0; j < 4; ++j) { v[j] = __builtin_nontemporal_load(xr + 64 * j); s += (v[j].x * v[j].x + v[j].y * v[j].y) + (v[j].z * v[j].z + v[j].w * v[j].w); }
          const float rstd = __builtin_amdgcn_rsqf(wave_sum(s) * (1.0f / D) + 1e-5f);
          u32x2* o8 = (u32x2*)((bf16_t*)(ws + WS_XN) + (size_t)m * D) + lane;
#pragma unroll
          for (int j = 0; j < 4; ++j) { u32x2 w; w.x = pk2(v[j].x * rstd * gv[j].x, v[j].y * rstd * gv[j].y); w.y = pk2(v[j].z * rstd * gv[j].z, v[j].w * rstd * gv[j].w); o8[64 * j] = w; }
      } }
}

#define LB() do { asm volatile("s_waitcnt lgkmcnt(0)" ::: "memory"); __builtin_amdgcn_s_barrier(); asm volatile("" ::: "memory"); } while (0)
typedef short v4i16_t __attribute__((ext_vector_type(4)));
__device__ __forceinline__ bf16x8 tr_frag(const LAS bf16_t* base, int ld, int lane) {
    const LAS bf16_t* a = base + (8 * (lane >> 4) + ((lane & 15) >> 2)) * ld + 4 * (lane & 3);
    const v4i16_t lo = __builtin_amdgcn_ds_read_tr16_b64_v4i16((LAS v4i16_t*)a), hi = __builtin_amdgcn_ds_read_tr16_b64_v4i16((LAS v4i16_t*)(a + 4 * ld));
    return __builtin_shufflevector(lo, hi, 0, 1, 2, 3, 4, 5, 6, 7);
}
template <int KS> __device__ __forceinline__ void mma_tx(f32x4& acc, const LAS bf16_t* XR, int ldx, const LAS bf16_t* Y, int ldy, int lane) {
    const LAS bf16_t* yp = Y + (lane & 15) * ldy + 8 * (lane >> 4);
#pragma unroll
    for (int ks = 0; ks < KS; ++ks) { const bf16x8 a = tr_frag(XR + 32 * ks * ldx, ldx, lane), b = *(const LAS bf16x8*)(yp + 32 * ks); acc = __builtin_amdgcn_mfma_f32_16x16x32_bf16(a, b, acc, 0, 0, 0); }
}
template <int KS> __device__ __forceinline__ void mma_ty(f32x4& acc, const LAS bf16_t* X, int ldx, const LAS bf16_t* YR, int ldy, int lane) {
    const LAS bf16_t* xp = X + (lane & 15) * ldx + 8 * (lane >> 4);
#pragma unroll
    for (int ks = 0; ks < KS; ++ks) { const bf16x8 a = *(const LAS bf16x8*)(xp + 32 * ks), b = tr_frag(YR + 32 * ks * ldy, ldy, lane); acc = __builtin_amdgcn_mfma_f32_16x16x32_bf16(a, b, acc, 0, 0, 0); }
}
template <int KS> __device__ __forceinline__ void mma_rx(f32x4& acc, const bf16x8 (&xf)[KS], const LAS bf16_t* Y, int ldy, int lane) {
    const LAS bf16_t* yp = Y + (lane & 15) * ldy + 8 * (lane >> 4);
#pragma unroll
    for (int ks = 0; ks < KS; ++ks) { const bf16x8 b = *(const LAS bf16x8*)(yp + 32 * ks); acc = __builtin_amdgcn_mfma_f32_16x16x32_bf16(xf[ks], b, acc, 0, 0, 0); }
}

__device__ __forceinline__ void sgu_phase(const Ctx& F) {
    const int w = F.wave;
    const bf16_t* PROJ = (const bf16_t*)(F.ws + WS_PROJ); bf16_t* YCAT = (bf16_t*)(F.ws + WS_YCAT); const bf16_t* SW = (const bf16_t*)(F.ws + WS_SGUW);
    LAS bf16_t* vn = (LAS bf16_t*)F.lds;
    constexpr int LDV = 264;
    for (int unit = F.vcu; unit < 256; unit += F.G) {
        int tv_ = F.tid; asm volatile("" : "+v"(tv_)); const int lane = tv_ & 63;
        const int nb = unit >> 1, hh = unit & 1, m0 = nb * 128;
        float lg[8], lb[8];
#pragma unroll
        for (int q = 0; q < 8; ++q) { lg[q] = F.in[I_SLNG][lane * 8 + q]; lb[q] = F.in[I_SLNB][lane * 8 + q]; }
        const int hl = w >> 1, ih = w & 1, h = hh * 4 + hl;
        u32x4 raw[16];
#pragma unroll
        for (int rr = 0; rr < 16; ++rr) raw[rr] = *(const u32x4*)(PROJ + (size_t)(m0 + w * 16 + rr) * NPROJ + COL_V + lane * 8);
        bf16x8 bfr[4][4]; u32x2 ur[4][4]; float bsv[4];
#pragma unroll
        for (int ks = 0; ks < 4; ++ks)
#pragma unroll
            for (int it = 0; it < 4; ++it) bfr[ks][it] = *(const bf16x8*)(SW + (size_t)h * 16384 + (ih * 64 + it * 16 + (lane & 15)) * 128 + ks * 32 + 8 * (lane >> 4));
#pragma unroll
        for (int it = 0; it < 4; ++it) { const int i = ih * 64 + it * 16 + (lane & 15); bsv[it] = F.in[I_SGUB][h * 128 + i];
#pragma unroll
            for (int ct = 0; ct < 4; ++ct) ur[it][ct] = *(const u32x2*)(PROJ + (size_t)(m0 + i) * NPROJ + h * 64 + ct * 16 + 4 * (lane >> 4)); }
#pragma unroll
        for (int rr = 0; rr < 16; ++rr) {
            const int pos = w * 16 + rr; float v[8]; unpack8(raw[rr], v);
            float s = 0.f;
#pragma unroll
            for (int q = 0; q < 8; ++q) s += v[q];
            const float mean = wave_sum(s) * (1.0f / 512.0f); float qq = 0.f;
#pragma unroll
            for (int q = 0; q < 8; ++q) { v[q] -= mean; qq += v[q] * v[q]; }
            const float rstd = __builtin_amdgcn_rsqf(wave_sum(qq) * (1.0f / 512.0f) + 1e-5f);
            if ((lane >> 5) == hh) { float o[8];
#pragma unroll
                for (int q = 0; q < 8; ++q) o[q] = v[q] * rstd * lg[q] + lb[q];
                *(LAS u32x4*)(vn + pos * LDV + (lane & 31) * 8) = pack8(o); }
        }
        LB();
        f32x4 acc[4][4];
#pragma unroll
        for (int a = 0; a < 4; ++a)
#pragma unroll
            for (int b = 0; b < 4; ++b) acc[a][b] = (f32x4){0.f, 0.f, 0.f, 0.f};
#pragma unroll
        for (int ks = 0; ks < 4; ++ks) {
            bf16x8 af[4];
#pragma unroll
            for (int ct = 0; ct < 4; ++ct) af[ct] = tr_frag(vn + (32 * ks) * LDV + hl * 64 + ct * 16, LDV, lane);
#pragma unroll
            for (int ct = 0; ct < 4; ++ct)
#pragma unroll
                for (int it = 0; it < 4; ++it) acc[ct][it] = __builtin_amdgcn_mfma_f32_16x16x32_bf16(af[ct], bfr[ks][it], acc[ct][it], 0, 0, 0);
        }
#pragma unroll
        for (int it = 0; it < 4; ++it) { const int i = ih * 64 + it * 16 + (lane & 15); const float bs = bsv[it]; const size_t row = (size_t)(m0 + i);
#pragma unroll
            for (int cp = 0; cp < 4; cp += 2) { u32x2 o[2];
#pragma unroll
                for (int q = 0; q < 2; ++q) { const u32x2 uu = ur[it][cp + q]; const f32x4 a = acc[cp + q][it];
                    o[q].x = pk2(bflo(uu.x) * (a[0] + bs), bfhi(uu.x) * (a[1] + bs)); o[q].y = pk2(bflo(uu.y) * (a[2] + bs), bfhi(uu.y) * (a[3] + bs)); }
                const int gq = lane >> 4, c = h * 64 + (cp + (gq & 1)) * 16 + 4 * (gq & 2);
                *(u32x4*)(YCAT + row * D + c) = widen16(o[0], o[1]); } }
        LB();
    }
}

namespace rk {
constexpr int LD = 72, LDF = 68, LDG = 136, MBY = 64 * LD * 2;
constexpr int O_AT = 0, O_RT = MBY, O_BH = 2 * MBY, O_KH = 3 * MBY, O_V = 4 * MBY, O_TB = 5 * MBY, O_LAK = 6 * MBY, O_MRB = 7 * MBY, O_MRK = 8 * MBY,
              O_ST = 9 * MBY, O_XT = 11 * MBY, O_UT = 13 * MBY, O_WC = 15 * MBY, O_WT = O_WC + 512, O_PAR = O_WT + 2048, O_END = O_PAR + 2560;
static_assert(O_END <= MISC_OFF, "RWKV LDS map");
enum { P_MUR = 0, P_MUK, P_MUV, P_W0, P_A0, P_KK, P_KA, P_RK, P_LG, P_LB };
constexpr size_t CHB = 6 * 4096;
template <int KS> __device__ __forceinline__ void mma_txy(f32x4& acc, const LAS bf16_t* XR, int ldx, const LAS bf16_t* YR, int ldy, int lane) {
#pragma unroll
    for (int ks = 0; ks < KS; ++ks) { const bf16x8 a = tr_frag(XR + 32 * ks * ldx, ldx, lane), b = tr_frag(YR + 32 * ks * ldy, ldy, lane); acc = __builtin_amdgcn_mfma_f32_16x16x32_bf16(a, b, acc, 0, 0, 0); }
}
__device__ __forceinline__ void state_yfrags(const f32x4 (&acc)[4], bf16x8 (&yf)[2]) {
#pragma unroll
    for (int ks = 0; ks < 2; ++ks) { u32x4 wv; wv.x = pk2(acc[2 * ks][0], acc[2 * ks][1]); wv.y = pk2(acc[2 * ks][2], acc[2 * ks][3]); wv.z = pk2(acc[2 * ks + 1][0], acc[2 * ks + 1][1]); wv.w = pk2(acc[2 * ks + 1][2], acc[2 * ks + 1][3]);
        yf[ks] = __builtin_bit_cast(bf16x8, wv); }
}
__device__ __forceinline__ void load_xfrags(u32x2 (&xr)[4][2][2], const bf16_t* mt, int ldm, int lane) {
#pragma unroll
    for (int ct = 0; ct < 4; ++ct)
#pragma unroll
        for (int ks = 0; ks < 2; ++ks)
#pragma unroll
            for (int hf = 0; hf < 2; ++hf) xr[ct][ks][hf] = *(const u32x2*)(mt + (size_t)(16 * ct + (lane & 15)) * ldm + 32 * ks + 16 * hf + 4 * (lane >> 4));
}
__device__ __forceinline__ void load_xfrags_lds(u32x2 (&xr)[4][2][2], const LAS bf16_t* mt, int ldm, int lane) {
#pragma unroll
    for (int ct = 0; ct < 4; ++ct)
#pragma unroll
        for (int ks = 0; ks < 2; ++ks)
#pragma unroll
            for (int hf = 0; hf < 2; ++hf) xr[ct][ks][hf] = *(const LAS u32x2*)(mt + (16 * ct + (lane & 15)) * ldm + 32 * ks + 16 * hf + 4 * (lane >> 4));
}
__device__ __forceinline__ void state_step(f32x4 (&acc)[4], const u32x2 (&xr)[4][2][2]) {
    bf16x8 yf[2]; state_yfrags(acc, yf);
#pragma unroll
    for (int ct = 0; ct < 4; ++ct) { f32x4 d = (f32x4){0.f, 0.f, 0.f, 0.f};
#pragma unroll
        for (int ks = 0; ks < 2; ++ks) { u32x4 xw; xw.x = xr[ct][ks][0].x; xw.y = xr[ct][ks][0].y; xw.z = xr[ct][ks][1].x; xw.w = xr[ct][ks][1].y;
            d = __builtin_amdgcn_mfma_f32_16x16x32_bf16(__builtin_bit_cast(bf16x8, xw), yf[ks], d, 0, 0, 0); }
        acc[ct] = d; }
}
__device__ __forceinline__ f32x4 bf4(const u32x2 w) { return (f32x4){bflo(w.x), bfhi(w.x), bflo(w.y), bfhi(w.y)}; }
__device__ __forceinline__ int frag_off(int row, int col) { return (((row >> 4) * 64 + ((col >> 2) & 3) * 16 + (row & 15)) * 4 + (col >> 4)) * 4 + (col & 3); }
}

__device__ __forceinline__ void rwkv_prep_unit(const Ctx& F, int unit) {
    using namespace rk;
    const int w = F.wave;
    const int b = unit >> 7, h = (unit >> 4) & 7, seg = unit & 15;
    constexpr int NL = 4;
    LAS unsigned char* L = F.lds;
    LAS bf16_t *AT = (LAS bf16_t*)(L + O_AT), *RT = (LAS bf16_t*)(L + O_RT), *BH = (LAS bf16_t*)(L + O_BH), *KH = (LAS bf16_t*)(L + O_KH), *V = (LAS bf16_t*)(L + O_V), *TB = (LAS bf16_t*)(L + O_TB),
                *LAK = (LAS bf16_t*)(L + O_LAK), *MRB = (LAS bf16_t*)(L + O_MRB), *MRK = (LAS bf16_t*)(L + O_MRK), *ST = (LAS bf16_t*)(L + O_ST), *XT = (LAS bf16_t*)(L + O_XT), *UT = (LAS bf16_t*)(L + O_UT);
    LAS bf16_t *DECP = ST, *ICLP = ST + 64 * LD, *LW = XT, *LA = XT + 64 * LD, *BT = XT, *KT = XT + 64 * LD, *LG = UT, *AH = ST, *XL = ST + 64 * LD, *UL = XT, *PHL = UT, *PSL = UT + 64 * LD;
    LAS float *LF = (LAS float*)(L + O_ST), *TF = (LAS float*)(L + O_XT), *TMP = (LAS float*)(L + O_UT), *WC = (LAS float*)(L + O_WC), *WT = (LAS float*)(L + O_WT), *PAR = (LAS float*)(L + O_PAR);
    const bf16_t* PROJ = (const bf16_t*)(F.ws + WS_PROJ);
    bf16_t* SEGP = (bf16_t*)(F.ws + WS_SEGP); float* SEGQ = (float*)(F.ws + WS_SEGQ);
    bf16_t *PHIT = (bf16_t*)(F.ws + WS_PHIT), *PSI = (bf16_t*)(F.ws + WS_PSI), *YSG = (bf16_t*)(F.ws + WS_YS), *YLG = (bf16_t*)(F.ws + WS_YL), *GTG = (bf16_t*)(F.ws + WS_GT), *BVG = (bf16_t*)(F.ws + WS_BV);

    { int tid = F.tid; asm volatile("" : "+v"(tid));
      for (int i = tid; i < 640; i += 512) { const int pv = i >> 6, cc = h * 64 + (i & 63); const float* src;
          switch (pv) { case P_MUR: src = F.in[I_MURKV] + 0 * 512; break; case P_MUK: src = F.in[I_MURKV] + 1 * 512; break; case P_MUV: src = F.in[I_MURKV] + 2 * 512; break; case P_W0: src = F.in[I_W0]; break;
                        case P_A0: src = F.in[I_A0]; break; case P_KK: src = F.in[I_KK]; break; case P_KA: src = F.in[I_KA]; break; case P_RK: src = F.in[I_RK]; break; case P_LG: src = F.in[I_LNXG]; break; default: src = F.in[I_LNXB]; break; }
          PAR[i] = src[cc]; }
    }
    const bf16_t* LW2 = (const bf16_t*)(F.ws + WS_LW2); const bf16_t* LA2 = (const bf16_t*)(F.ws + WS_LA2); const bf16_t* LG2 = (const bf16_t*)(F.ws + WS_LG2);

    f32x4 acc[4];
#pragma unroll
    for (int ct = 0; ct < 4; ++ct) acc[ct] = (f32x4){0.f, 0.f, 0.f, 0.f};
    if (w < 4) { int tv0_ = F.tid; asm volatile("" : "+v"(tv0_)); const int lane = tv0_ & 63;
#pragma unroll
        for (int ct = 0; ct < 4; ++ct)
#pragma unroll
            for (int r = 0; r < 4; ++r) acc[ct][r] = (16 * ct + 4 * (lane >> 4) + r == 16 * w + (lane & 15)) ? 1.0f : 0.0f; }
    LB();

    u32x4 rw_c[3 + NL], rw_p[3 + NL];
    auto load_raw = [&](int c, int tv) {
        const int t = tv >> 3, c0 = (tv & 7) * 8, hc = h * 64 + c0; const int tq0 = (seg * SEGC + c) * CH;
        const bf16_t* rowc = PROJ + ((size_t)b * SEQ + tq0 + t) * NPROJ; const bool hasp = (tq0 + t) > 0; const bf16_t* rowp = hasp ? rowc - NPROJ : rowc;
        rw_c[0] = *(const u32x4*)(rowc + COL_R + hc); rw_c[1] = *(const u32x4*)(rowc + COL_K + hc); rw_c[2] = *(const u32x4*)(rowc + COL_VR + hc);
        rw_p[0] = *(const u32x4*)(rowp + COL_R + hc); rw_p[1] = *(const u32x4*)(rowp + COL_K + hc); rw_p[2] = *(const u32x4*)(rowp + COL_VR + hc);
#pragma unroll
        for (int q4 = 0; q4 < NL; ++q4) { rw_c[3 + q4] = *(const u32x4*)(rowc + COL_LA + q4 * 64 + c0); rw_p[3 + q4] = *(const u32x4*)(rowp + COL_LB + q4 * 64 + c0); }
    };
    bf16x8 fW[2], fA[2], fG[4];
    { int tvw_ = F.tid; asm volatile("" : "+v"(tvw_)); const int g_ = (tvw_ & 63) >> 4, ln_ = tvw_ & 15; const size_t row = (size_t)(h * 64 + (w & 3) * 16 + ln_);
#pragma unroll
      for (int ks = 0; ks < 2; ++ks) { fW[ks] = *(const bf16x8*)(LW2 + row * 64 + 32 * ks + 8 * g_); fA[ks] = *(const bf16x8*)(LA2 + row * 64 + 32 * ks + 8 * g_); }
#pragma unroll
      for (int ks = 0; ks < 4; ++ks) fG[ks] = *(const bf16x8*)(LG2 + row * 128 + 32 * ks + 8 * g_); }
    { int tv0_ = F.tid; asm volatile("" : "+v"(tv0_)); load_raw(0, tv0_); }

    for (int c = 0; c < SEGC; ++c) {
        int tv_ = F.tid; asm volatile("" : "+v"(tv_));
        const int lane = tv_ & 63, t = tv_ >> 3, cg = tv_ & 7, c0 = cg * 8, g = lane >> 4, ln = lane & 15;
        const size_t cu = (size_t)((b * 8 + h) * NCHUNK + seg * SEGC + c) * CHB;
        float r_[8], k_[8], v_[8], a_[8], b_[8], ld_[8], pf_[8];
        {
            float cv[8], pv[8];
            { const unsigned km = ((seg * SEGC + c) * CH + t) > 0 ? 0xffffffffu : 0u;
#pragma unroll
              for (int i = 0; i < 3 + NL; ++i) { rw_p[i].x &= km; rw_p[i].y &= km; rw_p[i].z &= km; rw_p[i].w &= km; } }
            unpack8(rw_c[0], cv); unpack8(rw_p[0], pv);
#pragma unroll
            for (int q = 0; q < 8; ++q) r_[q] = cv[q] + (pv[q] - cv[q]) * PAR[P_MUR * 64 + c0 + q];
            unpack8(rw_c[1], cv); unpack8(rw_p[1], pv);
#pragma unroll
            for (int q = 0; q < 8; ++q) k_[q] = cv[q] + (pv[q] - cv[q]) * PAR[P_MUK * 64 + c0 + q];
            unpack8(rw_c[2], cv); unpack8(rw_p[2], pv);
#pragma unroll
            for (int q = 0; q < 8; ++q) v_[q] = cv[q] + (pv[q] - cv[q]) * PAR[P_MUV * 64 + c0 + q];
#pragma unroll
            for (int q4 = 0; q4 < NL; ++q4) { float o[8];
                unpack8(rw_c[3 + q4], cv); unpack8(rw_p[3 + q4], pv);
#pragma unroll
                for (int q = 0; q < 8; ++q) { const float x = cv[q] + pv[q]; o[q] = (q4 == 0) ? (1.0f - 2.0f * __builtin_amdgcn_rcpf(1.0f + __expf(2.0f * x))) : (q4 == 1 ? x : fsigmoid(x)); }
                LAS bf16_t* dst = (q4 == 0) ? (LW + t * LD + c0) : (q4 == 1) ? (LA + t * LD + c0) : (LG + t * LDG + (q4 - 2) * 64 + c0);
                *(LAS u32x4*)dst = pack8(o);
            }
        }
        LB();
        {
            const int ct = w & 3, tp = (w >> 2) * 2;
#pragma unroll
            for (int j = 0; j < 2; ++j) { const int tt = tp + j; const int so = (tt * 16 + ln) * LD + ct * 16 + 4 * g;
                f32x4 d = (f32x4){0.f, 0.f, 0.f, 0.f}; mma_rx<2>(d, fW, LW + tt * 16 * LD, LD, lane); st4bf(DECP + so, d);
                d = (f32x4){0.f, 0.f, 0.f, 0.f}; mma_rx<2>(d, fA, LA + tt * 16 * LD, LD, lane); st4bf(ICLP + so, d);
                d = (f32x4){0.f, 0.f, 0.f, 0.f}; mma_rx<4>(d, fG, LG + tt * 16 * LDG, LDG, lane);
                u32x2 gw; gw.x = pk2(d[0], d[1]); gw.y = pk2(d[2], d[3]); *(u32x2*)(GTG + cu + frag_off(tt * 16 + ln, ct * 16 + 4 * g)) = gw; }
        }
        LB();
        {
            float dp[8], ip[8]; unpack8(*(const LAS u32x4*)(DECP + t * LD + c0), dp); unpack8(*(const LAS u32x4*)(ICLP + t * LD + c0), ip);
            float kk[8], ss = 0.f, bonus = 0.f;
#pragma unroll
            for (int q = 0; q < 8; ++q) {
                const float xw = dp[q] + PAR[P_W0 * 64 + c0 + q]; const float z = -xw;
                const float sp = fmaxf(z, 0.f) + __logf(1.0f + __expf(-fabsf(z)));
                const float wl = -sp - 0.5f; ld_[q] = -__expf(wl);
                ip[q] = fsigmoid(ip[q] + PAR[P_A0 * 64 + c0 + q]);
                kk[q] = k_[q] * PAR[P_KK * 64 + c0 + q]; ss += kk[q] * kk[q];
            }
            ss = sum8(ss);
            const float inv = __builtin_amdgcn_rsqf(fmaxf(ss, 1e-24f));
#pragma unroll
            for (int q = 0; q < 8; ++q) { kk[q] *= inv; k_[q] = k_[q] * (1.0f + (ip[q] - 1.0f) * PAR[P_KA * 64 + c0 + q]); a_[q] = -kk[q]; b_[q] = kk[q] * ip[q];
                bonus += r_[q] * k_[q] * PAR[P_RK * 64 + c0 + q]; }
            bonus = sum8(bonus);
            { float o[8];
#pragma unroll
              for (int q = 0; q < 8; ++q) o[q] = bonus * v_[q];
              const u32x4 pw = pack8(o); u32x2 lo_, hi_; lo_.x = pw.x; lo_.y = pw.y; hi_.x = pw.z; hi_.y = pw.w;
              *(u32x2*)(BVG + cu + frag_off(t, c0)) = lo_; *(u32x2*)(BVG + cu + frag_off(t, c0 + 4)) = hi_; }
#pragma unroll
            for (int q = 0; q < 8; ++q) { float x = ld_[q];
#pragma unroll
                for (int dsh = 8; dsh < 64; dsh <<= 1) { const float y = __shfl_up(x, dsh); x += (lane >= dsh) ? y : 0.f; }
                pf_[q] = x; }
            if ((lane >> 3) == 7) { *(LAS f32x4*)(WT + w * 64 + c0) = (f32x4){pf_[0], pf_[1], pf_[2], pf_[3]}; *(LAS f32x4*)(WT + w * 64 + c0 + 4) = (f32x4){pf_[4], pf_[5], pf_[6], pf_[7]}; }
        }
        LB();
        REP(16) {
        {
            float off[8], tot[8];
#pragma unroll
            for (int q = 0; q < 8; ++q) { off[q] = 0.f; tot[q] = 0.f; }
#pragma unroll
            for (int ww = 0; ww < 8; ++ww) { const f32x4 x0 = *(const LAS f32x4*)(WT + ww * 64 + c0), x1 = *(const LAS f32x4*)(WT + ww * 64 + c0 + 4); const float m = (ww < w) ? 1.0f : 0.0f;
#pragma unroll
                for (int q = 0; q < 4; ++q) { tot[q] += x0[q]; tot[q + 4] += x1[q]; off[q] += m * x0[q]; off[q + 4] += m * x1[q]; } }
            float o1[8], o2[8], o3[8], o4[8], o5[8], o6[8];
#pragma unroll
            for (int q = 0; q < 8; ++q) { const float cu_ = pf_[q] + off[q]; const float ec = __expf(cu_), en = __builtin_amdgcn_rcpf(ec), wc = __expf(tot[q]), er = wc * en;
                o1[q] = a_[q] * __expf(cu_ - ld_[q]); o2[q] = r_[q] * ec; o3[q] = b_[q] * en; o4[q] = k_[q] * en; o5[q] = b_[q] * er; o6[q] = k_[q] * er;
                if (t == 63) WC[c0 + q] = wc; }
            *(LAS u32x4*)(AT + t * LD + c0) = pack8(o1); *(LAS u32x4*)(RT + t * LD + c0) = pack8(o2); *(LAS u32x4*)(BT + t * LD + c0) = pack8(o3); *(LAS u32x4*)(KT + t * LD + c0) = pack8(o4);
            *(LAS u32x4*)(BH + t * LD + c0) = pack8(o5); *(LAS u32x4*)(KH + t * LD + c0) = pack8(o6); *(LAS u32x4*)(V + t * LD + c0) = pack8(v_);
        }
        LB();
        {
            const int tt = w & 3, ip0 = (w >> 2) * 2;
#pragma unroll
            for (int j = 0; j < 2; ++j) { const int it = ip0 + j; const int i0 = it * 16 + 4 * g, tq = tt * 16 + ln;
                f32x4 d0 = (f32x4){0.f, 0.f, 0.f, 0.f}, d1 = d0, d2 = d0, d3 = d0;
                if (it <= tt) {
                    mma_nt<2>(d0, BT + it * 16 * LD, LD, AT + tt * 16 * LD, LD, lane); mma_nt<2>(d1, KT + it * 16 * LD, LD, AT + tt * 16 * LD, LD, lane);
                    mma_nt<2>(d2, BT + it * 16 * LD, LD, RT + tt * 16 * LD, LD, lane); mma_nt<2>(d3, KT + it * 16 * LD, LD, RT + tt * 16 * LD, LD, lane);
                    if (it == tt) {
#pragma unroll
                        for (int r = 0; r < 4; ++r) { const int i = i0 + r; if (!(i < tq)) { d0[r] = 0.f; d1[r] = 0.f; } if (!(i <= tq)) { d2[r] = 0.f; d3[r] = 0.f; } } }
                }
                *(LAS f32x4*)(LF + tq * LDF + i0) = d0; st4bf(LAK + tq * LD + i0, d1); st4bf(MRB + tq * LD + i0, d2); st4bf(MRK + tq * LD + i0, d3); }
        }
        LB();
        }
        load_raw(c + 1 < SEGC ? c + 1 : c, tv_);
        REP(14) {
        if (w == 0) { const int bk = lane >> 4, j = lane & 15; float x[16];
            const LAS float* Lb = LF + (16 * bk) * LDF + 16 * bk; LAS float* Tb = TF + (16 * bk) * LDF + 16 * bk + j;
            f32x4 ra[4], rb[4];
#pragma unroll
            for (int q = 0; q < 4; ++q) ra[q] = *(const LAS f32x4*)(Lb + 1 * LDF + 4 * q);
            x[0] = (j == 0) ? 1.0f : 0.0f; Tb[0] = x[0];
#pragma unroll
            for (int tr = 1; tr < 16; ++tr) {
                f32x4 (&cur)[4] = (tr & 1) ? ra : rb; f32x4 (&nxt)[4] = (tr & 1) ? rb : ra;
                if (tr < 15) {
#pragma unroll
                    for (int q = 0; q < 4; ++q) nxt[q] = *(const LAS f32x4*)(Lb + (tr + 1) * LDF + 4 * q); }
                float s0 = (tr == j) ? 1.0f : 0.0f, s1 = 0.f;
#pragma unroll
                for (int i = 0; i < tr; ++i) { if (i & 1) s1 += cur[i >> 2][i & 3] * x[i]; else s0 += cur[i >> 2][i & 3] * x[i]; }
                x[tr] = s0 + s1; Tb[tr * LDF] = x[tr]; } }
        LB();
        if (w < 2) { const int p = w, lr = lane & 15, lk = lane >> 4; f32x4 d = (f32x4){0.f, 0.f, 0.f, 0.f};
#pragma unroll
            for (int ks = 0; ks < 4; ++ks) d = __builtin_amdgcn_mfma_f32_16x16x4f32(LF[(32 * p + 16 + lr) * LDF + 32 * p + 4 * ks + lk], TF[(32 * p + 4 * ks + lk) * LDF + 32 * p + lr], d, 0, 0, 0);
#pragma unroll
            for (int r = 0; r < 4; ++r) TMP[(32 * p + 16 + 4 * lk + r) * LDF + 32 * p + lr] = d[r];
            LDS_WAIT(); f32x4 e = (f32x4){0.f, 0.f, 0.f, 0.f};
#pragma unroll
            for (int ks = 0; ks < 4; ++ks) e = __builtin_amdgcn_mfma_f32_16x16x4f32(TF[(32 * p + 16 + lr) * LDF + 32 * p + 16 + 4 * ks + lk], TMP[(32 * p + 16 + 4 * ks + lk) * LDF + 32 * p + lr], e, 0, 0, 0);
#pragma unroll
            for (int r = 0; r < 4; ++r) TF[(32 * p + 16 + 4 * lk + r) * LDF + 32 * p + lr] = e[r]; }
        LB();
        if (w < 4) { const int ri = w >> 1, cj = w & 1, lr = lane & 15, lk = lane >> 4; f32x4 d = (f32x4){0.f, 0.f, 0.f, 0.f};
#pragma unroll
            for (int ks = 0; ks < 8; ++ks) { const int k = 4 * ks + lk; const float bb = ((k >> 4) >= cj) ? TF[k * LDF + 16 * cj + lr] : 0.0f;
                d = __builtin_amdgcn_mfma_f32_16x16x4f32(LF[(32 + 16 * ri + lr) * LDF + k], bb, d, 0, 0, 0); }
#pragma unroll
            for (int r = 0; r < 4; ++r) TMP[(32 + 16 * ri + 4 * lk + r) * LDF + 16 * cj + lr] = d[r]; }
        LB();
        if (w < 4) { const int ri = w >> 1, cj = w & 1, lr = lane & 15, lk = lane >> 4; f32x4 d = (f32x4){0.f, 0.f, 0.f, 0.f};
#pragma unroll
            for (int ks = 0; ks < 8; ++ks) { const int k = 4 * ks + lk; const float aa = (ri >= (k >> 4)) ? TF[(32 + 16 * ri + lr) * LDF + 32 + k] : 0.0f;
                d = __builtin_amdgcn_mfma_f32_16x16x4f32(aa, TMP[(32 + k) * LDF + 16 * cj + lr], d, 0, 0, 0); }
#pragma unroll
            for (int r = 0; r < 4; ++r) TF[(32 + 16 * ri + 4 * lk + r) * LDF + 16 * cj + lr] = d[r]; }
        LB();
        { float o[8];
#pragma unroll
          for (int q = 0; q < 8; ++q) { const int i = c0 + q; o[q] = ((i >> 4) <= (t >> 4)) ? TF[t * LDF + i] : 0.0f; }
          *(LAS u32x4*)(TB + t * LD + c0) = pack8(o); }
        LB();
        }
        const int tt = w & 3, pr = (w >> 2) * 2;
        REP(15) {
#pragma unroll
        for (int j = 0; j < 2; ++j) { const int mt = pr + j; const int so = (tt * 16 + ln) * LD + mt * 16 + 4 * g;
            f32x4 d = (f32x4){0.f, 0.f, 0.f, 0.f}; mma_tx<2>(d, AT + 16 * mt, LD, TB + tt * 16 * LD, LD, lane); st4bf(AH + so, d);
            d = (f32x4){0.f, 0.f, 0.f, 0.f}; mma_tx<2>(d, V + 16 * mt, LD, LAK + tt * 16 * LD, LD, lane); st4bf(XL + so, d); }
        LB();
#pragma unroll
        for (int j = 0; j < 2; ++j) { const int mt = pr + j; const int so = (tt * 16 + ln) * LD + mt * 16 + 4 * g;
            f32x4 d = (f32x4){0.f, 0.f, 0.f, 0.f}; mma_tx<2>(d, XL + 16 * mt, LD, TB + tt * 16 * LD, LD, lane); st4bf(UL + so, d);
            d = bf4(*(const LAS u32x2*)(RT + so)); mma_tx<2>(d, AH + 16 * mt, LD, MRB + tt * 16 * LD, LD, lane);
            { u32x2 o; o.x = pk2(d[0], d[1]); o.y = pk2(d[2], d[3]); *(u32x2*)(YSG + cu + frag_off(tt * 16 + ln, mt * 16 + 4 * g)) = o; }
            d = (f32x4){0.f, 0.f, 0.f, 0.f}; mma_txy<2>(d, AH + 16 * mt, LD, BH + 16 * tt, LD, lane);
            { const f32x4 wc4 = *(const LAS f32x4*)(WC + mt * 16 + 4 * g);
#pragma unroll
              for (int r = 0; r < 4; ++r) d[r] += (mt * 16 + 4 * g + r == tt * 16 + ln) ? wc4[r] : 0.0f;
              u32x2 o; o.x = pk2(d[0], d[1]); o.y = pk2(d[2], d[3]); *(LAS u32x2*)(PHL + so) = o; } }
        LB();
#pragma unroll
        for (int j = 0; j < 2; ++j) { const int mt = pr + j; const int so = (tt * 16 + ln) * LD + mt * 16 + 4 * g;
            f32x4 d = (f32x4){0.f, 0.f, 0.f, 0.f}; mma_txy<2>(d, BH + 16 * mt, LD, UL + 16 * tt, LD, lane); mma_txy<2>(d, KH + 16 * mt, LD, V + 16 * tt, LD, lane);
            { u32x2 o; o.x = pk2(d[0], d[1]); o.y = pk2(d[2], d[3]); *(LAS u32x2*)(PSL + so) = o; }
            d = (f32x4){0.f, 0.f, 0.f, 0.f}; mma_tx<2>(d, UL + 16 * mt, LD, MRB + tt * 16 * LD, LD, lane); mma_tx<2>(d, V + 16 * mt, LD, MRK + tt * 16 * LD, LD, lane);
            { u32x2 o; o.x = pk2(d[0], d[1]); o.y = pk2(d[2], d[3]); *(u32x2*)(YLG + cu + frag_off(tt * 16 + ln, mt * 16 + 4 * g)) = o; } }
        LB();
        }
        { u32x2 xr[4][2][2]; load_xfrags_lds(xr, PHL, LD, lane); state_step(acc, xr);
          if (w >= 4) {
#pragma unroll
              for (int ct = 0; ct < 4; ++ct) { acc[ct] += bf4(*(const LAS u32x2*)(PSL + (16 * (w - 4) + ln) * LD + 16 * ct + 4 * g));
                  u32x2 o; o.x = pk2(acc[ct][0], acc[ct][1]); o.y = pk2(acc[ct][2], acc[ct][3]); *(u32x2*)(PSI + cu + frag_off(16 * (w - 4) + ln, 16 * ct + 4 * g)) = o; }
          } else {
#pragma unroll
              for (int ct = 0; ct < 4; ++ct) { float v0 = acc[ct][0], v1 = acc[ct][1], v2 = acc[ct][2], v3 = acc[ct][3];
                  { const bool od = lane & 1; float t0 = od ? v0 : v1, t1 = od ? v2 : v3; t0 = dpp_f<DPP_XOR1>(t0); t1 = dpp_f<DPP_XOR1>(t1); if (od) { v0 = t0; v2 = t1; } else { v1 = t0; v3 = t1; } }
                  { const bool od = lane & 2; float t0 = od ? v0 : v2, t1 = od ? v1 : v3; t0 = dpp_f<DPP_XOR2>(t0); t1 = dpp_f<DPP_XOR2>(t1); if (od) { v0 = t0; v1 = t1; } else { v2 = t0; v3 = t1; } }
                  u32x2 o; o.x = pk2(v0, v1); o.y = pk2(v2, v3); *(u32x2*)(PHIT + cu + frag_off(16 * ct + 4 * g + (ln & 3), 16 * w + (ln & 12))) = o; } } }
        LB();
    }
    LB();
}

namespace rk {
struct FoldRegs { u32x2 x[4][2][2]; f32x4 q[4]; };
__device__ __forceinline__ void fold_load(FoldRegs& R, const bf16_t* RP, const bf16_t* RQ, int up, int rt, int lane) {
    const size_t cu = ((size_t)up * SEGC + (SEGC - 1)) * CHB;
#pragma unroll
    for (int ct = 0; ct < 4; ++ct)
#pragma unroll
        for (int ks = 0; ks < 2; ++ks) { const u32x4 v = *(const u32x4*)(RP + cu + (size_t)(ct * 64 + lane) * 16 + 8 * ks); R.x[ct][ks][0] = (u32x2){v.x, v.y}; R.x[ct][ks][1] = (u32x2){v.z, v.w}; }
#pragma unroll
    for (int ks = 0; ks < 2; ++ks) { const u32x4 v = *(const u32x4*)(RQ + cu + (size_t)(rt * 64 + lane) * 16 + 8 * ks); R.q[2 * ks] = bf4((u32x2){v.x, v.y}); R.q[2 * ks + 1] = bf4((u32x2){v.z, v.w}); }
}
__device__ __forceinline__ void fold_step(const FoldRegs& R, f32x4 (&acc)[4]) { state_step(acc, R.x);
#pragma unroll
    for (int ct = 0; ct < 4; ++ct) acc[ct] += R.q[ct]; }
}
__device__ __forceinline__ void rwkv_scan_unit(const Ctx& F, int unit) {
    using namespace rk;
    const int w = F.wave;
    const int b = unit >> 7, h = (unit >> 4) & 7, seg = unit & 15;
    int tv_ = F.tid; asm volatile("" : "+v"(tv_));
    const int lane = tv_ & 63, g = lane >> 4, ln = lane & 15;
    LAS bf16_t* ST = (LAS bf16_t*)F.lds;
    LAS float* PG = (LAS float*)(F.lds + MBY);
    const bf16_t *RP = (const bf16_t*)(F.ws + WS_PHIT), *RQ = (const bf16_t*)(F.ws + WS_PSI), *YSG = (const bf16_t*)(F.ws + WS_YS), *YLG = (const bf16_t*)(F.ws + WS_YL), *GTG = (const bf16_t*)(F.ws + WS_GT), *BVG = (const bf16_t*)(F.ws + WS_BV);
    bf16_t* YCAT = (bf16_t*)(F.ws + WS_YCAT);
    const bf16_t* SEGP = (const bf16_t*)(F.ws + WS_SEGP); const float* SEGQ = (const float*)(F.ws + WS_SEGQ);
    if (tv_ < 128) PG[tv_] = (tv_ < 64) ? F.in[I_LNXG][h * 64 + tv_] : F.in[I_LNXB][h * 64 + tv_ - 64];
    const int c = w;
    const size_t cu = (size_t)((b * 8 + h) * NCHUNK + seg * SEGC + c) * CHB, cp = c > 0 ? cu - CHB : cu;
    bf16x8 ptx[4][2]; u32x4 qv[4][2]; bf16x8 ysr[4][2];
#define SCAN_LOADS() do { \
_Pragma("unroll") \
    for (int ct = 0; ct < 4; ++ct) \
_Pragma("unroll") \
        for (int ks = 0; ks < 2; ++ks) { ptx[ct][ks] = *(const bf16x8*)(RP + cp + (size_t)(ct * 64 + lane) * 16 + 8 * ks); qv[ct][ks] = *(const u32x4*)(RQ + cp + (size_t)(ct * 64 + lane) * 16 + 8 * ks); \
            ysr[ct][ks] = *(const bf16x8*)(YSG + cu + (size_t)(ct * 64 + lane) * 16 + 8 * ks); } \
    } while (0)
    if (w < 4) SCAN_LOADS();
    if (w >= 4) {
        f32x4 acc[4];
#pragma unroll
        for (int ct = 0; ct < 4; ++ct) acc[ct] = (f32x4){0.f, 0.f, 0.f, 0.f};
        const int rt = w - 4, u0 = unit - seg; FoldRegs F0, F1, F2, F3;
        const int ul = unit > 0 ? unit - 1 : 0;
#define FLD(R, k) do { const int un_ = u0 + (k); fold_load(R, RP, RQ, un_ < ul ? un_ : ul, rt, lane); } while (0)
        FLD(F0, 0); FLD(F1, 1); FLD(F2, 2);
        for (int sp = 0; sp < seg; sp += 4) {
            FLD(F3, sp + 3); fold_step(F0, acc);
            FLD(F0, sp + 4); if (sp + 1 < seg) fold_step(F1, acc);
            FLD(F1, sp + 5); if (sp + 2 < seg) fold_step(F2, acc);
            FLD(F2, sp + 6); if (sp + 3 < seg) fold_step(F3, acc);
        }
#undef FLD
#pragma unroll
        for (int ct = 0; ct < 4; ++ct) st4bf(ST + (16 * rt + ln) * LD + 16 * ct + 4 * g, acc[ct]);
        SCAN_LOADS();
    }
#undef SCAN_LOADS
    LB();
    bf16x8 xs[4][2];
#pragma unroll
    for (int rt = 0; rt < 4; ++rt) {
        f32x4 sc[4];
        if (c > 0) {
            bf16x8 yf[2];
#pragma unroll
            for (int ks = 0; ks < 2; ++ks) { const u32x2 lo_ = *(const LAS u32x2*)(ST + (16 * rt + ln) * LD + 32 * ks + 4 * g), hi_ = *(const LAS u32x2*)(ST + (16 * rt + ln) * LD + 32 * ks + 16 + 4 * g);
                u32x4 wv; wv.x = lo_.x; wv.y = lo_.y; wv.z = hi_.x; wv.w = hi_.y; yf[ks] = __builtin_bit_cast(bf16x8, wv); }
#pragma unroll
            for (int ct = 0; ct < 4; ++ct) { u32x2 q2; if (ct & 1) { q2.x = qv[rt][ct >> 1].z; q2.y = qv[rt][ct >> 1].w; } else { q2.x = qv[rt][ct >> 1].x; q2.y = qv[rt][ct >> 1].y; } f32x4 d = bf4(q2);
#pragma unroll
                for (int ks = 0; ks < 2; ++ks) d = __builtin_amdgcn_mfma_f32_16x16x32_bf16(ptx[ct][ks], yf[ks], d, 0, 0, 0);
                sc[ct] = d; }
        } else {
#pragma unroll
            for (int ct = 0; ct < 4; ++ct) sc[ct] = bf4(*(const LAS u32x2*)(ST + (16 * rt + ln) * LD + 16 * ct + 4 * g));
        }
        state_yfrags(sc, xs[rt]);
    }
    const size_t orow0 = ((size_t)b * SEQ + (size_t)(seg * SEGC + c) * CH) * D + 512 + h * 64;
    u32x4 yl[4][2], gt[4][2], bv[4][2];
#pragma unroll
    for (int tt = 0; tt < 4; ++tt)
#pragma unroll
        for (int ks = 0; ks < 2; ++ks) { const size_t ro = cu + (size_t)(tt * 64 + lane) * 16 + 8 * ks; yl[tt][ks] = *(const u32x4*)(YLG + ro); gt[tt][ks] = *(const u32x4*)(GTG + ro); bv[tt][ks] = *(const u32x4*)(BVG + ro); }
#define H2(a, vt) (((vt) & 1) ? (u32x2){(a)[(vt) >> 1].z, (a)[(vt) >> 1].w} : (u32x2){(a)[(vt) >> 1].x, (a)[(vt) >> 1].y})
#pragma unroll
    for (int tt = 0; tt < 4; ++tt) {
        f32x4 y[4]; float s = 0.f;
#pragma unroll
        for (int vt = 0; vt < 4; ++vt) { f32x4 d = bf4(H2(yl[tt], vt));
#pragma unroll
            for (int ks = 0; ks < 2; ++ks) d = __builtin_amdgcn_mfma_f32_16x16x32_bf16(xs[vt][ks], ysr[tt][ks], d, 0, 0, 0);
            y[vt] = d; s += (d[0] + d[1]) + (d[2] + d[3]); }
        s = xor32_sum(xor16_sum(s));
        const float mean = s * (1.0f / 64.0f); float qq = 0.f;
#pragma unroll
        for (int vt = 0; vt < 4; ++vt) { y[vt] = y[vt] - mean; qq += (y[vt][0] * y[vt][0] + y[vt][1] * y[vt][1]) + (y[vt][2] * y[vt][2] + y[vt][3] * y[vt][3]); }
        qq = xor32_sum(xor16_sum(qq));
        const float rstd = __builtin_amdgcn_rsqf(qq * (1.0f / 64.0f) + 64e-5f);
        const size_t orow = orow0 + (size_t)(16 * tt + ln) * D;
#pragma unroll
        for (int vp = 0; vp < 4; vp += 2) { u32x2 ow[2];
#pragma unroll
            for (int q = 0; q < 2; ++q) { const int vt = vp + q; const f32x4 lg4 = *(const LAS f32x4*)(PG + 16 * vt + 4 * g), lb4 = *(const LAS f32x4*)(PG + 64 + 16 * vt + 4 * g);
                const f32x4 o = (y[vt] * rstd * lg4 + lb4 + bf4(H2(bv[tt], vt))) * bf4(H2(gt[tt], vt)); ow[q].x = pk2(o[0], o[1]); ow[q].y = pk2(o[2], o[3]); }
            *(u32x4*)(YCAT + orow + 16 * (vp + (g & 1)) + 4 * (g & 2)) = widen16(ow[0], ow[1]); }
    }
#undef H2
    LB();
}

__device__ __forceinline__ void router_phase(const Ctx& F) {
    const int tid = F.tid, lane = F.lane, w = F.wave;
    constexpr int LDX = 1028;
    LAS float* X = (LAS float*)F.lds;
    LAS float* RS = (LAS float*)(F.lds + 32 * LDX * 4);
    LAS float* LOG = RS + 32;
    LAS int* LCNT = (LAS int*)(LOG + 32 * 33);
    LAS float* TOPV = (LAS float*)(LCNT + 32);
    const float* XI = F.in[I_X]; const bf16_t* ATT = (const bf16_t*)(F.ws + WS_H1); unsigned char* HN2 = F.ws + WS_HN2; bf16_t* H1B = (bf16_t*)(F.ws + WS_XN); const float* RW = (const float*)(F.ws + WS_RW);
    int* CNT = (int*)(F.ws + WS_CNT); int* RIDX = (int*)(F.ws + WS_RIDX); float* RGATE = (float*)(F.ws + WS_RGATE); int* RRANK = (int*)(F.ws + WS_RRANK);
    f32x4 gv[4];
#pragma unroll
    for (int j = 0; j < 4; ++j) gv[j] = *((const f32x4*)F.in[I_N2G] + lane + 64 * j);
    f32x4 vr[4][4]; u32x2 ar[4][4];
    if (F.vcu < NRT) {
#pragma unroll
        for (int rr = 0; rr < 4; ++rr) { const size_t ro = ((size_t)F.vcu * RT_TOK + w * 4 + rr) * D; const f32x4* xr = (const f32x4*)(XI + ro) + lane; const u32x2* qr = (const u32x2*)(ATT + ro) + lane;
#pragma unroll
            for (int j = 0; j < 4; ++j) { vr[rr][j] = __builtin_nontemporal_load(xr + 64 * j); ar[rr][j] = __builtin_nontemporal_load(qr + 64 * j);     } } }
    bf16x8 wh[8], wl[8];
#pragma unroll
    for (int st = 0; st < 8; ++st) { u32x4 h4, l4;
#pragma unroll
        for (int jp = 0; jp < 4; ++jp) { const int k = 128 * w + 16 * st + 8 * (lane >> 5) + 2 * jp; const float a = RW[k * NEXP + (lane & 31)], b = RW[(k + 1) * NEXP + (lane & 31)];
            const unsigned hw = pk2(a, b); h4[jp] = hw; l4[jp] = pk2(a - bflo(hw), b - bfhi(hw)); }
        wh[st] = __builtin_bit_cast(bf16x8, h4); wl[st] = __builtin_bit_cast(bf16x8, l4); }
    for (int tile = F.vcu; tile < NRT; tile += F.G) {
#pragma unroll
        for (int rr = 0; rr < 4; ++rr) { const int row = w * 4 + rr; const size_t m = (size_t)tile * RT_TOK + row;
            f32x4 v[4]; float s = 0.f;
#pragma unroll
            for (int j = 0; j < 4; ++j) { const u32x2 a2 = ar[rr][j]; v[j] = vr[rr][j] + (f32x4){bflo(a2.x), bfhi(a2.x), bflo(a2.y), bfhi(a2.y)}; s += (v[j].x * v[j].x + v[j].y * v[j].y) + (v[j].z * v[j].z + v[j].w * v[j].w); }
            const float rstd = __builtin_amdgcn_rsqf(wave_sum(s) * (1.0f / D) + 1e-5f);
            unsigned* o4 = (unsigned*)(HN2 + m * D) + lane; u32x2* h4 = (u32x2*)(H1B + m * D) + lane;
#pragma unroll
            for (int j = 0; j < 4; ++j) { { u32x2 hb; hb.x = pk2(v[j].x, v[j].y); hb.y = pk2(v[j].z, v[j].w); __builtin_nontemporal_store(hb, h4 + 64 * j); }
                o4[64 * j] = pk4_fp8(v[j].x * rstd * gv[j].x, v[j].y * rstd * gv[j].y, v[j].z * rstd * gv[j].z, v[j].w * rstd * gv[j].w);
                *(LAS f32x4*)(X + row * LDX + 4 * (lane + 64 * j)) = v[j]; }
            if (lane == 0) RS[row] = rstd; }
        WG_BAR();
        if (tile + F.G < NRT) {
#pragma unroll
            for (int rr = 0; rr < 4; ++rr) { const size_t ro = ((size_t)(tile + F.G) * RT_TOK + w * 4 + rr) * D; const f32x4* xr = (const f32x4*)(XI + ro) + lane; const u32x2* qr = (const u32x2*)(ATT + ro) + lane;
#pragma unroll
                for (int j = 0; j < 4; ++j) { vr[rr][j] = __builtin_nontemporal_load(xr + 64 * j); ar[rr][j] = __builtin_nontemporal_load(qr + 64 * j);     } } }
        f32x16 acc;
#pragma unroll
        for (int r = 0; r < 16; ++r) acc[r] = 0.f;
        { const int i = lane & 31, hh = lane >> 5;
#pragma unroll
          for (int st = 0; st < 8; ++st) { const int kb = 128 * w + 16 * st + 8 * hh; const f32x4 x0 = *(const LAS f32x4*)(X + i * LDX + kb), x1 = *(const LAS f32x4*)(X + i * LDX + kb + 4);
              u32x4 h4, l4;
              h4[0] = pk2(x0[0], x0[1]); h4[1] = pk2(x0[2], x0[3]); h4[2] = pk2(x1[0], x1[1]); h4[3] = pk2(x1[2], x1[3]);
              l4[0] = pk2(x0[0] - bflo(h4[0]), x0[1] - bfhi(h4[0])); l4[1] = pk2(x0[2] - bflo(h4[1]), x0[3] - bfhi(h4[1]));
              l4[2] = pk2(x1[0] - bflo(h4[2]), x1[1] - bfhi(h4[2])); l4[3] = pk2(x1[2] - bflo(h4[3]), x1[3] - bfhi(h4[3]));
              const bf16x8 xh = __builtin_bit_cast(bf16x8, h4), xl = __builtin_bit_cast(bf16x8, l4);
              acc = __builtin_amdgcn_mfma_f32_32x32x16_bf16(xh, wh[st], acc, 0, 0, 0);
              acc = __builtin_amdgcn_mfma_f32_32x32x16_bf16(xh, wl[st], acc, 0, 0, 0);
              acc = __builtin_amdgcn_mfma_f32_32x32x16_bf16(xl, wh[st], acc, 0, 0, 0); } }
        WG_BAR();
#pragma unroll
        for (int r = 0; r < 16; ++r) { const int tok = (r & 3) + 8 * (r >> 2) + 4 * (lane >> 5); X[(w * 32 + tok) * 33 + (lane & 31)] = acc[r]; }
        WG_BAR();
#pragma unroll
        for (int q = 0; q < 2; ++q) { const int idx = tid + 512 * q, tok = idx >> 5, e = idx & 31; float s = 0.f;
#pragma unroll
            for (int ww = 0; ww < 8; ++ww) s += X[(ww * 32 + tok) * 33 + e];
            LOG[tok * 33 + e] = s * RS[tok] + F.in[I_RB][e]; }
        if (tid < 32) LCNT[tid] = 0;
        WG_BAR();
        {
            const int e = lane & 31;
#pragma unroll
            for (int it = 0; it < 2; ++it) { const int tok = w * 4 + 2 * it + (lane >> 5); const LAS float* lr = LOG + tok * 33; const float val = lr[e]; int rank = 0;
#pragma unroll
                for (int j = 0; j < 32; ++j) { const float o = lr[j]; rank += (o > val || (o == val && j < e)) ? 1 : 0; }
                if (rank < 4) TOPV[tok * 4 + rank] = val;
                LDS_WAIT(); asm volatile("" ::: "memory");
                const f32x4 t4 = *(const LAS f32x4*)(TOPV + tok * 4);
                const float es = 1.0f + __expf(t4[1] - t4[0]) + __expf(t4[2] - t4[0]) + __expf(t4[3] - t4[0]);
                const float gate = __expf(val - t4[0]) * __builtin_amdgcn_rcpf(es); const size_t m = (size_t)tile * RT_TOK + tok;
                if (rank < 4) { const int rk = atomicAdd((int*)(LCNT + e), 1); RIDX[m * 4 + rank] = e; RGATE[m * 4 + rank] = gate; RRANK[m * 4 + rank] = rk; }
            }
        }
        WG_BAR();
        if (tid < 32) CNT[tile * 32 + tid] = LCNT[tid];
        WG_BAR();
    }
}

__device__ __forceinline__ void scatter_phase(const Ctx& F) {
    const int tid = F.tid;
    LAS int* PS = (LAS int*)F.lds;
    LAS int* PAD = PS + 512;
    LAS int* BASE = PAD + 64;
    const int* CNT = (const int*)(F.ws + WS_CNT); const int* RIDX = (const int*)(F.ws + WS_RIDX); const int* RRANK = (const int*)(F.ws + WS_RRANK);
    int* TDEST = (int*)(F.ws + WS_TDEST); int* ROWTOK = (int*)(F.ws + WS_ROWTOK); int* ETAB = (int*)(F.ws + WS_ETAB);
    for (int t0 = F.vcu; t0 < NRT; t0 += 2 * F.G) {
        const int tl = tid >> 7, mytile = t0 + tl * F.G;
        int ae = 0, ar = 0;
        if (tid < 256 && mytile < NRT) { const size_t ix = (size_t)mytile * 128 + (tid & 127); ae = RIDX[ix]; ar = RRANK[ix]; }
        int part = 0; const int btile = t0 + (tid >> 5) * F.G;
        if (tid < 64 && btile < NRT) { const int p = btile >> 5;
#pragma unroll
            for (int j = 0; j < 32; ++j) { const int v = CNT[(32 * p + j) * 32 + (tid & 31)]; part += (32 * p + j < btile) ? v : 0; } }
        { const int e = tid & 31, p = tid >> 5; int sm = 0;
#pragma unroll
          for (int j = 0; j < 32; ++j) sm += CNT[(32 * p + j) * 32 + e];
          PS[p * 32 + e] = sm; }
        WG_BAR();
        if (tid < 64) { const int e = tid & 31; int tot = 0;
#pragma unroll
            for (int p = 0; p < 16; ++p) tot += PS[p * 32 + e];
            const int padn = (tot + 255) & ~255; int inc = padn;
#pragma unroll
            for (int d = 1; d < 32; d <<= 1) { const int o = __shfl_up(inc, d, 32); inc += (e >= d) ? o : 0; }
            if (tid < 32) { PAD[e] = inc - padn; if (e == 31) PAD[32] = inc; }
            if (btile < NRT) { const int p = btile >> 5; int sm = inc - padn + part;
#pragma unroll
                for (int pp = 0; pp < 16; ++pp) sm += (pp < p) ? PS[pp * 32 + e] : 0;
                BASE[(tid >> 5) * 32 + e] = sm; } }
        WG_BAR();
        if (F.vcu == 0 && t0 == F.vcu && tid < 33) ETAB[tid] = PAD[tid];
        if (t0 == F.vcu) { LAS unsigned char* tx = F.lds + TEXP_OFF;
            for (int pm = tid; pm < MAXROWS / 256; pm += 512) { const int r0 = pm * 256; int e = 0;
#pragma unroll
                for (int j = 1; j < NEXP; ++j) e = (PAD[j] <= r0) ? j : e;
                tx[pm] = (unsigned char)e; } }
        if (tid < 256 && mytile < NRT) { const size_t ix = (size_t)mytile * 128 + (tid & 127); const int dest = BASE[tl * 32 + ae] + ar;
            ROWTOK[dest] = (int)(ix >> 2) << 10; TDEST[ix] = dest; }
        WG_BAR();
    }
}

struct CombRows { u32x2 a[4]; unsigned y[4][4]; };
__device__ __forceinline__ void comb_load(CombRows& R, const bf16_t* H1B, const LAS unsigned char* hl, const unsigned char* YOUT, const int4 td, int m, int lane) {
    if (hl) {
#pragma unroll
        for (int j = 0; j < 4; ++j) R.a[j] = *(const LAS u32x2*)(hl + 8 * lane + 512 * j); }
    else { const u32x2* qr = (const u32x2*)(H1B + (size_t)m * D) + lane;
#pragma unroll
        for (int j = 0; j < 4; ++j) R.a[j] = __builtin_nontemporal_load(qr + 64 * j); }
    const int dd[4] = {td.x, td.y, td.z, td.w};
#pragma unroll
    for (int p = 0; p < 4; ++p) { const unsigned* yr = (const unsigned*)(YOUT + (size_t)dd[p] * D) + lane;
#pragma unroll
        for (int j = 0; j < 4; ++j) R.y[p][j] = __builtin_nontemporal_load(yr + 64 * j); }
}
__device__ __forceinline__ void comb_store(const CombRows& R, const f32x4 (&gv)[4], const f32x4 gt, float* out, int m, int lane) {
    f32x4 v[4]; float s = 0.f; const float gp[4] = {gt.x * (1.0f / FP8_SY), gt.y * (1.0f / FP8_SY), gt.z * (1.0f / FP8_SY), gt.w * (1.0f / FP8_SY)};
#pragma unroll
    for (int j = 0; j < 4; ++j) { v[j] = (f32x4){bflo(R.a[j].x), bfhi(R.a[j].x), bflo(R.a[j].y), bfhi(R.a[j].y)};
#pragma unroll
        for (int p = 0; p < 4; ++p) { const unsigned y = R.y[p][j]; const f32x2 lo = __builtin_amdgcn_cvt_pk_f32_fp8(y, false), hi = __builtin_amdgcn_cvt_pk_f32_fp8(y, true);
            v[j].x += lo.x * gp[p]; v[j].y += lo.y * gp[p]; v[j].z += hi.x * gp[p]; v[j].w += hi.y * gp[p]; }
        s += (v[j].x * v[j].x + v[j].y * v[j].y) + (v[j].z * v[j].z + v[j].w * v[j].w); }
    const float rstd = __builtin_amdgcn_rsqf(wave_sum(s) * (1.0f / D) + 1e-5f);
    f32x4* o = (f32x4*)(out + (size_t)m * D) + lane;
#pragma unroll
    for (int j = 0; j < 4; ++j) __builtin_nontemporal_store(v[j] * rstd * gv[j], o + 64 * j);
}
__device__ __forceinline__ void combine_preload(const Ctx& F) {
    const int gw = F.vcu * 8 + F.wave, NGW = F.G * 8; const bf16_t* H1B = (const bf16_t*)(F.ws + WS_XN);
#pragma unroll
    for (int i = 0; i < 8; ++i) { const int m = gw + i * NGW; const char* src = (const char*)(H1B + (size_t)(m < M ? m : M - 1) * D);
#pragma unroll
        for (int k = 0; k < 2; ++k) __builtin_amdgcn_global_load_lds((const unsigned*)(src + k * 1024 + F.lane * 16), (LAS unsigned*)(F.lds + F.wave * 16384 + i * 2048 + k * 1024), 16, 0, 2); }
    asm volatile("s_waitcnt vmcnt(0)" ::: "memory");
}
__device__ __forceinline__ void combine_phase(const Ctx& F, float* out, bool pre) {
    const int lane = F.lane; const int gw = F.vcu * 8 + F.wave, NGW = F.G * 8;
    const bf16_t* H1B = (const bf16_t*)(F.ws + WS_XN); const unsigned char* YOUT = F.ws + WS_YOUT; const int4* TDEST = (const int4*)(F.ws + WS_TDEST); const f32x4* RGATE = (const f32x4*)(F.ws + WS_RGATE);
    f32x4 gv[4];
#pragma unroll
    for (int j = 0; j < 4; ++j) gv[j] = *((const f32x4*)F.in[I_FG] + lane + 64 * j);
    for (int m0 = gw; m0 < M; m0 += 8 * NGW) {
        int4 td[8]; f32x4 gt[8];
#pragma unroll
        for (int i = 0; i < 8; ++i) { const int m = m0 + i * NGW; td[i] = TDEST[m < M ? m : M - 1]; gt[i] = RGATE[m < M ? m : M - 1]; }
        CombRows R[4];
#pragma unroll
        for (int i = 0; i < 4; ++i) { const int m = m0 + i * NGW; comb_load(R[i], H1B, (pre && m0 == gw) ? F.lds + F.wave * 16384 + i * 2048 : (const LAS unsigned char*)nullptr, YOUT, td[i], m < M ? m : M - 1, lane); }
#pragma unroll
        for (int i = 0; i < 8; ++i) {
            { const int m = m0 + i * NGW; if (m < M) comb_store(R[i & 3], gv, gt[i], out, m, lane); }
            if (i + 4 < 8) { const int m = m0 + (i + 4) * NGW; comb_load(R[i & 3], H1B, (pre && m0 == gw) ? F.lds + F.wave * 16384 + (i + 4) * 2048 : (const LAS unsigned char*)nullptr, YOUT, td[i + 4], m < M ? m : M - 1, lane); }
        }
    }
}

__global__ void __launch_bounds__(512, 2) mk_fwd(Args args) {
    extern __shared__ __attribute__((aligned(16))) unsigned char lds_raw[];
    Ctx F;
    F.lds = (LAS unsigned char*)lds_raw;
    F.tid = threadIdx.x; F.lane = F.tid & 63; F.wave = __builtin_amdgcn_readfirstlane(F.tid >> 6);
    F.G = gridDim.x; { const int bx = blockIdx.x; F.vcu = (F.G % 8 == 0) ? (bx % 8) * (F.G / 8) + bx / 8 : bx; }
    F.ws = args.ws; F.in = args.in;
    volatile LAS unsigned* MISC = (volatile LAS unsigned*)(F.lds + MISC_OFF);
    if (F.tid < 64) MISC[F.tid] = 0u;
    __syncthreads();
    unsigned* ctl = (unsigned*)(args.ws + WS_CTL);
    XcdBarrier bar; bar.bar = ctl + CW_BAR; bar.x = 0; bar.st = nullptr;
    const int lo = args.ph_lo, hi = args.ph_hi;
    if (hi - lo > 1) bar = xcd_barrier_post(ctl + CW_BAR + args.li * XCD_BAR_WORDS, MISC + 8);
    if (F.tid == 0 && (F.G % 8) == 0) {
        const unsigned me = xb_xcc_id() + 1u; unsigned expect = 0u;
        if (!__hip_atomic_compare_exchange_strong(ctl + CW_XMAP + (blockIdx.x & 7), &expect, me, __ATOMIC_RELAXED, __ATOMIC_RELAXED, __HIP_MEMORY_SCOPE_AGENT) && expect != me)
            __hip_atomic_fetch_or(ctl + CW_XBAD, 1u, __ATOMIC_RELAXED, __HIP_MEMORY_SCOPE_AGENT); }
#define IN(k) (lo <= (k) && (k) < hi)
#define SEAM(k) do { if (IN(k) && IN((k) + 1)) xcd_barrier(bar); } while (0)
#define MOE_FILL(j) do { if ((j) == 3 && F.G == 256) moe_weight_skew(F, moe_slice_lo(j)); else if ((j) < 2 && (F.G & 1) == 0) moe_weight_half(F, moe_slice_lo(j), moe_slice_hi(j), 1 - (j)); else moe_weight_phase(F, moe_slice_lo(j), moe_slice_hi(j)); } while (0)
#define SEAM_FILL(k, j) do { if (IN(k) && IN((k) + 1)) { xcd_barrier_arrive(bar); MOE_FILL(j); xcd_barrier_wait(bar); } else if (IN(k)) MOE_FILL(j); } while (0)
    unsigned char* ws = args.ws;

    if (IN(0)) REP(0) { p0_prologue(F); } SEAM_FILL(0, 0);
    if (IN(1)) REP(1) {
        pg8::Gemm g{(const bf16_t*)(ws + WS_XN), (const bf16_t*)(ws + WS_WCAT), M, NPROJ, D}; pg8::StaticOrder S; S.init(M, NPROJ, D, F.G, (int)blockIdx.x);
        pg8::EpiProj E{(bf16_t*)(ws + WS_PROJ), NPROJ, 4};
        pg8::gemm_phase<pg8::EpiProj, pg8::StaticOrder, false>(F.lds, g, S, E);
    } SEAM_FILL(1, 1);
    if (IN(2)) REP(2) { REP(10) sgu_phase(F); for (int u = F.vcu; u < NRU; u += F.G) rwkv_prep_unit(F, u); } SEAM_FILL(2, 2);
    if (IN(3)) REP(3) { for (int u = F.vcu; u < NRU; u += F.G) rwkv_scan_unit(F, u); } SEAM_FILL(3, 3);
    if (IN(4)) REP(4) {
        pg8::Gemm g{(const bf16_t*)(ws + WS_YCAT), (const bf16_t*)(ws + WS_WOUT), M, D, D}; pg8::StaticOrder S; S.init(M, D, D, F.G, (int)blockIdx.x);
        pg8::EpiProj E{(bf16_t*)(ws + WS_H1), D, 0};
        pg8::gemm_phase<pg8::EpiProj, pg8::StaticOrder, false>(F.lds, g, S, E);
    } SEAM_FILL(4, 4);
    if (IN(5)) REP(5) { router_phase(F); }
    if (IN(5) && IN(6)) {
        xcd_barrier_arrive(bar); moe_weight_phase(F, 0, MOE_ITEMS - MOE_EARLY); xcd_barrier_wait(bar); scatter_phase(F);
    } else if (IN(6)) REP(6) { scatter_phase(F); moe_weight_phase(F, 0, MOE_ITEMS - MOE_EARLY); }
    SEAM(6);
    if (IN(7)) REP(7) {
        const int* etab = (const int*)(ws + WS_ETAB); const int ntiles = etab[32] >> 8;
        pg8::MoeChain S; S.deal(ntiles, F.G, (int)blockIdx.x); S.pad_start = etab; S.rowtok = (const int*)(ws + WS_ROWTOK);
        S.A1 = (const char*)(ws + WS_HN2); S.B1 = (const char*)(ws + WS_W1T); S.A2 = (const char*)(ws + WS_ACT); S.B2 = (const char*)(ws + WS_W2T); S.cnt = ctl + CW_DEP;
        if (IN(6) && F.vcu < NRT) { S.texp = F.lds + TEXP_OFF; __syncthreads(); } else S.build_texp(F.lds);
        pg8::Gemm g{nullptr, nullptr, MAXROWS, NHID, D};
        const bool plain_ok = (F.G % 8) == 0 && hi - lo > 1 && __hip_atomic_load(ctl + CW_XBAD, __ATOMIC_RELAXED, __HIP_MEMORY_SCOPE_AGENT) == 0u;
        pg8::EpiChain E{{ws + WS_ACT, F.in[I_MB1], S.texp, plain_ok}, {ws + WS_YOUT, F.in[I_MB2], S.texp}};
        pg8::gemm_phase<pg8::EpiChain, pg8::MoeChain, true, true>(F.lds, g, S, E);
    }
    if (IN(7) && IN(8) && IN(9)) { xcd_barrier_arrive(bar); combine_preload(F); xcd_barrier_wait(bar); combine_phase(F, args.out, true); }
    else { SEAM(7); if (IN(9)) REP(9) { combine_phase(F, args.out, false); } }
#undef IN
#undef SEAM
}

extern "C" void kernel_launch(void* const* d_in, const int* in_sizes, int n_in, void* d_out, int out_size, void* d_ws, size_t ws_size, hipStream_t stream) {
    static int grid = 0;
    if (grid == 0) {
        if (n_in != 31 || in_sizes[0] != M * D || out_size != M * D || ws_size < WS_END) { fprintf(stderr, "kernel_launch: unexpected problem (n_in %d, out %d, ws %zu); nothing launched\n", n_in, out_size, ws_size); grid = -1; return; }
        int dev = 0, cus = 0, per_cu = 0;
        if (hipGetDevice(&dev) != hipSuccess || hipDeviceGetAttribute(&cus, hipDeviceAttributeMultiprocessorCount, dev) != hipSuccess) { grid = -1; return; }
        if (hipFuncSetAttribute((const void*)mk_fwd, hipFuncAttributeMaxDynamicSharedMemorySize, LDS_BYTES) != hipSuccess) { fprintf(stderr, "kernel_launch: hipFuncSetAttribute failed\n"); grid = -1; return; }
        if (hipOccupancyMaxActiveBlocksPerMultiprocessor(&per_cu, (const void*)mk_fwd, 512, LDS_BYTES) != hipSuccess || per_cu < 1) fprintf(stderr, "kernel_launch: occupancy query reports %d\n", per_cu);
        (void)hipGetLastError();
        grid = cus;
    }
    if (grid < 0) return;
    if (hipMemsetAsync((char*)d_ws + WS_CTL, 0, CTL_ZERO_BYTES, stream) != hipSuccess) return;
    Args a; memset(&a, 0, sizeof(a));
    for (int i = 0; i < 31; ++i) a.in[i] = (const float*)d_in[i];
    a.out = (float*)d_out; a.ws = (unsigned char*)d_ws;
    constexpr int NL = MK_N_LAUNCHES;
    static_assert(NL == 1 || NL == N_PHASES, "MK_N_LAUNCHES: 1 (one launch) or 10 (one launch per phase)");
    for (int li = 0; li < NL; ++li) {
        a.ph_lo = (NL == 1) ? 0 : li; a.ph_hi = (NL == 1) ? N_PHASES : li + 1; a.li = 0; a.pad = 0;
        hipLaunchKernelGGL(mk_fwd, dim3(grid), dim3(512), LDS_BYTES, stream, a);
    }
}
```
